# Optimizing an MI355X kernel written in HIP

```python
import math
import jax, jax.numpy as jnp
from jax import lax
import numpy as np

D_MODEL = 2048
BATCH = 4
SEQ = 2048
DEPTH = 2
DEC_BATCH = 128
DEC_SEQ = 4
PAST_LEN = 16384
PAGE_SIZE = 128

D_RET = D_MODEL // 2
RET_HEADS = 4
RET_HEAD_DIM = D_RET // RET_HEADS
D_POOL = D_MODEL - D_RET
POOL_WINDOWS = (2, 4, 8, 16)
N_POOL_GROUPS = len(POOL_WINDOWS)
POOL_GROUP_DIM = D_POOL // N_POOL_GROUPS
POOL_BUF = max(POOL_WINDOWS) - 1
D_IN = 4 * D_RET + D_POOL
N_MEM = 256
MEM_HEADS = 4
MEM_HEAD_DIM = D_MODEL // MEM_HEADS
D_FF = 4 * D_MODEL
RET_CHUNK = 128
ROPE_BASE = 10000.0
EPS = 1e-6

kernel_name = 'hymba_retention_pool_memory_decode_step'


def rmsnorm(x, w):
    xf = x.astype(jnp.float32)
    y = xf * lax.rsqrt(jnp.mean(xf * xf, axis=-1, keepdims=True) + EPS)
    return (y * w.astype(jnp.float32)).astype(x.dtype)


def rotary(x, pos):
    half = x.shape[-1] // 2
    inv = ROPE_BASE ** (-jnp.arange(half, dtype=jnp.float32) / half)
    ang = pos.astype(jnp.float32)[:, None] * inv[None, :]
    cos = jnp.cos(ang)[None, :, None, :]
    sin = jnp.sin(ang)[None, :, None, :]
    xf = x.astype(jnp.float32)
    x1, x2 = xf[..., :half], xf[..., half:]
    return jnp.concatenate([x1 * cos - x2 * sin, x2 * cos + x1 * sin], axis=-1)


def log_gamma():
    return jnp.log1p(-jnp.exp2(-5.0 - jnp.arange(RET_HEADS, dtype=jnp.float32)))


def retention(q, k, v, s0, chunk):
    B, T, H, Dk = q.shape
    Dv = v.shape[-1]
    nc = T // chunk
    lg = log_gamma()
    idx = jnp.arange(chunk, dtype=jnp.float32)
    diff = idx[:, None] - idx[None, :]
    decay_in = jnp.where(diff[None] >= 0.0,
                         jnp.exp(lg[:, None, None] * jnp.maximum(diff, 0.0)[None]), 0.0)
    decay_q = jnp.exp(lg[None, :] * (idx[:, None] + 1.0))
    decay_k = jnp.exp(lg[None, :] * (chunk - 1.0 - idx[:, None]))
    decay_chunk = jnp.exp(lg * chunk)

    def split(a):
        return a.reshape(B, nc, chunk, H, a.shape[-1]).swapaxes(0, 1)

    def step(s, qkv):
        qc, kc, vc = qkv
        scores = jnp.einsum('bihd,bjhd->bhij', qc, kc) * decay_in[None]
        o = jnp.einsum('bhij,bjhe->bihe', scores, vc)
        o = o + jnp.einsum('bihd,bhde->bihe', qc * decay_q[None, :, :, None], s)
        s = s * decay_chunk[None, :, None, None] + jnp.einsum(
            'bjhd,bjhe->bhde', kc * decay_k[None, :, :, None], vc)
        return s, o

    s, o = lax.scan(step, s0, (split(q), split(k), split(v)))
    return o.swapaxes(0, 1).reshape(B, T, H, Dv), s


def pool_mix(u, buf, n_prev):
    T = u.shape[1]
    uf = u.astype(jnp.float32)
    ext = jnp.concatenate([buf.astype(jnp.float32), uf], axis=1)
    cs = jnp.pad(jnp.cumsum(ext, axis=1), ((0, 0), (1, 0), (0, 0)))
    end = cs[:, POOL_BUF + 1:]
    outs = []
    for g, w in enumerate(POOL_WINDOWS):
        sl = slice(g * POOL_GROUP_DIM, (g + 1) * POOL_GROUP_DIM)
        start = cs[:, POOL_BUF + 1 - w: POOL_BUF + 1 - w + T, sl]
        cnt = jnp.minimum(jnp.arange(T) + n_prev + 1, w).astype(jnp.float32)
        outs.append((end[..., sl] - start) / cnt[None, :, None] - uf[..., sl])
    pooled = jnp.stack(outs, axis=2)
    return pooled, ext[:, -POOL_BUF:].astype(u.dtype)


def mem_kv(mem, norm_w, w_k, w_v):
    B = mem.shape[0]
    m = rmsnorm(mem, norm_w)
    k = (m @ w_k).reshape(B, N_MEM, MEM_HEADS, MEM_HEAD_DIM)
    v = (m @ w_v).reshape(B, N_MEM, MEM_HEADS, MEM_HEAD_DIM)
    return k, v


def cross_attend(h, mk, mv, w_q):
    B, T, _ = h.shape
    q = (h @ w_q).reshape(B, T, MEM_HEADS, MEM_HEAD_DIM)
    s = jnp.einsum('bthd,bmhd->bhtm', q, mk).astype(jnp.float32) * (MEM_HEAD_DIM ** -0.5)
    p = jax.nn.softmax(s, axis=-1).astype(h.dtype)
    return jnp.einsum('bhtm,bmhd->bthd', p, mv).reshape(B, T, D_MODEL)


def layer(x, pos, s_ret, p_buf, n_prev, chunk, mk, mv, lw):
    B, T, _ = x.shape
    h = rmsnorm(x, lw['attn_norm_w'])
    z = h @ lw['w_in']
    q, k, v, g, u = jnp.split(z, [D_RET, 2 * D_RET, 3 * D_RET, 4 * D_RET], axis=-1)
    heads = lambda a: a.reshape(B, T, RET_HEADS, RET_HEAD_DIM)
    qr = rotary(heads(q), pos)
    kr = rotary(heads(k), pos) * (RET_HEAD_DIM ** -0.5)
    o, s_new = retention(qr, kr, heads(v).astype(jnp.float32), s_ret.astype(jnp.float32), chunk)
    o = o * lax.rsqrt(jnp.mean(o * o, axis=-1, keepdims=True) + EPS)
    o = o.reshape(B, T, D_RET) * lw['ret_norm_w'].astype(jnp.float32)
    o = (jax.nn.silu(g.astype(jnp.float32)) * o).astype(x.dtype)
    pooled, buf_new = pool_mix(u, p_buf, n_prev)
    pm = jnp.einsum('btgc,gcd->btgd', pooled.astype(x.dtype), lw['pool_w']).reshape(B, T, D_POOL)
    pm = pm * lw['pool_scale']
    x = x + jnp.concatenate([o, pm], axis=-1) @ lw['w_out']
    h = rmsnorm(x, lw['xattn_norm_w'])
    x = x + cross_attend(h, mk, mv, lw['w_xq']) @ lw['w_xo']
    h = rmsnorm(x, lw['mlp_norm_w'])
    x = x + jnp.square(jax.nn.relu(h @ lw['w_up'])) @ lw['w_down']
    return x, s_new.astype(x.dtype), buf_new


def setup_inputs(seed: int = 0) -> dict:
    key = jax.random.key(seed)
    ks = jax.random.split(key, 24)
    f32 = jnp.float32
    nrm = lambda k, shape, s: jax.random.normal(k, shape, f32) * s
    gain = lambda k, shape: 1.0 + 0.02 * jax.random.normal(k, shape, f32)
    return {
        'x_prompt': nrm(ks[0], (BATCH, SEQ, D_MODEL), 1.0),
        'x_sample': nrm(ks[1], (DEC_BATCH, DEC_SEQ, D_MODEL), 1.0),
        'mem_prompt': nrm(ks[2], (BATCH, N_MEM, D_MODEL), 1.0),
        'state_ret': nrm(ks[3], (DEPTH, DEC_BATCH, RET_HEADS, RET_HEAD_DIM, RET_HEAD_DIM), 0.5),
        'state_pool': nrm(ks[4], (DEPTH, DEC_BATCH, POOL_BUF, D_POOL), 1.0),
        'cache_mem_k': nrm(ks[5], (DEPTH, DEC_BATCH, N_MEM, MEM_HEADS, MEM_HEAD_DIM), 1.0),
        'cache_mem_v': nrm(ks[6], (DEPTH, DEC_BATCH, N_MEM, MEM_HEADS, MEM_HEAD_DIM), 1.0),
        'attn_norm_w': gain(ks[7], (DEPTH, D_MODEL)),
        'w_in': nrm(ks[8], (DEPTH, D_MODEL, D_IN), D_MODEL ** -0.5),
        'ret_norm_w': gain(ks[9], (DEPTH, D_RET)),
        'pool_w': nrm(ks[10], (DEPTH, N_POOL_GROUPS, POOL_GROUP_DIM, POOL_GROUP_DIM), POOL_GROUP_DIM ** -0.5),
        'pool_scale': gain(ks[11], (DEPTH, D_POOL)),
        'w_out': nrm(ks[12], (DEPTH, D_MODEL, D_MODEL), D_MODEL ** -0.5),
        'xattn_norm_w': gain(ks[13], (DEPTH, D_MODEL)),
        'mem_norm_w': gain(ks[14], (DEPTH, D_MODEL)),
        'w_xq': nrm(ks[15], (DEPTH, D_MODEL, D_MODEL), D_MODEL ** -0.5),
        'w_mk': nrm(ks[16], (DEPTH, D_MODEL, D_MODEL), D_MODEL ** -0.5),
        'w_mv': nrm(ks[17], (DEPTH, D_MODEL, D_MODEL), D_MODEL ** -0.5),
        'w_xo': nrm(ks[18], (DEPTH, D_MODEL, D_MODEL), D_MODEL ** -0.5),
        'mlp_norm_w': gain(ks[19], (DEPTH, D_MODEL)),
        'w_up': nrm(ks[20], (DEPTH, D_MODEL, D_FF), D_MODEL ** -0.5),
        'w_down': nrm(ks[21], (DEPTH, D_FF, D_MODEL), D_FF ** -0.5),
        'final_norm_w': gain(ks[22], (D_MODEL,)),
    }


def reference(x_prompt, x_sample, mem_prompt, state_ret, state_pool, cache_mem_k, cache_mem_v,
              attn_norm_w, w_in, ret_norm_w, pool_w, pool_scale, w_out, xattn_norm_w, mem_norm_w,
              w_xq, w_mk, w_mv, w_xo, mlp_norm_w, w_up, w_down, final_norm_w):
    pos_p = jnp.arange(SEQ)
    pos_s = jnp.arange(DEC_SEQ) + PAST_LEN
    xp, xs = x_prompt, x_sample
    ret_p, buf_p, mk_p, mv_p, ret_s, buf_s = [], [], [], [], [], []
    for l in range(DEPTH):
        lw = {'attn_norm_w': attn_norm_w[l], 'w_in': w_in[l], 'ret_norm_w': ret_norm_w[l],
              'pool_w': pool_w[l], 'pool_scale': pool_scale[l], 'w_out': w_out[l],
              'xattn_norm_w': xattn_norm_w[l], 'w_xq': w_xq[l], 'w_xo': w_xo[l],
              'mlp_norm_w': mlp_norm_w[l], 'w_up': w_up[l], 'w_down': w_down[l]}
        mk, mv = mem_kv(mem_prompt, mem_norm_w[l], w_mk[l], w_mv[l])
        s0 = jnp.zeros((BATCH, RET_HEADS, RET_HEAD_DIM, RET_HEAD_DIM), jnp.float32)
        b0 = jnp.zeros((BATCH, POOL_BUF, D_POOL), xp.dtype)
        xp, sp, bp = layer(xp, pos_p, s0, b0, 0, RET_CHUNK, mk, mv, lw)
        ret_p.append(sp)
        buf_p.append(bp)
        mk_p.append(mk)
        mv_p.append(mv)
        xs, ss, bs = layer(xs, pos_s, state_ret[l], state_pool[l], PAST_LEN, DEC_SEQ,
                           cache_mem_k[l], cache_mem_v[l], lw)
        ret_s.append(ss)
        buf_s.append(bs)
    y_prompt = rmsnorm(xp, final_norm_w)
    y_sample = rmsnorm(xs, final_norm_w)
    return (y_prompt, y_sample, jnp.stack(ret_p), jnp.stack(buf_p), jnp.stack(mk_p), jnp.stack(mv_p),
            jnp.stack(ret_s), jnp.stack(buf_s))
```

```cpp
#include <hip/hip_runtime.h>
#include <cstdio>
#include <cstdint>

#define DI __device__ __forceinline__
#define GAS __attribute__((address_space(1)))
#define LAS __attribute__((address_space(3)))
typedef unsigned short bf16;
typedef short bf16x8 __attribute__((ext_vector_type(8)));
typedef short s16x4 __attribute__((ext_vector_type(4)));
typedef float f32x4 __attribute__((ext_vector_type(4)));
typedef float f32x2 __attribute__((ext_vector_type(2)));
typedef unsigned u32x4 __attribute__((ext_vector_type(4)));
typedef unsigned u32x2 __attribute__((ext_vector_type(2)));

#ifndef MK_N_LAUNCHES
#define MK_N_LAUNCHES 1
#endif

constexpr int DM = 2048, MP = 8192, MS = 512, MT = MP + MS, DIN = 5120, DFF = 8192, DRET = 1024, DPOOL = 1024, NMEM = 256;
constexpr int SEQ = 2048, NB = 4, DECB = 128, DECT = 4, NPOS = SEQ + DECT;
constexpr float EPS = 1e-6f;

constexpr size_t MiB = 1u << 20;
constexpr size_t WS_CTL = 0, CTL_ZERO_BYTES = 64 * 1024;
constexpr size_t WS_COS = 1 * MiB, WS_SIN = 2 * MiB + MiB / 2;
constexpr size_t WS_W = 4 * MiB, W_LAYER = 125 * MiB;
constexpr size_t WO_IN = 0, WO_OUT = 20 * MiB, WO_XQ = 28 * MiB, WO_MKV = 36 * MiB, WO_XO = 52 * MiB, WO_UP = 60 * MiB, WO_DN = 92 * MiB, WO_POOL = 124 * MiB;
constexpr size_t WS_XN = 254 * MiB;
constexpr size_t WS_Z = 288 * MiB;
constexpr size_t WS_KD = 373 * MiB;
constexpr size_t WS_PL = 389 * MiB;
constexpr size_t WS_CAT = 406 * MiB;
constexpr size_t WS_Q2 = 440 * MiB;
constexpr size_t WS_ATT = 474 * MiB;
constexpr size_t WS_XA = 508 * MiB;
constexpr size_t WS_UP = 576 * MiB;
constexpr size_t WS_MN = 712 * MiB;
constexpr size_t WS_MKB = 720 * MiB, WS_MVB = 724 * MiB;
constexpr size_t WS_KVT = 728 * MiB;
constexpr size_t WS_ST = 792 * MiB;
constexpr size_t WS_DUMMY = 824 * MiB;
constexpr size_t WS_SSQ = 892 * MiB, SSQ_BYTES = 4 * MiB;
constexpr size_t WS_PART = 900 * MiB;
constexpr size_t WS_END = 916 * MiB;

constexpr size_t OUT_YP = 0, OUT_YS = 16777216, OUT_RSP = OUT_YS + 1048576, OUT_PBP = OUT_RSP + 2097152, OUT_MK = OUT_PBP + 122880,
                 OUT_MV = OUT_MK + 4194304, OUT_RSS = OUT_MV + 4194304, OUT_PBS = OUT_RSS + 67108864, OUT_TOTAL = OUT_PBS + 3932160;

constexpr int LDS_CTL = 0, LDS_BIG = 1024, LDS_BYTES = 147456;

DI float bf2f(unsigned short b) { return __uint_as_float((unsigned)b << 16); }
typedef __bf16 bf16x2_t __attribute__((ext_vector_type(2)));
DI unsigned cvt_pk_bf16(float lo, float hi) { f32x2 v = {lo, hi}; bf16x2_t b = __builtin_convertvector(v, bf16x2_t); return __builtin_bit_cast(unsigned, b); }
DI u32x4 pack8(f32x4 a, f32x4 b) { u32x4 w; w.x = cvt_pk_bf16(a[0], a[1]); w.y = cvt_pk_bf16(a[2], a[3]); w.z = cvt_pk_bf16(b[0], b[1]); w.w = cvt_pk_bf16(b[2], b[3]); return w; }
DI u32x2 pack4(f32x4 a) { u32x2 w; w.x = cvt_pk_bf16(a[0], a[1]); w.y = cvt_pk_bf16(a[2], a[3]); return w; }
DI f32x4 unpack4(u32x2 w) { f32x4 r; r[0] = __uint_as_float(w.x << 16); r[1] = __uint_as_float(w.x & 0xffff0000u); r[2] = __uint_as_float(w.y << 16); r[3] = __uint_as_float(w.y & 0xffff0000u); return r; }
DI float wave_sum(float v) {
#pragma unroll
    for (int o = 1; o < 64; o <<= 1) v += __shfl_xor(v, o);
    return v;
}
DI float wave_max(float v) {
#pragma unroll
    for (int o = 1; o < 64; o <<= 1) v = fmaxf(v, __shfl_xor(v, o));
    return v;
}
DI float lg2gamma(int h) { return log2f(1.0f - exp2f(-5.0f - (float)h)); }
DI bf16x8 cat8(s16x4 a, s16x4 b) { return __builtin_shufflevector(a, b, 0, 1, 2, 3, 4, 5, 6, 7); }
template <int O0, int O1, int O2, int O3, int O4, int O5, int O6, int O7>
DI void tr8(unsigned a, s16x4 (&o)[8]) {
    asm volatile("ds_read_b64_tr_b16 %0, %8 offset:%9\n\tds_read_b64_tr_b16 %1, %8 offset:%10\n\tds_read_b64_tr_b16 %2, %8 offset:%11\n\tds_read_b64_tr_b16 %3, %8 offset:%12\n\t"
                 "ds_read_b64_tr_b16 %4, %8 offset:%13\n\tds_read_b64_tr_b16 %5, %8 offset:%14\n\tds_read_b64_tr_b16 %6, %8 offset:%15\n\tds_read_b64_tr_b16 %7, %8 offset:%16\n\t"
                 "s_waitcnt lgkmcnt(0)"
                 : "=&v"(o[0]), "=&v"(o[1]), "=&v"(o[2]), "=&v"(o[3]), "=&v"(o[4]), "=&v"(o[5]), "=&v"(o[6]), "=&v"(o[7])
                 : "v"(a), "i"(O0), "i"(O1), "i"(O2), "i"(O3), "i"(O4), "i"(O5), "i"(O6), "i"(O7) : "memory");
}
#define MFMA16(a, b, c) __builtin_amdgcn_mfma_f32_16x16x32_bf16((a), (b), (c), 0, 0, 0)

namespace pg8 {
#define PG8_LAS __attribute__((address_space(3)))
typedef unsigned short bf16_t;
constexpr int BM = 256, BK = 64, HALF = 128, HTB = HALF * BK * 2, STAGE_BYTES = 8 * HTB, NXCD = 8, WGM = 8;
__host__ __device__ __forceinline__ int lds_byte(int r, int c) { const int st = (r >> 4) * 2 + (c >> 5), rr = r & 15, cc = c & 31, ob = rr * 64 + cc * 2; return st * 1024 + (ob ^ (((ob >> 9) & 1) << 5)); }
__host__ __device__ __forceinline__ void stage_rc(int b, int& R, int& C) { const int st = b / 1024, sb = b % 1024, swz = sb ^ (((sb >> 9) & 1) << 5); R = (st >> 1) * 16 + swz / 64; C = (st & 1) * 32 + (swz % 64) / 2; }
__host__ __device__ __forceinline__ int perm32(int rho) { const int n = rho >> 4, i = rho & 15; return 8 * (i >> 2) + 4 * n + (i & 3); }
struct Unit { int pm, pn; };
struct Gemm { const bf16_t* A; const bf16_t* Bt; int M, N, K, lda, a_pn_off; };
struct StaticOrder {
    int nM, nN, nwg, G, c;
    __host__ __device__ void init(int M, int N, int G_, int c_) { nM = M / BM; nN = N / BM; nwg = nM * nN; G = G_; c = c_; }
    __host__ __device__ bool next(int i, Unit& u) const {
        const long L = (long)i * G + c; if (L >= nwg) return false;
        int wgid = (int)L; { const int q = nwg / NXCD, r = nwg % NXCD, xcd = wgid % NXCD, off = wgid / NXCD; wgid = (xcd < r ? xcd * (q + 1) : r * (q + 1) + (xcd - r) * q) + off; }
        const int nig = WGM * nN, gid = wgid / nig, fm = gid * WGM, gsz = (nM - fm) < WGM ? (nM - fm) : WGM;
        u.pm = fm + ((wgid % nig) % gsz); u.pn = (wgid % nig) / gsz; return true;
    }
    __device__ __forceinline__ void a_ready(const Unit&) const {}
    __device__ __forceinline__ void done(const Unit&) const {}
};
template <class Epi, class Sched, bool ALIGN_EPI = false, bool SP2 = false>
__device__ __forceinline__ void gemm_phase(PG8_LAS unsigned char* lds, const Gemm g, const Sched& S, const Epi& E) {
    int tid = threadIdx.x; asm volatile("" : "+v"(tid));
    const int wid = __builtin_amdgcn_readfirstlane(tid >> 6), lane = tid & 63, wr = wid >> 2, wc = wid & 3, fr = lane & 15, fq = lane >> 4;
    int K = g.K, lda = g.lda; asm volatile("" : "+s"(K), "+s"(lda));
    const int nt = K / BK;
    unsigned voffA[2], voffB[2];
#pragma unroll
    for (int i = 0; i < 2; ++i) { int R, C; stage_rc(tid * 16 + i * 8192, R, C); const int Rb = Epi::PERM ? ((R & ~31) + perm32(R & 31)) : R;
        voffA[i] = (unsigned)(R * lda + C) * 2u; voffB[i] = (unsigned)(Rb * K + C) * 2u; }
    const size_t kstep = (size_t)(BK * 2);
    const size_t hstepA = (size_t)HALF * lda * 2, hstepB = (size_t)HALF * K * 2;
    const size_t tstepA = 2 * hstepA, tstepB = 2 * hstepB;
    const unsigned ldsw = (unsigned)wid * 1024u;
    const int aoff = lds_byte(wr * 64 + fr, fq * 8), boff = lds_byte(wc * 32 + fr, fq * 8);
#define PG8_SA(b, h) (((b) * 2 + (h)) * HTB)
#define PG8_SB(b, h) ((4 + (b) * 2 + (h)) * HTB)
#define PG8_STAGE(bufoff, gbase, voff) do { _Pragma("unroll") for (int _i = 0; _i < 2; ++_i) \
        __builtin_amdgcn_global_load_lds((const unsigned*)((const char*)(gbase) + (voff)[_i]), (PG8_LAS unsigned*)(lds + (bufoff) + ldsw + _i * 8192), 16, 0, 0); } while (0)
#define PG8_LDA(dst, b, h) do { _Pragma("unroll") for (int m = 0; m < 4; ++m) _Pragma("unroll") for (int k = 0; k < 2; ++k) dst[m][k] = *(const PG8_LAS bf16x8*)(lds + PG8_SA(b, h) + aoff + m * 2048 + k * 1024); } while (0)
#define PG8_LDB(dst, b, h) do { _Pragma("unroll") for (int n = 0; n < 2; ++n) _Pragma("unroll") for (int k = 0; k < 2; ++k) dst[n][k] = *(const PG8_LAS bf16x8*)(lds + PG8_SB(b, h) + boff + n * 2048 + k * 1024); } while (0)
#define PG8_MMA(ai, bj, At, Bt) do { __builtin_amdgcn_s_setprio(1); _Pragma("unroll") for (int m = 0; m < 4; ++m) _Pragma("unroll") for (int n = 0; n < 2; ++n) _Pragma("unroll") for (int k = 0; k < 2; ++k) \
        acc[ai][bj][m][n] = __builtin_amdgcn_mfma_f32_16x16x32_bf16(Bt[n][k], At[m][k], acc[ai][bj][m][n], 0, 0, 0); __builtin_amdgcn_s_setprio(0); } while (0)
#define PG8_WAIT_V(n) asm volatile("s_waitcnt vmcnt(" #n ")" ::: "memory")
#define PG8_WAIT_L(n) asm volatile("s_waitcnt lgkmcnt(" #n ")" ::: "memory")
#define PG8_BAR __builtin_amdgcn_s_barrier()
#define PG8_SCHED __builtin_amdgcn_sched_barrier(0)
    Unit cur, nxt; int ui = 0;
    if (!S.next(0, cur)) return;
    f32x4 acc[2][2][4][2];
#pragma unroll
    for (int a = 0; a < 2; ++a)
#pragma unroll
        for (int b = 0; b < 2; ++b)
#pragma unroll
            for (int m = 0; m < 4; ++m)
#pragma unroll
                for (int n = 0; n < 2; ++n) acc[a][b][m][n] = (f32x4){0.f, 0.f, 0.f, 0.f};
    bf16x8 At[4][2], B0[2][2], B1[2][2];
    const char* cA = (const char*)g.A + (size_t)cur.pm * tstepA + (size_t)cur.pn * g.a_pn_off * 2; const char* cB = (const char*)g.Bt + (size_t)cur.pn * tstepB;
    S.a_ready(cur);
    if constexpr (SP2) {
        PG8_STAGE(PG8_SB(0, 0), cB, voffB); PG8_STAGE(PG8_SB(0, 1), cB + hstepB, voffB); PG8_STAGE(PG8_SA(0, 0), cA, voffA); PG8_STAGE(PG8_SA(0, 1), cA + hstepA, voffA);
        if (wr == 1) PG8_BAR;
        PG8_WAIT_V(2); PG8_BAR;
        PG8_STAGE(PG8_SB(1, 0), cB + kstep, voffB); PG8_STAGE(PG8_SA(1, 0), cA + kstep, voffA); PG8_STAGE(PG8_SB(1, 1), cB + hstepB + kstep, voffB);
        PG8_WAIT_V(6); PG8_BAR;
    } else {
        PG8_STAGE(PG8_SB(0, 0), cB, voffB); PG8_STAGE(PG8_SA(0, 0), cA, voffA); PG8_STAGE(PG8_SB(0, 1), cB + hstepB, voffB); PG8_STAGE(PG8_SA(0, 1), cA + hstepA, voffA);
        if (wr == 1) PG8_BAR;
        PG8_WAIT_V(4); PG8_BAR;
        PG8_STAGE(PG8_SB(1, 0), cB + kstep, voffB); PG8_STAGE(PG8_SA(1, 0), cA + kstep, voffA); PG8_STAGE(PG8_SB(1, 1), cB + hstepB + kstep, voffB);
        PG8_WAIT_V(6); PG8_BAR;
    }
    for (;;) {
        const bool has_next = S.next(ui + 1, nxt);
        const char* nA = has_next ? (const char*)g.A + (size_t)nxt.pm * tstepA + (size_t)nxt.pn * g.a_pn_off * 2 : cA; const char* nB = has_next ? (const char*)g.Bt + (size_t)nxt.pn * tstepB : cB;
        for (int t = 0; t < nt; t += 2) {
            const bool last = (t == nt - 2);
            const char* a1 = cA + (size_t)(t + 1) * kstep;
            const char* a2 = last ? nA : cA + (size_t)(t + 2) * kstep; const char* b2 = last ? nB : cB + (size_t)(t + 2) * kstep;
            const char* a3 = a2 + kstep; const char* b3 = b2 + kstep;
            if (last && has_next) S.a_ready(nxt);
            if constexpr (SP2) {
            PG8_LDB(B0, 0, 0); PG8_LDB(B1, 0, 1); PG8_SCHED; PG8_LDA(At, 0, 0); PG8_STAGE(PG8_SA(1, 1), a1 + hstepA, voffA);
            PG8_WAIT_V(8); PG8_WAIT_L(0); PG8_BAR; PG8_MMA(0, 0, At, B0); PG8_MMA(0, 1, At, B1); PG8_BAR; PG8_SCHED;
            PG8_LDA(At, 0, 1); PG8_STAGE(PG8_SB(0, 0), b2, voffB); PG8_STAGE(PG8_SB(0, 1), b2 + hstepB, voffB); PG8_STAGE(PG8_SA(0, 0), a2, voffA);
            PG8_WAIT_V(8); PG8_WAIT_L(0); PG8_BAR; PG8_MMA(1, 0, At, B0); PG8_MMA(1, 1, At, B1); PG8_BAR; PG8_SCHED;
            PG8_LDB(B0, 1, 0); PG8_LDB(B1, 1, 1); PG8_SCHED; PG8_LDA(At, 1, 0); PG8_STAGE(PG8_SA(0, 1), a2 + hstepA, voffA);
            PG8_WAIT_V(8); PG8_WAIT_L(0); PG8_BAR; PG8_MMA(0, 0, At, B0); PG8_MMA(0, 1, At, B1); PG8_BAR; PG8_SCHED;
            PG8_LDA(At, 1, 1); PG8_STAGE(PG8_SB(1, 0), b3, voffB); PG8_STAGE(PG8_SB(1, 1), b3 + hstepB, voffB); PG8_STAGE(PG8_SA(1, 0), a3, voffA);
            PG8_WAIT_V(8); PG8_WAIT_L(0); PG8_BAR; PG8_MMA(1, 0, At, B0); PG8_MMA(1, 1, At, B1); PG8_BAR; PG8_SCHED;
            } else {
            PG8_LDB(B0, 0, 0); PG8_SCHED; PG8_LDA(At, 0, 0); PG8_STAGE(PG8_SA(1, 1), a1 + hstepA, voffA);
            PG8_WAIT_L(8); PG8_BAR; PG8_WAIT_L(0); PG8_MMA(0, 0, At, B0); PG8_BAR; PG8_SCHED;
            PG8_LDB(B1, 0, 1); PG8_STAGE(PG8_SB(0, 0), b2, voffB);
            PG8_BAR; PG8_WAIT_L(0); PG8_MMA(0, 1, At, B1); PG8_BAR;
            PG8_LDA(At, 0, 1); PG8_STAGE(PG8_SA(0, 0), a2, voffA);
            PG8_BAR; PG8_WAIT_L(0); PG8_MMA(1, 0, At, B0); PG8_BAR; PG8_SCHED;
            PG8_STAGE(PG8_SB(0, 1), b2 + hstepB, voffB);
            PG8_WAIT_V(6); PG8_BAR; PG8_MMA(1, 1, At, B1); PG8_BAR;
            PG8_LDB(B0, 1, 0); PG8_SCHED; PG8_LDA(At, 1, 0); PG8_STAGE(PG8_SA(0, 1), a2 + hstepA, voffA);
            PG8_WAIT_L(8); PG8_BAR; PG8_WAIT_L(0); PG8_MMA(0, 0, At, B0); PG8_BAR; PG8_SCHED;
            PG8_LDB(B1, 1, 1); PG8_STAGE(PG8_SB(1, 0), b3, voffB);
            PG8_BAR; PG8_WAIT_L(0); PG8_MMA(0, 1, At, B1); PG8_BAR;
            PG8_LDA(At, 1, 1); PG8_STAGE(PG8_SA(1, 0), a3, voffA);
            PG8_BAR; PG8_WAIT_L(0); PG8_MMA(1, 0, At, B0); PG8_BAR; PG8_SCHED;
            PG8_STAGE(PG8_SB(1, 1), b3 + hstepB, voffB);
            PG8_WAIT_V(6); PG8_BAR; PG8_MMA(1, 1, At, B1); PG8_BAR;
            }
        }
        if constexpr (ALIGN_EPI) { if (wr == 0) PG8_BAR; }
        E(acc, cur, wr, wc, fr, fq); S.done(cur);
        if (!has_next) break;
#pragma unroll
        for (int a = 0; a < 2; ++a)
#pragma unroll
            for (int b = 0; b < 2; ++b)
#pragma unroll
                for (int m = 0; m < 4; ++m)
#pragma unroll
                    for (int n = 0; n < 2; ++n) acc[a][b][m][n] = (f32x4){0.f, 0.f, 0.f, 0.f};
        cur = nxt; cA = nA; cB = nB; ++ui;
        if constexpr (ALIGN_EPI) { if (wr == 1) PG8_BAR; }
    }
    PG8_WAIT_V(0);
    if constexpr (!ALIGN_EPI) { if (wr == 0) PG8_BAR; }
    PG8_BAR;
#undef PG8_SA
#undef PG8_SB
#undef PG8_STAGE
#undef PG8_LDA
#undef PG8_LDB
#undef PG8_MMA
#undef PG8_WAIT_V
#undef PG8_WAIT_L
#undef PG8_BAR
#undef PG8_SCHED
}
}
using pg8::Unit;


template <int NS> DI float row_rstd(const float* __restrict__ ssq, int row, int fq) {
    const f32x4* p = (const f32x4*)(ssq + (size_t)row * 64 + fq * (NS / 4)); float s = 0.f;
#pragma unroll
    for (int i = 0; i < NS / 16; ++i) { const f32x4 v = p[i]; s += (v[0] + v[1]) + (v[2] + v[3]); }
    s += __shfl_xor(s, 16); s += __shfl_xor(s, 32);
    return __builtin_amdgcn_rsqf(s * (1.0f / DM) + EPS);
}
struct EpiZ {
    static constexpr bool PERM = true;
    bf16* Z; bf16* KD; const float* cosT; const float* sinT; float* pbp; float* pbs; const float* ssq;
    DI void operator()(const f32x4 (&acc)[2][2][4][2], const Unit& u, int wr, int wc, int fr, int fq) const {
        asm volatile("" : "+v"(fr), "+v"(fq));
        const int type = u.pn >> 2, row0 = u.pm * 256 + wr * 64 + fr, cl = wc * 32 + 8 * fq;
        const bool sample = u.pm >= 32;
        if (type <= 1) {
            const float ksc = type == 1 ? 0.0625f : 1.0f;
#pragma unroll
            for (int ai = 0; ai < 2; ++ai)
#pragma unroll
                for (int m = 0; m < 4; ++m) {
                    const int row = row0 + ai * 128 + m * 16;
                    const int tab = sample ? (SEQ + (row & 3)) : (row & (SEQ - 1));
                    const f32x4 c0 = *(const f32x4*)(cosT + tab * 128 + cl), c1 = *(const f32x4*)(cosT + tab * 128 + cl + 4);
                    const f32x4 s0 = *(const f32x4*)(sinT + tab * 128 + cl), s1 = *(const f32x4*)(sinT + tab * 128 + cl + 4);
                    const float rs = sample ? row_rstd<64>(ssq, row, fq) : row_rstd<32>(ssq, row, fq);
                    const f32x4 a0 = acc[ai][0][m][0] * rs, a1 = acc[ai][0][m][1] * rs, b0 = acc[ai][1][m][0] * rs, b1 = acc[ai][1][m][1] * rs;
                    const f32x4 o10 = (a0 * c0 - b0 * s0) * ksc, o11 = (a1 * c1 - b1 * s1) * ksc, o20 = (b0 * c0 + a0 * s0) * ksc, o21 = (b1 * c1 + a1 * s1) * ksc;
                    bf16* zp = Z + (size_t)row * DIN + u.pn * 256 + cl;
                    *(u32x4*)zp = pack8(o10, o11); *(u32x4*)(zp + 128) = pack8(o20, o21);
                }
        } else {
#pragma unroll
            for (int ai = 0; ai < 2; ++ai)
#pragma unroll
                for (int m = 0; m < 4; ++m) {
                    const int row = row0 + ai * 128 + m * 16;
                    bf16* zp = Z + (size_t)row * DIN + u.pn * 256 + cl;
                    const float rs = sample ? row_rstd<64>(ssq, row, fq) : row_rstd<32>(ssq, row, fq);
                    f32x4 v[2][2];
#pragma unroll
                    for (int bj = 0; bj < 2; ++bj) { v[bj][0] = acc[ai][bj][m][0] * rs; v[bj][1] = acc[ai][bj][m][1] * rs; *(u32x4*)(zp + bj * 128) = pack8(v[bj][0], v[bj][1]); }
                    if (type == 4) {
                        const int cu = (u.pn - 16) * 256 + cl;
                        float* dst = nullptr;
                        if (sample) { const int rr = row - MP; dst = pbs + ((size_t)(rr >> 2) * 15 + 11 + (rr & 3)) * DPOOL + cu; }
                        else { const int t = row & (SEQ - 1); if (t >= SEQ - 15) dst = pbp + ((size_t)(row >> 11) * 15 + (t - (SEQ - 15))) * DPOOL + cu; }
                        if (dst) {
#pragma unroll
                            for (int bj = 0; bj < 2; ++bj) { *(f32x4*)(dst + bj * 128) = v[bj][0]; *(f32x4*)(dst + bj * 128 + 4) = v[bj][1]; }
                        }
                    }
                }
        }
    }
};
struct EpiMemKV {
    static constexpr bool PERM = true;
    float* ok; float* ov; bf16* kb; bf16* vb;
    DI void operator()(const f32x4 (&acc)[2][2][4][2], const Unit& u, int wr, int wc, int fr, int fq) const {
        asm volatile("" : "+v"(fr), "+v"(fq));
        const bool isv = u.pn >= 8; float* of = isv ? ov : ok; bf16* ob = isv ? vb : kb;
        const int row0 = u.pm * 256 + wr * 64 + fr, col0 = (u.pn & 7) * 256 + wc * 32 + 8 * fq;
#pragma unroll
        for (int ai = 0; ai < 2; ++ai)
#pragma unroll
            for (int m = 0; m < 4; ++m) { const size_t ro = (size_t)(row0 + ai * 128 + m * 16) * DM + col0;
#pragma unroll
                for (int bj = 0; bj < 2; ++bj) { const f32x4 v0 = acc[ai][bj][m][0], v1 = acc[ai][bj][m][1];
                    *(f32x4*)(of + ro + bj * 128) = v0; *(f32x4*)(of + ro + bj * 128 + 4) = v1; *(u32x4*)(ob + ro + bj * 128) = pack8(v0, v1); } }
    }
};
struct EpiRes {
    static constexpr bool PERM = true;
    const float* basef; const bf16* baseb; bf16* xb; float* ssq;
    DI void operator()(const f32x4 (&acc)[2][2][4][2], const Unit& u, int wr, int wc, int fr, int fq) const {
        asm volatile("" : "+v"(fr), "+v"(fq));
        const int row0 = u.pm * 256 + wr * 64 + fr, col0 = u.pn * 256 + wc * 32 + 8 * fq;
#pragma unroll
        for (int ai = 0; ai < 2; ++ai)
#pragma unroll
            for (int m = 0; m < 4; ++m) { const int row = row0 + ai * 128 + m * 16; const size_t ro = (size_t)row * DM + col0; float sq = 0.f;
#pragma unroll
                for (int bj = 0; bj < 2; ++bj) { f32x4 b0, b1;
                    if (basef) { b0 = *(const f32x4*)(basef + ro + bj * 128); b1 = *(const f32x4*)(basef + ro + bj * 128 + 4); }
                    else { const u32x4 w = *(const u32x4*)(baseb + ro + bj * 128); b0 = unpack4((u32x2){w.x, w.y}); b1 = unpack4((u32x2){w.z, w.w}); }
                    const f32x4 v0 = b0 + acc[ai][bj][m][0], v1 = b1 + acc[ai][bj][m][1];
                    *(u32x4*)(xb + ro + bj * 128) = pack8(v0, v1);
                    sq += ((v0[0] * v0[0] + v0[1] * v0[1]) + (v0[2] * v0[2] + v0[3] * v0[3])) + ((v1[0] * v1[0] + v1[1] * v1[1]) + (v1[2] * v1[2] + v1[3] * v1[3])); }
                sq += __shfl_xor(sq, 16); sq += __shfl_xor(sq, 32);
                if (fq == 0) ssq[(size_t)row * 64 + u.pn * 4 + wc] = sq; }
    }
};
template <int ACT> struct EpiB {
    static constexpr bool PERM = true;
    bf16* O; int ldc; float scale; const float* cs; int coff; const float* ssq;
    DI void operator()(const f32x4 (&acc)[2][2][4][2], const Unit& u, int wr, int wc, int fr, int fq) const {
        asm volatile("" : "+v"(fr), "+v"(fq));
        const int row0 = u.pm * 256 + wr * 64 + fr, col0 = u.pn * 256 + wc * 32 + 8 * fq;
#pragma unroll
        for (int ai = 0; ai < 2; ++ai)
#pragma unroll
            for (int m = 0; m < 4; ++m) { bf16* rp = O + (size_t)(row0 + ai * 128 + m * 16) * ldc + coff + col0;
                float rs = scale; if (ACT != 2) rs *= row_rstd<32>(ssq, row0 + ai * 128 + m * 16, fq);
#pragma unroll
                for (int bj = 0; bj < 2; ++bj) { f32x4 v0 = acc[ai][bj][m][0], v1 = acc[ai][bj][m][1];
                    if (ACT != 2) { v0 = v0 * rs; v1 = v1 * rs; }
                    if (ACT == 1) { v0 = __builtin_elementwise_max(v0, (f32x4){0.f, 0.f, 0.f, 0.f}); v1 = __builtin_elementwise_max(v1, (f32x4){0.f, 0.f, 0.f, 0.f}); v0 = v0 * v0; v1 = v1 * v1; }
                    if (ACT == 2) { v0 = v0 * *(const f32x4*)(cs + col0 + bj * 128); v1 = v1 * *(const f32x4*)(cs + col0 + bj * 128 + 4); }
                    *(u32x4*)(rp + bj * 128) = pack8(v0, v1); } }
    }
};

#define XB_TMO      128
#define XB_XCNT(j)  (256  + 64 * (j))
#define XB_XSUB(j)  (1280 + 64 * (j))
#define XB_XGEN(j)  (2304 + 64 * (j))
#define XB_TOP      3328
#define XB_TOPGEN   3392
#define XCD_BAR_WORDS 3456
#define XB_SPIN_CAP (1u << 18)
__device__ __forceinline__ unsigned xb_ld(unsigned* p)              { return __hip_atomic_load(p, __ATOMIC_RELAXED, __HIP_MEMORY_SCOPE_AGENT); }
__device__ __forceinline__ unsigned xb_add(unsigned* p, unsigned v) { return __hip_atomic_fetch_add(p, v, __ATOMIC_RELAXED, __HIP_MEMORY_SCOPE_AGENT); }
__device__ __forceinline__ unsigned xb_xcc_id() { return (unsigned)__builtin_amdgcn_s_getreg((3 << 11) | 20) & 0xFu; }
#define XB_SPIN(cond, bar) do { unsigned _sp = 0; while (cond) { __builtin_amdgcn_s_sleep(1); \
    if ((++_sp & 255u) == 0u) { if (xb_ld(&(bar)[XB_TMO])) break; if (_sp > XB_SPIN_CAP) { atomicAdd(&(bar)[XB_TMO], 1u); break; } } } } while (0)
struct XcdBarrier { unsigned* bar; unsigned x; volatile LAS unsigned* st; };
__device__ __forceinline__ XcdBarrier xcd_barrier_post(unsigned* bar, volatile LAS unsigned* st) {
    XcdBarrier b; b.bar = bar; b.x = xb_xcc_id(); b.st = st;
    if (threadIdx.x == 0) (void)xb_add(&bar[XB_XCNT(b.x)], 1u);
    return b;
}
__device__ __forceinline__ void xcd_barrier_complete(unsigned* bar, unsigned x, unsigned& nloc, unsigned& nx) {
    const unsigned G = gridDim.x * gridDim.y * gridDim.z;
    unsigned sum, cnt, mine, sp = 0u;
    for (;;) {
        sum = 0u; cnt = 0u; mine = 0u;
#pragma unroll
        for (unsigned j = 0; j < 16; ++j) { const unsigned c = xb_ld(&bar[XB_XCNT(j)]); sum += c; cnt += (c > 0u) ? 1u : 0u; }
        mine = xb_ld(&bar[XB_XCNT(x)]);
        if (sum == G) break;
        __builtin_amdgcn_s_sleep(1);
        if ((++sp & 255u) == 0u) { if (xb_ld(&bar[XB_TMO])) break; if (sp > XB_SPIN_CAP) { atomicAdd(&bar[XB_TMO], 1u); break; } }
    }
    nloc = mine > 0u ? mine : 1u; nx = cnt > 0u ? cnt : 1u;
}
__device__ __forceinline__ void xcd_barrier(const XcdBarrier& b) {
    asm volatile("s_waitcnt vmcnt(0)" ::: "memory");
    __syncthreads();
    if (threadIdx.x == 0) {
        unsigned* bar = b.bar;
        __builtin_amdgcn_s_waitcnt(0);
        unsigned nloc = b.st[0], nx = b.st[1];
        if (nloc == 0u) { xcd_barrier_complete(bar, b.x, nloc, nx); b.st[0] = nloc; b.st[1] = nx; }
        const unsigned old = xb_add(&bar[XB_XSUB(b.x)], 1u);
        const unsigned gen = old / nloc;
        if (old + 1u == (gen + 1u) * nloc) {
            __builtin_amdgcn_fence(__ATOMIC_RELEASE, "agent");
            asm volatile("s_waitcnt vmcnt(0)" ::: "memory");
            const unsigned og = xb_add(&bar[XB_TOP], 1u);
            const unsigned tg = og / nx;
            if (og + 1u == (tg + 1u) * nx) xb_add(&bar[XB_TOPGEN], 1u);
            else XB_SPIN(xb_ld(&bar[XB_TOPGEN]) == tg, bar);
            __builtin_amdgcn_fence(__ATOMIC_ACQUIRE, "agent");
            xb_add(&bar[XB_XGEN(b.x)], 1u);
            asm volatile("s_waitcnt vmcnt(0)" ::: "memory");
        } else {
            XB_SPIN(xb_ld(&bar[XB_XGEN(b.x)]) == gen, bar);
            __builtin_amdgcn_fence(__ATOMIC_ACQUIRE, "agent");
            asm volatile("s_waitcnt vmcnt(0)" ::: "memory");
        }
    }
    __syncthreads();
}

constexpr int RP = 528;
constexpr int VP = 272;
DI unsigned lds_addr(LAS unsigned char* p) { return (unsigned)(unsigned long)p; }
template <int BASE, int ST, int SF>
DI void tr_frag4(unsigned a, bf16x8 (&f)[4]) {
    s16x4 o[8];
    tr8<BASE, BASE + ST, BASE + SF, BASE + SF + ST, BASE + 2 * SF, BASE + 2 * SF + ST, BASE + 3 * SF, BASE + 3 * SF + ST>(a, o);
    f[0] = cat8(o[0], o[1]); f[1] = cat8(o[2], o[3]); f[2] = cat8(o[4], o[5]); f[3] = cat8(o[6], o[7]);
}

DI void transpose_item(const float* __restrict__ W, int K, int N, bf16* __restrict__ WT, LAS float* scr, int item, int lane, const float* __restrict__ gain = nullptr) {
    const int nblk = N >> 6, kb = item / nblk, nb = item - kb * nblk, k0 = kb * 64, n0 = nb * 64;
    const int lr = lane >> 4, lc = (lane & 15) * 4;
    f32x4 v[16];
#pragma unroll
    for (int i = 0; i < 16; ++i) v[i] = *(const f32x4*)(W + (size_t)(k0 + 4 * i + lr) * N + n0 + lc);
#pragma unroll
    for (int i = 0; i < 16; ++i) { LAS float* s = scr + (4 * i + lr) * 65 + lc; const float gn = gain ? gain[k0 + 4 * i + lr] : 1.0f;
        s[0] = v[i][0] * gn; s[1] = v[i][1] * gn; s[2] = v[i][2] * gn; s[3] = v[i][3] * gn; }
    asm volatile("s_waitcnt lgkmcnt(0)" ::: "memory");
    const int c = lane & 7;
#pragma unroll
    for (int j = 0; j < 8; ++j) { const int n = (lane >> 3) + 8 * j; const LAS float* s = scr + (8 * c) * 65 + n;
        u32x4 o; o.x = cvt_pk_bf16(s[0], s[65]); o.y = cvt_pk_bf16(s[130], s[195]); o.z = cvt_pk_bf16(s[260], s[325]); o.w = cvt_pk_bf16(s[390], s[455]);
        *(u32x4*)(WT + (size_t)(n0 + n) * K + k0 + 8 * c) = o; }
    asm volatile("s_waitcnt lgkmcnt(0)" ::: "memory");
}
struct CItem { const float* W; bf16* WT; const float* gain; int K, N, item; };
DI void citem_load(const CItem& t, f32x4 (&v)[8], int tid) {
    const int nblk = t.N >> 7, kb = t.item / nblk, nb = t.item - kb * nblk;
    const float* p = t.W + (size_t)(128 * kb + (tid >> 5)) * t.N + 128 * nb + (tid & 31) * 4;
#pragma unroll
    for (int i = 0; i < 8; ++i) v[i] = __builtin_nontemporal_load((const f32x4*)(p + (size_t)(16 * i) * t.N));
}
DI void citem_to_lds(const CItem& t, const f32x4 (&v)[8], LAS float* scr, int tid) {
    const int nblk = t.N >> 7, kb = t.item / nblk, k0 = 128 * kb;
#pragma unroll
    for (int i = 0; i < 8; ++i) { const int row = (tid >> 5) + 16 * i; LAS float* s = scr + row * 129 + (tid & 31) * 4; const float gn = t.gain ? t.gain[k0 + row] : 1.0f;
        s[0] = v[i][0] * gn; s[1] = v[i][1] * gn; s[2] = v[i][2] * gn; s[3] = v[i][3] * gn; }
}
DI void citem_store(const CItem& t, const LAS float* scr, int tid) {
    const int nblk = t.N >> 7, kb = t.item / nblk, nb = t.item - kb * nblk, k0 = 128 * kb, n0 = 128 * nb;
    const int c = tid & 15;
#pragma unroll
    for (int j = 0; j < 4; ++j) { const int n = (tid >> 4) + 32 * j; const LAS float* s = scr + (8 * c) * 129 + n;
        u32x4 o; o.x = cvt_pk_bf16(s[0], s[129]); o.y = cvt_pk_bf16(s[258], s[387]); o.z = cvt_pk_bf16(s[516], s[645]); o.w = cvt_pk_bf16(s[774], s[903]);
        *(u32x4*)(t.WT + (size_t)(n0 + n) * t.K + k0 + 8 * c) = o; }
}
DI void rms_row_bf16(const float* __restrict__ xrow, const float* __restrict__ w, bf16* __restrict__ orow, int lane) {
    const f32x4* xr = (const f32x4*)xrow + lane; const f32x4* wr = (const f32x4*)w + lane;
    f32x4 v[8]; float s = 0.f;
#pragma unroll
    for (int j = 0; j < 8; ++j) { v[j] = xr[64 * j]; s += (v[j][0] * v[j][0] + v[j][1] * v[j][1]) + (v[j][2] * v[j][2] + v[j][3] * v[j][3]); }
    const float rstd = 1.0f / sqrtf(wave_sum(s) * (1.0f / DM) + EPS);
    u32x2* o = (u32x2*)orow + lane;
#pragma unroll
    for (int j = 0; j < 8; ++j) o[64 * j] = pack4(v[j] * rstd * wr[64 * j]);
}
DI void row_to_xb(const float* __restrict__ xrow, bf16* __restrict__ orow, float* __restrict__ ssqrow, int ns, int lane, const float* __restrict__ part = nullptr, size_t pstride = 0, float* __restrict__ xw = nullptr) {
    const f32x4* xr = (const f32x4*)xrow + lane; f32x4 v[8]; float s = 0.f;
#pragma unroll
    for (int j = 0; j < 8; ++j) { v[j] = xr[64 * j];
        if (part) { for (int q = 0; q < 4; ++q) v[j] += ((const f32x4*)(part + q * pstride) + lane)[64 * j]; ((f32x4*)xw + lane)[64 * j] = v[j]; }
        s += (v[j][0] * v[j][0] + v[j][1] * v[j][1]) + (v[j][2] * v[j][2] + v[j][3] * v[j][3]); }
    s = wave_sum(s);
    u32x2* o = (u32x2*)orow + lane;
#pragma unroll
    for (int j = 0; j < 8; ++j) o[64 * j] = pack4(v[j]);
    if (lane < ns) ssqrow[lane] = lane == 0 ? s : 0.f;
}
DI void load_row_bf16(const bf16* __restrict__ xrow, f32x4 (&v)[8], int lane, const float* __restrict__ part, size_t pstride) {
    const u32x2* xr = (const u32x2*)xrow + lane;
#pragma unroll
    for (int j = 0; j < 8; ++j) { v[j] = unpack4(xr[64 * j]);
        if (part) { for (int q = 0; q < 4; ++q) v[j] += ((const f32x4*)(part + q * pstride) + lane)[64 * j]; } }
}
DI void row_fin_bf16(const bf16* __restrict__ xrow, bf16* __restrict__ orow, float* __restrict__ ssqrow, int lane, const float* __restrict__ part, size_t pstride) {
    f32x4 v[8]; load_row_bf16(xrow, v, lane, part, pstride); float s = 0.f;
#pragma unroll
    for (int j = 0; j < 8; ++j) s += (v[j][0] * v[j][0] + v[j][1] * v[j][1]) + (v[j][2] * v[j][2] + v[j][3] * v[j][3]);
    s = wave_sum(s);
    u32x2* o = (u32x2*)orow + lane;
#pragma unroll
    for (int j = 0; j < 8; ++j) o[64 * j] = pack4(v[j]);
    ssqrow[lane] = lane == 0 ? s : 0.f;
}
DI void rms_row_f32_b(const bf16* __restrict__ xrow, const float* __restrict__ w, float* __restrict__ orow, int lane, const float* __restrict__ part = nullptr, size_t pstride = 0) {
    f32x4 v[8]; load_row_bf16(xrow, v, lane, part, pstride); float s = 0.f; const f32x4* wr = (const f32x4*)w + lane;
#pragma unroll
    for (int j = 0; j < 8; ++j) s += (v[j][0] * v[j][0] + v[j][1] * v[j][1]) + (v[j][2] * v[j][2] + v[j][3] * v[j][3]);
    const float rstd = 1.0f / sqrtf(wave_sum(s) * (1.0f / DM) + EPS);
    f32x4* o = (f32x4*)orow + lane;
#pragma unroll
    for (int j = 0; j < 8; ++j) o[64 * j] = v[j] * rstd * wr[64 * j];
}
DI u32x4 pair16(u32x2 a, u32x2 b, bool odd) {
    const u32x2 send = odd ? a : b; u32x2 recv;
    recv.x = (unsigned)__shfl_xor((int)send.x, 16); recv.y = (unsigned)__shfl_xor((int)send.y, 16);
    return odd ? (u32x4){recv.x, recv.y, b.x, b.y} : (u32x4){a.x, a.y, recv.x, recv.y};
}
template <int KS, int NG>
DI void kvt_sub(unsigned aV, const bf16x8 af, f32x4 (&acc)[16]) {
    bf16x8 bf[4]; tr_frag4<(32 * KS) * RP + NG * 128, 4 * RP, 32>(aV, bf);
#pragma unroll
    for (int f = 0; f < 4; ++f) acc[4 * NG + f] = MFMA16(af, bf[f], acc[4 * NG + f]);
}
DI void kvt_unit(LAS unsigned char* big, const bf16* __restrict__ Z, const bf16* __restrict__ KD, bf16* __restrict__ KVT, int bh, int c, int tid, int wid, int lane) {
    const int b = bh >> 2, h = bh & 3, r0 = b * SEQ + c * 128;
    LAS unsigned char* Vs = big; LAS unsigned char* Ks = big + 128 * RP;
    const float l2g = lg2gamma(h);
#pragma unroll
    for (int i = 0; i < 8; ++i) { const int id = tid + 512 * i, row = id >> 5, ch = id & 31;
        const u32x4 v = *(const u32x4*)(Z + (size_t)(r0 + row) * DIN + 2048 + h * 256 + ch * 8);
        const u32x4 k = *(const u32x4*)(Z + (size_t)(r0 + row) * DIN + 1024 + h * 256 + ch * 8);
        const float dk = exp2f(l2g * (float)(127 - row));
        const f32x4 k0 = unpack4((u32x2){k.x, k.y}) * dk, k1 = unpack4((u32x2){k.z, k.w}) * dk;
        *(LAS u32x4*)(Vs + row * RP + ch * 16) = v; *(LAS u32x4*)(Ks + row * RP + ch * 16) = pack8(k0, k1); }
    __syncthreads();
    const int g = lane >> 4, q = (lane >> 2) & 3, p = lane & 3;
    const unsigned aV = lds_addr(Vs) + (8 * g + q) * RP + 8 * p;
    bf16* o = KVT + ((size_t)(bh * 16 + c) * 256) * 256;
    for (int mb = 0; mb < 2; ++mb) {
        const unsigned aK = lds_addr(Ks) + (8 * g + q) * RP + (32 * wid + 16 * mb + 4 * p) * 2;
        bf16x8 af[4]; tr_frag4<0, 4 * RP, 32 * RP>(aK, af);
        f32x4 acc[16];
#pragma unroll
        for (int n = 0; n < 16; ++n) acc[n] = (f32x4){0.f, 0.f, 0.f, 0.f};
        kvt_sub<0, 0>(aV, af[0], acc); kvt_sub<0, 1>(aV, af[0], acc); kvt_sub<0, 2>(aV, af[0], acc); kvt_sub<0, 3>(aV, af[0], acc);
        kvt_sub<1, 0>(aV, af[1], acc); kvt_sub<1, 1>(aV, af[1], acc); kvt_sub<1, 2>(aV, af[1], acc); kvt_sub<1, 3>(aV, af[1], acc);
        kvt_sub<2, 0>(aV, af[2], acc); kvt_sub<2, 1>(aV, af[2], acc); kvt_sub<2, 2>(aV, af[2], acc); kvt_sub<2, 3>(aV, af[2], acc);
        kvt_sub<3, 0>(aV, af[3], acc); kvt_sub<3, 1>(aV, af[3], acc); kvt_sub<3, 2>(aV, af[3], acc); kvt_sub<3, 3>(aV, af[3], acc);
#pragma unroll
        for (int nb = 0; nb < 16; nb += 2) { const bool odd = (g & 1) != 0; const u32x4 w = pair16(pack4(acc[nb]), pack4(acc[nb + 1]), odd);
            *(u32x4*)(o + (size_t)(16 * (nb + (odd ? 1 : 0)) + (lane & 15)) * 256 + 32 * wid + 16 * mb + 4 * (g & 2)) = w; }
    }
    __syncthreads();
}

DI void sret_unit(LAS unsigned char* big, const bf16* __restrict__ Z, const float* __restrict__ S0, float* __restrict__ Sout, const float* __restrict__ rnw, bf16* __restrict__ CAT,
                  int b, int h, int tid, int wid, int lane) {
    LAS float* qs = (LAS float*)big; LAS float* ks_ = qs + 1024; LAS float* vs = qs + 2048; LAS float* sc = qs + 3072; LAS float* red = qs + 3136;
    const int rs = MP + 4 * b; const float l2g = lg2gamma(h);
#pragma unroll
    for (int i = 0; i < 6; ++i) { const int id = tid + 512 * i, which = id >> 10, t = (id >> 8) & 3, d = id & 255;
        qs[id] = bf2f(Z[(size_t)(rs + t) * DIN + which * 1024 + h * 256 + d]); }
    __syncthreads();
#pragma unroll
    for (int pp = 0; pp < 2; ++pp) { const int pi = 2 * wid + pp, i = pi >> 2, j = pi & 3; float s = 0.f;
#pragma unroll
        for (int m = 0; m < 4; ++m) s += qs[i * 256 + lane + 64 * m] * ks_[j * 256 + lane + 64 * m];
        s = wave_sum(s); if (lane == 0) sc[pi] = (i >= j) ? s * exp2f(l2g * (float)(i - j)) : 0.f; }
    const float g4 = exp2f(l2g * 4.0f), gk0 = exp2f(l2g * 3.0f), gk1 = exp2f(l2g * 2.0f), gk2 = exp2f(l2g), gk3 = 1.0f;
    const size_t sbase = ((size_t)(b * 4 + h)) * 65536 + 4 * lane;
    f32x4 vv[4];
#pragma unroll
    for (int j = 0; j < 4; ++j) vv[j] = *(LAS f32x4*)(vs + j * 256 + 4 * lane);
    f32x4 oi[4];
#pragma unroll
    for (int i = 0; i < 4; ++i) oi[i] = (f32x4){0.f, 0.f, 0.f, 0.f};
    float ql[4], kl[4];
    { const int dl = wid + 8 * (lane & 31);
      ql[0] = qs[dl]; ql[1] = qs[256 + dl]; ql[2] = qs[512 + dl]; ql[3] = qs[768 + dl];
      kl[0] = ks_[dl] * gk0; kl[1] = ks_[256 + dl] * gk1; kl[2] = ks_[512 + dl] * gk2; kl[3] = ks_[768 + dl] * gk3; }
#pragma unroll
    for (int rb = 0; rb < 2; ++rb) {
        f32x4 sv[16];
#pragma unroll
        for (int r8 = 0; r8 < 16; ++r8) sv[r8] = __builtin_nontemporal_load((const f32x4*)(S0 + sbase + (size_t)(wid + 8 * (16 * rb + r8)) * 256));
#pragma unroll
        for (int r8 = 0; r8 < 16; ++r8) { const int r = 16 * rb + r8; const f32x4 s = sv[r8];
            const float fq0 = __int_as_float(__builtin_amdgcn_readlane(__float_as_int(ql[0]), r)), fq1 = __int_as_float(__builtin_amdgcn_readlane(__float_as_int(ql[1]), r));
            const float fq2 = __int_as_float(__builtin_amdgcn_readlane(__float_as_int(ql[2]), r)), fq3 = __int_as_float(__builtin_amdgcn_readlane(__float_as_int(ql[3]), r));
            const float fk0 = __int_as_float(__builtin_amdgcn_readlane(__float_as_int(kl[0]), r)), fk1 = __int_as_float(__builtin_amdgcn_readlane(__float_as_int(kl[1]), r));
            const float fk2 = __int_as_float(__builtin_amdgcn_readlane(__float_as_int(kl[2]), r)), fk3 = __int_as_float(__builtin_amdgcn_readlane(__float_as_int(kl[3]), r));
            oi[0] += s * fq0; oi[1] += s * fq1; oi[2] += s * fq2; oi[3] += s * fq3;
            const f32x4 sn = s * g4 + vv[0] * fk0 + vv[1] * fk1 + vv[2] * fk2 + vv[3] * fk3;
            __builtin_nontemporal_store(sn, (f32x4*)(Sout + sbase + (size_t)(wid + 8 * r) * 256)); }
    }
#pragma unroll
    for (int i = 0; i < 4; ++i) *(LAS f32x4*)(red + (wid * 4 + i) * 256 + 4 * lane) = oi[i];
    __syncthreads();
    if (wid < 4) { const int i = wid; f32x4 o = (f32x4){0.f, 0.f, 0.f, 0.f};
#pragma unroll
        for (int w = 0; w < 8; ++w) o += *(LAS f32x4*)(red + (w * 4 + i) * 256 + 4 * lane);
        o = o * exp2f(l2g * (float)(i + 1));
#pragma unroll
        for (int j = 0; j < 4; ++j) if (j <= i) o += vv[j] * sc[i * 4 + j];
        const float ss = wave_sum((o[0] * o[0] + o[1] * o[1]) + (o[2] * o[2] + o[3] * o[3]));
        const float rstd = 1.0f / sqrtf(ss * (1.0f / 256.0f) + EPS);
        const f32x4 w4 = *(const f32x4*)(rnw + h * 256 + 4 * lane);
        const f32x4 gt = unpack4(*(const u32x2*)(Z + (size_t)(rs + i) * DIN + 3072 + h * 256 + 4 * lane));
        f32x4 r;
#pragma unroll
        for (int e = 0; e < 4; ++e) r[e] = o[e] * rstd * w4[e] * (gt[e] / (1.0f + __expf(-gt[e])));
        *(u32x2*)(CAT + (size_t)(rs + i) * DM + h * 256 + 4 * lane) = pack4(r); }
    __syncthreads();
}

DI void pooled_items(const bf16* __restrict__ Z, const float* __restrict__ spool, bf16* __restrict__ PL, float* __restrict__ pbs, int gw, int NGW, int lane) {
    for (int it = gw; it < MT * 2; it += NGW) {
        const int row = it >> 1, col = (it & 1) * 512 + lane * 8, w = 2 << (col >> 8);
        float s[8], u0[8];
#pragma unroll
        for (int e = 0; e < 8; ++e) { s[e] = 0.f; u0[e] = 0.f; }
        float inv;
        if (row < MP) {
            const int t = row & (SEQ - 1), n = (t + 1 < w) ? t + 1 : w; inv = 1.0f / (float)n;
#pragma unroll
            for (int k = 0; k < 16; ++k) if (k < n) { const u32x4 v = *(const u32x4*)(Z + (size_t)(row - k) * DIN + 4096 + col);
                const f32x4 a = unpack4((u32x2){v.x, v.y}), c = unpack4((u32x2){v.z, v.w});
#pragma unroll
                for (int e = 0; e < 4; ++e) { s[e] += a[e]; s[4 + e] += c[e]; if (k == 0) { u0[e] = a[e]; u0[4 + e] = c[e]; } } }
        } else {
            const int rr = row - MP, b = rr >> 2, t = rr & 3; inv = 1.0f / (float)w;
#pragma unroll
            for (int k = 0; k < 16; ++k) if (k < w) { const int idx = 15 + t - k; f32x4 a, c;
                if (idx >= 15) { const u32x4 v = *(const u32x4*)(Z + (size_t)(MP + 4 * b + idx - 15) * DIN + 4096 + col); a = unpack4((u32x2){v.x, v.y}); c = unpack4((u32x2){v.z, v.w}); }
                else { const float* sp = spool + ((size_t)b * 15 + idx) * DPOOL + col; a = *(const f32x4*)sp; c = *(const f32x4*)(sp + 4); }
#pragma unroll
                for (int e = 0; e < 4; ++e) { s[e] += a[e]; s[4 + e] += c[e]; if (k == 0) { u0[e] = a[e]; u0[4 + e] = c[e]; } } }
        }
        f32x4 o0, o1;
#pragma unroll
        for (int e = 0; e < 4; ++e) { o0[e] = s[e] * inv - u0[e]; o1[e] = s[4 + e] * inv - u0[4 + e]; }
        *(u32x4*)(PL + (size_t)row * DPOOL + col) = pack8(o0, o1);
    }
    for (int it = gw; it < DECB * 11; it += NGW) { const int b = it / 11, r = it - b * 11;
        const f32x4* src = (const f32x4*)(spool + ((size_t)b * 15 + r + 4) * DPOOL) + lane; f32x4* dst = (f32x4*)(pbs + ((size_t)b * 15 + r) * DPOOL) + lane;
#pragma unroll
        for (int j = 0; j < 4; ++j) dst[64 * j] = src[64 * j]; }
}

DI void scan_items(const bf16* __restrict__ KVT, bf16* __restrict__ ST, float* __restrict__ rsp  , int gt, int NGT) {
    for (int it = gt; it < 16 * 8192; it += NGT) {
        const int bh = it >> 13, q8 = it & 8191; const float g128 = exp2f(lg2gamma(bh & 3) * 128.0f);
        f32x4 S0 = (f32x4){0.f, 0.f, 0.f, 0.f}, S1 = (f32x4){0.f, 0.f, 0.f, 0.f};
        u32x4 kv[16];
#pragma unroll
        for (int c = 0; c < 16; ++c) kv[c] = *(const u32x4*)(KVT + ((size_t)(bh * 16 + c) * 8192 + q8) * 8);
#pragma unroll
        for (int c = 0; c < 16; ++c) { S0 = S0 * g128 + unpack4((u32x2){kv[c].x, kv[c].y}); S1 = S1 * g128 + unpack4((u32x2){kv[c].z, kv[c].w});
            if (c < 15) *(u32x4*)(ST + ((size_t)(bh * 16 + c) * 8192 + q8) * 8) = pack8(S0, S1); }
        const int dv = q8 >> 5, dk = (q8 & 31) * 8;
        float* o = rsp + (size_t)bh * 65536 + (size_t)dk * 256 + dv;
        o[0] = S0[0]; o[256] = S0[1]; o[512] = S0[2]; o[768] = S0[3]; o[1024] = S1[0]; o[1280] = S1[1]; o[1536] = S1[2]; o[1792] = S1[3];
    }
}

template <int KS2, int NG>
DI void ret2_pv(unsigned aV, const bf16x8 pf, f32x4 (&oacc)[16]) {
    bf16x8 vf[4]; tr_frag4<(32 * KS2) * RP + NG * 128, 16 * RP, 32>(aV, vf);
#pragma unroll
    for (int f = 0; f < 4; ++f) oacc[4 * NG + f] = MFMA16(vf[f], pf, oacc[4 * NG + f]);
}
template <int KS2, int MG>
DI void xat_pv(unsigned aV, const bf16x8 pf, f32x4 (&oacc)[8]) {
    bf16x8 vf[4]; tr_frag4<(32 * KS2) * VP + MG * 128, 16 * VP, 32>(aV, vf);
#pragma unroll
    for (int f = 0; f < 4; ++f) oacc[4 * MG + f] = MFMA16(vf[f], pf, oacc[4 * MG + f]);
}
template <int PPR> DI void chunk_ld(u32x4 (&r)[8], const bf16* __restrict__ src, size_t src_pitch, int tid) {
    const bf16* p = src + (size_t)(tid / PPR) * src_pitch + (tid % PPR) * 8;
#pragma unroll
    for (int i = 0; i < 8; ++i) r[i] = *(const u32x4*)(p + (size_t)i * (512 / PPR) * src_pitch);
}
template <int PPR, int PITCH> DI void chunk_st(LAS unsigned char* dst, const u32x4 (&r)[8], int tid) {
    LAS unsigned char* d = dst + (tid / PPR) * PITCH + (tid % PPR) * 16;
#pragma unroll
    for (int i = 0; i < 8; ++i) *(LAS u32x4*)(d + i * (512 / PPR) * PITCH) = r[i];
}
constexpr int KP = 1040;
constexpr int XBUF = 69632;

DI void xattn_p_unit2(LAS unsigned char* big, const bf16* __restrict__ Q2, const bf16* __restrict__ MKB, const bf16* __restrict__ MVB, bf16* __restrict__ ATT, int b, int h, int qt, int tid, int wid, int lane) {
    const int g = lane >> 4, li = lane & 15, q = (lane >> 2) & 3, p = lane & 3;
    const int myrow = b * SEQ + qt * 128 + 16 * wid + li;
    LAS unsigned char* buf0 = big; LAS unsigned char* buf1 = big + XBUF;
    const bf16* kbase = MKB + (size_t)(b * NMEM) * DM + h * 512;
    const bf16* vbase = MVB + (size_t)(b * NMEM) * DM + h * 512;
    u32x4 r[8];
    chunk_ld<64>(r, kbase, DM, tid);
    bf16x8 qf[16];
#pragma unroll
    for (int ks = 0; ks < 16; ++ks) qf[ks] = *(const bf16x8*)(Q2 + (size_t)myrow * DM + h * 512 + 32 * ks + 8 * g);
    chunk_st<64, KP>(buf0, r, tid);
    __syncthreads();
    f32x4 sacc[16];
#pragma unroll
    for (int c = 0; c < 4; ++c) {
        if (c < 3) chunk_ld<64>(r, kbase + (size_t)(64 * (c + 1)) * DM, DM, tid);
        else chunk_ld<16>(r, vbase, DM, tid);
        const LAS unsigned char* cur = (c & 1) ? buf1 : buf0;
#pragma unroll
        for (int j = 0; j < 4; ++j) { const int nb = 4 * c + j; sacc[nb] = (f32x4){0.f, 0.f, 0.f, 0.f};
#pragma unroll
            for (int ks = 0; ks < 16; ++ks) sacc[nb] = MFMA16(*(const LAS bf16x8*)(cur + (16 * j + li) * KP + (32 * ks + 8 * g) * 2), qf[ks], sacc[nb]);
            __builtin_amdgcn_sched_barrier(0); }
        if (c < 3) { chunk_st<64, KP>((c & 1) ? buf0 : buf1, r, tid); __syncthreads(); }
    }
    float mx = -3.0e38f;
#pragma unroll
    for (int nb = 0; nb < 16; ++nb) mx = fmaxf(mx, fmaxf(fmaxf(sacc[nb][0], sacc[nb][1]), fmaxf(sacc[nb][2], sacc[nb][3])));
    mx = fmaxf(mx, __shfl_xor(mx, 16)); mx = fmaxf(mx, __shfl_xor(mx, 32));
    float sum = 0.f;
#pragma unroll
    for (int nb = 0; nb < 16; ++nb)
#pragma unroll
        for (int e = 0; e < 4; ++e) { const float pe = exp2f((sacc[nb][e] - mx) * 1.44269504089f); sacc[nb][e] = pe; sum += pe; }
    sum += __shfl_xor(sum, 16); sum += __shfl_xor(sum, 32);
    const float inv = 1.0f / sum;
    bf16x8 pf[8];
#pragma unroll
    for (int ks2 = 0; ks2 < 8; ++ks2) { u32x4 w; const f32x4 a = sacc[2 * ks2] * inv, c = sacc[2 * ks2 + 1] * inv;
        w.x = cvt_pk_bf16(a[0], a[1]); w.y = cvt_pk_bf16(a[2], a[3]); w.z = cvt_pk_bf16(c[0], c[1]); w.w = cvt_pk_bf16(c[2], c[3]); pf[ks2] = __builtin_bit_cast(bf16x8, w); }
    __syncthreads();
    chunk_st<16, VP>(buf0, r, tid);
    __syncthreads();
    for (int dq = 0; dq < 4; ++dq) {
        if (dq < 3) chunk_ld<16>(r, vbase + (dq + 1) * 128, DM, tid);
        const unsigned aV = lds_addr((dq & 1) ? buf1 : buf0) + (4 * g + q) * VP + 8 * p;
        f32x4 oacc[8];
#pragma unroll
        for (int mb = 0; mb < 8; ++mb) oacc[mb] = (f32x4){0.f, 0.f, 0.f, 0.f};
        xat_pv<0, 0>(aV, pf[0], oacc); xat_pv<0, 1>(aV, pf[0], oacc); xat_pv<1, 0>(aV, pf[1], oacc); xat_pv<1, 1>(aV, pf[1], oacc);
        xat_pv<2, 0>(aV, pf[2], oacc); xat_pv<2, 1>(aV, pf[2], oacc); xat_pv<3, 0>(aV, pf[3], oacc); xat_pv<3, 1>(aV, pf[3], oacc);
        xat_pv<4, 0>(aV, pf[4], oacc); xat_pv<4, 1>(aV, pf[4], oacc); xat_pv<5, 0>(aV, pf[5], oacc); xat_pv<5, 1>(aV, pf[5], oacc);
        xat_pv<6, 0>(aV, pf[6], oacc); xat_pv<6, 1>(aV, pf[6], oacc); xat_pv<7, 0>(aV, pf[7], oacc); xat_pv<7, 1>(aV, pf[7], oacc);
#pragma unroll
        for (int mb = 0; mb < 8; mb += 2) { const bool odd = (g & 1) != 0; const u32x4 w = pair16(pack4(oacc[mb]), pack4(oacc[mb + 1]), odd);
            *(u32x4*)(ATT + (size_t)myrow * DM + h * 512 + dq * 128 + 16 * (mb + (odd ? 1 : 0)) + 4 * (g & 2)) = w; }
        if (dq < 3) chunk_st<16, VP>((dq & 1) ? buf0 : buf1, r, tid);
        __syncthreads();
    }
}

DI void ret2_unit2(LAS unsigned char* big, const bf16* __restrict__ Z, const bf16* __restrict__ ST, const float* __restrict__ rnw, bf16* __restrict__ CAT, int bh, int c, int tid, int wid, int lane) {
    const int b = bh >> 2, h = bh & 3, r0 = b * SEQ + c * 128;
    const int g = lane >> 4, li = lane & 15, q = (lane >> 2) & 3, p = lane & 3;
    LAS unsigned char* buf0 = big; LAS unsigned char* buf1 = big + 128 * RP;
    const bf16* kbase = Z + (size_t)r0 * DIN + 1024 + h * 256;
    const bf16* vbase = Z + (size_t)r0 * DIN + 2048 + h * 256;
    const bf16* sbase = ST + ((size_t)(bh * 16 + (c > 0 ? c - 1 : 0)) * 256) * 256;
    const int myrow = r0 + 16 * wid + li;
    u32x4 r[8];
    chunk_ld<32>(r, kbase, DIN, tid);
    bf16x8 qf[8];
#pragma unroll
    for (int ks = 0; ks < 8; ++ks) qf[ks] = *(const bf16x8*)(Z + (size_t)myrow * DIN + h * 256 + 32 * ks + 8 * g);
    chunk_st<32, RP>(buf0, r, tid);
    __syncthreads();
    if (c > 0) chunk_ld<32>(r, sbase, 256, tid); else chunk_ld<32>(r, vbase, DIN, tid);
    f32x4 sacc[8];
#pragma unroll
    for (int jb = 0; jb < 8; ++jb) { sacc[jb] = (f32x4){0.f, 0.f, 0.f, 0.f};
        if (jb <= wid) {
#pragma unroll
            for (int ks = 0; ks < 8; ++ks) sacc[jb] = MFMA16(*(const LAS bf16x8*)(buf0 + (16 * jb + li) * RP + (32 * ks + 8 * g) * 2), qf[ks], sacc[jb]); }
        __builtin_amdgcn_sched_barrier(0); }
    const float l2g = lg2gamma(h); const int i = 16 * wid + li;
    bf16x8 pf[4];
#pragma unroll
    for (int ks2 = 0; ks2 < 4; ++ks2) { u32x4 w;
#pragma unroll
        for (int hf = 0; hf < 2; ++hf) { const int jb = 2 * ks2 + hf; float d[4];
#pragma unroll
            for (int e = 0; e < 4; ++e) { const int j = 16 * jb + 4 * g + e; d[e] = (i >= j) ? sacc[jb][e] * exp2f(l2g * (float)(i - j)) : 0.f; }
            w[2 * hf] = cvt_pk_bf16(d[0], d[1]); w[2 * hf + 1] = cvt_pk_bf16(d[2], d[3]); }
        pf[ks2] = __builtin_bit_cast(bf16x8, w); }
    chunk_st<32, RP>(buf1, r, tid);
    __syncthreads();
    f32x4 oacc[16];
#pragma unroll
    for (int nb = 0; nb < 16; ++nb) oacc[nb] = (f32x4){0.f, 0.f, 0.f, 0.f};
    if (c > 0) {
        chunk_ld<32>(r, sbase + (size_t)128 * 256, 256, tid);
#pragma unroll
        for (int nb = 0; nb < 8; ++nb) {
#pragma unroll
            for (int ks = 0; ks < 8; ++ks) oacc[nb] = MFMA16(*(const LAS bf16x8*)(buf1 + (16 * nb + li) * RP + (32 * ks + 8 * g) * 2), qf[ks], oacc[nb]);
            __builtin_amdgcn_sched_barrier(0); }
        chunk_st<32, RP>(buf0, r, tid);
        __syncthreads();
        chunk_ld<32>(r, vbase, DIN, tid);
#pragma unroll
        for (int nb = 0; nb < 8; ++nb) {
#pragma unroll
            for (int ks = 0; ks < 8; ++ks) oacc[8 + nb] = MFMA16(*(const LAS bf16x8*)(buf0 + (16 * nb + li) * RP + (32 * ks + 8 * g) * 2), qf[ks], oacc[8 + nb]);
            __builtin_amdgcn_sched_barrier(0); }
        const float dq = exp2f(l2g * (float)(i + 1));
#pragma unroll
        for (int nb = 0; nb < 16; ++nb) oacc[nb] = oacc[nb] * dq;
        chunk_st<32, RP>(buf1, r, tid);
        __syncthreads();
    }
    const unsigned aV = lds_addr(buf1) + (4 * g + q) * RP + 8 * p;
    { ret2_pv<0, 0>(aV, pf[0], oacc); ret2_pv<0, 1>(aV, pf[0], oacc); ret2_pv<0, 2>(aV, pf[0], oacc); ret2_pv<0, 3>(aV, pf[0], oacc); }
    if (wid >= 2) { ret2_pv<1, 0>(aV, pf[1], oacc); ret2_pv<1, 1>(aV, pf[1], oacc); ret2_pv<1, 2>(aV, pf[1], oacc); ret2_pv<1, 3>(aV, pf[1], oacc); }
    if (wid >= 4) { ret2_pv<2, 0>(aV, pf[2], oacc); ret2_pv<2, 1>(aV, pf[2], oacc); ret2_pv<2, 2>(aV, pf[2], oacc); ret2_pv<2, 3>(aV, pf[2], oacc); }
    if (wid >= 6) { ret2_pv<3, 0>(aV, pf[3], oacc); ret2_pv<3, 1>(aV, pf[3], oacc); ret2_pv<3, 2>(aV, pf[3], oacc); ret2_pv<3, 3>(aV, pf[3], oacc); }
    float ss = 0.f;
#pragma unroll
    for (int nb = 0; nb < 16; ++nb) ss += (oacc[nb][0] * oacc[nb][0] + oacc[nb][1] * oacc[nb][1]) + (oacc[nb][2] * oacc[nb][2] + oacc[nb][3] * oacc[nb][3]);
    ss += __shfl_xor(ss, 16); ss += __shfl_xor(ss, 32);
    const float rstd = 1.0f / sqrtf(ss * (1.0f / 256.0f) + EPS);
#pragma unroll
    for (int nb = 0; nb < 16; nb += 2) { u32x2 pk[2];
#pragma unroll
        for (int q2 = 0; q2 < 2; ++q2) { const int dv = h * 256 + 16 * (nb + q2) + 4 * g;
            const f32x4 w4 = *(const f32x4*)(rnw + dv); const f32x4 gt = unpack4(*(const u32x2*)(Z + (size_t)myrow * DIN + 3072 + dv));
            f32x4 rr;
#pragma unroll
            for (int e = 0; e < 4; ++e) rr[e] = oacc[nb + q2][e] * rstd * w4[e] * (gt[e] / (1.0f + __expf(-gt[e])));
            pk[q2] = pack4(rr); }
        const bool odd = (g & 1) != 0; const u32x4 w = pair16(pk[0], pk[1], odd);
        *(u32x4*)(CAT + (size_t)myrow * DM + h * 256 + 16 * (nb + (odd ? 1 : 0)) + 4 * (g & 2)) = w; }
    __syncthreads();
}

DI void xs_scores(const f32x4 (&x)[16], const f32x4 (&qa)[4], const f32x4 (&qb)[4], LAS float* sc, int keybase, int lane) {
    float v[32];
#pragma unroll
    for (int j = 0; j < 8; ++j)
#pragma unroll
        for (int t = 0; t < 4; ++t) { const f32x4 m = x[2 * j] * qa[t] + x[2 * j + 1] * qb[t]; v[4 * j + t] = (m[0] + m[1]) + (m[2] + m[3]); }
    const bool h32 = (lane & 32) != 0, h16 = (lane & 16) != 0, h8 = (lane & 8) != 0, h4 = (lane & 4) != 0, h2 = (lane & 2) != 0;
#pragma unroll
    for (int i = 0; i < 16; ++i) { const float keep = h32 ? v[i + 16] : v[i], send = h32 ? v[i] : v[i + 16]; v[i] = keep + __shfl_xor(send, 32); }
#pragma unroll
    for (int i = 0; i < 8; ++i) { const float keep = h16 ? v[i + 8] : v[i], send = h16 ? v[i] : v[i + 8]; v[i] = keep + __shfl_xor(send, 16); }
#pragma unroll
    for (int i = 0; i < 4; ++i) { const float keep = h8 ? v[i + 4] : v[i], send = h8 ? v[i] : v[i + 4]; v[i] = keep + __shfl_xor(send, 8); }
#pragma unroll
    for (int i = 0; i < 2; ++i) { const float keep = h4 ? v[i + 2] : v[i], send = h4 ? v[i] : v[i + 2]; v[i] = keep + __shfl_xor(send, 4); }
    { const float keep = h2 ? v[1] : v[0], send = h2 ? v[0] : v[1]; v[0] = keep + __shfl_xor(send, 2); }
    v[0] += __shfl_xor(v[0], 1);
    const int idx = ((lane >> 5) & 1) * 16 + ((lane >> 4) & 1) * 8 + ((lane >> 3) & 1) * 4 + ((lane >> 2) & 1) * 2 + ((lane >> 1) & 1);
    if (!(lane & 1)) sc[(idx & 3) * 256 + keybase + (idx >> 2)] = v[0];
}
DI void xattn_s_unit(LAS unsigned char* big, const bf16* __restrict__ Q2, const float* __restrict__ Kc, const float* __restrict__ Vc, bf16* __restrict__ ATT, int b, int h, int tid, int wid, int lane) {
    LAS float* sc = (LAS float*)big; LAS float* red = sc + 1024;
    const int rs = MP + 4 * b;
    const float* ku = Kc + ((size_t)b * NMEM + 32 * wid) * DM + h * 512;
    const float* vu = Vc + ((size_t)b * NMEM + 32 * wid) * DM + h * 512;
    const unsigned vlo = (unsigned)(4 * lane);
    f32x4 xa[16], xb[16];
#define XS_LD(dst, base, bt) do { _Pragma("unroll") for (int j = 0; j < 8; ++j) { const float* vr_ = base + (8 * (bt) + j) * DM; \
        dst[2 * j] = __builtin_nontemporal_load((const f32x4*)(vr_ + vlo)); dst[2 * j + 1] = __builtin_nontemporal_load((const f32x4*)(vr_ + 256 + vlo)); } } while (0)
    XS_LD(xa, ku, 0);
    f32x4 qa[4], qb[4];
#pragma unroll
    for (int t = 0; t < 4; ++t) { const bf16* qp = Q2 + (size_t)(rs + t) * DM + h * 512 + 4 * lane; qa[t] = unpack4(*(const u32x2*)qp); qb[t] = unpack4(*(const u32x2*)(qp + 256)); }
    __syncthreads();
    XS_LD(xb, ku, 1); xs_scores(xa, qa, qb, sc, 32 * wid, lane); __builtin_amdgcn_sched_barrier(0);
    XS_LD(xa, ku, 2); xs_scores(xb, qa, qb, sc, 32 * wid + 8, lane); __builtin_amdgcn_sched_barrier(0);
    XS_LD(xb, ku, 3); xs_scores(xa, qa, qb, sc, 32 * wid + 16, lane); __builtin_amdgcn_sched_barrier(0);
    XS_LD(xa, vu, 0); xs_scores(xb, qa, qb, sc, 32 * wid + 24, lane); __builtin_amdgcn_sched_barrier(0);
    __syncthreads();
    if (wid < 4) { LAS f32x4* sp = (LAS f32x4*)(sc + wid * 256) + lane; f32x4 s = *sp;
        const float mx = wave_max(fmaxf(fmaxf(s[0], s[1]), fmaxf(s[2], s[3])));
#pragma unroll
        for (int e = 0; e < 4; ++e) s[e] = exp2f((s[e] - mx) * 1.44269504089f);
        const float inv = 1.0f / wave_sum((s[0] + s[1]) + (s[2] + s[3]));
        *sp = s * inv; }
    __syncthreads();
    f32x4 oa[4], ob[4];
#pragma unroll
    for (int t = 0; t < 4; ++t) { oa[t] = (f32x4){0.f, 0.f, 0.f, 0.f}; ob[t] = (f32x4){0.f, 0.f, 0.f, 0.f}; }
#define XS_PV(src, bt) do { _Pragma("unroll") for (int j = 0; j < 8; ++j) { _Pragma("unroll") for (int t = 0; t < 4; ++t) { const float pw = sc[t * 256 + 32 * wid + 8 * (bt) + j]; oa[t] += src[2 * j] * pw; ob[t] += src[2 * j + 1] * pw; } } \
        __builtin_amdgcn_sched_barrier(0); } while (0)
    XS_LD(xb, vu, 1); XS_PV(xa, 0);
    XS_LD(xa, vu, 2); XS_PV(xb, 1);
    XS_LD(xb, vu, 3); XS_PV(xa, 2);
    XS_PV(xb, 3);
#undef XS_LD
#undef XS_PV
#pragma unroll
    for (int t = 0; t < 4; ++t) { *(LAS f32x4*)(red + (wid * 4 + t) * 512 + 4 * lane) = oa[t]; *(LAS f32x4*)(red + (wid * 4 + t) * 512 + 256 + 4 * lane) = ob[t]; }
    __syncthreads();
    { const int t = tid >> 7, d4 = (tid & 127) * 4; f32x4 o = (f32x4){0.f, 0.f, 0.f, 0.f};
#pragma unroll
        for (int w = 0; w < 8; ++w) o += *(LAS f32x4*)(red + (w * 4 + t) * 512 + d4);
        *(u32x2*)(ATT + (size_t)(rs + t) * DM + h * 512 + d4) = pack4(o); }
    __syncthreads();
}

template <int PPR> DI void hchunk_ld(u32x4 (&r)[4], const bf16* __restrict__ src, size_t src_pitch, int tid) {
    const bf16* p = src + (size_t)(tid / PPR) * src_pitch + (tid % PPR) * 8;
#pragma unroll
    for (int i = 0; i < 4; ++i) r[i] = *(const u32x4*)(p + (size_t)i * (512 / PPR) * src_pitch);
}
template <int PPR, int PITCH> DI void hchunk_st(LAS unsigned char* dst, const u32x4 (&r)[4], int tid) {
    LAS unsigned char* d = dst + (tid / PPR) * PITCH + (tid % PPR) * 16;
#pragma unroll
    for (int i = 0; i < 4; ++i) *(LAS u32x4*)(d + i * (512 / PPR) * PITCH) = r[i];
}
constexpr int SG3_BUF = 2 * 64 * RP;
template <class Epi>
DI void sgemm3_tile(LAS unsigned char* big, const bf16* __restrict__ A, size_t lda, const bf16* __restrict__ Bt, int K, int row0, int col0, const Epi& E, int tid, int wid, int lane) {
    const int g = lane >> 4, li = lane & 15, wm = wid & 3, wn = wid >> 2;
    const bf16* ab = A + (size_t)row0 * lda; const bf16* bb = Bt + (size_t)col0 * K;
    const int n = K >> 8;
    u32x4 a0[4], b0[4], a1[4], b1[4];
    hchunk_ld<32>(a0, ab, lda, tid); hchunk_ld<32>(b0, bb, (size_t)K, tid);
    hchunk_ld<32>(a1, ab + 256, lda, tid); hchunk_ld<32>(b1, bb + 256, (size_t)K, tid);
    f32x4 acc[2] = {(f32x4){0.f, 0.f, 0.f, 0.f}, (f32x4){0.f, 0.f, 0.f, 0.f}};
    const int fao = (16 * wm + li) * RP + 16 * g, fbo = 64 * RP + (32 * wn + li) * RP + 16 * g;
#define SG3_ST(bufi, ra_, rb_) do { hchunk_st<32, RP>(big + (bufi) * SG3_BUF, ra_, tid); hchunk_st<32, RP>(big + (bufi) * SG3_BUF + 64 * RP, rb_, tid); } while (0)
#define SG3_LD(ra_, rb_, c_) do { hchunk_ld<32>(ra_, ab + (size_t)(c_) * 256, lda, tid); hchunk_ld<32>(rb_, bb + (size_t)(c_) * 256, (size_t)K, tid); } while (0)
#define SG3_MMA(bufi) do { const LAS unsigned char* fa_ = big + (bufi) * SG3_BUF + fao; const LAS unsigned char* fb_ = big + (bufi) * SG3_BUF + fbo; \
        _Pragma("unroll") for (int ks = 0; ks < 8; ++ks) { const bf16x8 af = *(const LAS bf16x8*)(fa_ + 64 * ks); \
            _Pragma("unroll") for (int nb = 0; nb < 2; ++nb) acc[nb] = MFMA16(*(const LAS bf16x8*)(fb_ + 16 * nb * RP + 64 * ks), af, acc[nb]); } } while (0)
    __syncthreads();
    SG3_ST(0, a0, b0);
    if (2 < n) SG3_LD(a0, b0, 2);
    __syncthreads();
    for (int c = 0; c < n; c += 2) {
        SG3_ST(1, a1, b1);
        if (c + 3 < n) SG3_LD(a1, b1, c + 3);
        SG3_MMA(0);
        __syncthreads();
        if (c + 2 < n) { SG3_ST(0, a0, b0); if (c + 4 < n) SG3_LD(a0, b0, c + 4); }
        SG3_MMA(1);
        __syncthreads();
    }
#undef SG3_ST
#undef SG3_LD
#undef SG3_MMA
    E(row0 + 16 * wm + li, col0 + 32 * wn + 4 * g, acc[0], acc[1], g, (col0 >> 6) * 2 + wn);
}
constexpr int SG4_BUF = 2 * 128 * VP;
template <class Epi>
DI void sgemm4_tile(LAS unsigned char* big, const bf16* __restrict__ A, size_t lda, const bf16* __restrict__ Bt, size_t ldb, int kbeg, int kend, int row0, int col0, const Epi& E, int tid, int wid, int lane) {
    const int g = lane >> 4, li = lane & 15, wm = wid & 3, wn = wid >> 2;
    const bf16* ab = A + (size_t)row0 * lda + kbeg; const bf16* bb = Bt + (size_t)col0 * ldb + kbeg;
    const int n = (kend - kbeg) >> 7;
    u32x4 a0[4], b0[4], a1[4], b1[4];
    hchunk_ld<16>(a0, ab, lda, tid); hchunk_ld<16>(b0, bb, ldb, tid);
    hchunk_ld<16>(a1, ab + 128, lda, tid); hchunk_ld<16>(b1, bb + 128, ldb, tid);
    f32x4 acc[2][4];
#pragma unroll
    for (int mb = 0; mb < 2; ++mb)
#pragma unroll
        for (int nb = 0; nb < 4; ++nb) acc[mb][nb] = (f32x4){0.f, 0.f, 0.f, 0.f};
    const int fao = (32 * wm + li) * VP + 16 * g, fbo = 128 * VP + (64 * wn + li) * VP + 16 * g;
#define SG4_ST(bufi, ra_, rb_) do { hchunk_st<16, VP>(big + (bufi) * SG4_BUF, ra_, tid); hchunk_st<16, VP>(big + (bufi) * SG4_BUF + 128 * VP, rb_, tid); } while (0)
#define SG4_LD(ra_, rb_, c_) do { hchunk_ld<16>(ra_, ab + (size_t)(c_) * 128, lda, tid); hchunk_ld<16>(rb_, bb + (size_t)(c_) * 128, ldb, tid); } while (0)
#define SG4_MMA(bufi) do { const LAS unsigned char* fa_ = big + (bufi) * SG4_BUF + fao; const LAS unsigned char* fb_ = big + (bufi) * SG4_BUF + fbo; \
        _Pragma("unroll") for (int ks = 0; ks < 4; ++ks) { const bf16x8 x0 = *(const LAS bf16x8*)(fa_ + 64 * ks), x1 = *(const LAS bf16x8*)(fa_ + 16 * VP + 64 * ks); \
            _Pragma("unroll") for (int nb = 0; nb < 4; ++nb) { const bf16x8 bfr = *(const LAS bf16x8*)(fb_ + 16 * nb * VP + 64 * ks); \
                acc[0][nb] = MFMA16(bfr, x0, acc[0][nb]); acc[1][nb] = MFMA16(bfr, x1, acc[1][nb]); } } } while (0)
    __syncthreads();
    SG4_ST(0, a0, b0);
    if (2 < n) SG4_LD(a0, b0, 2);
    __syncthreads();
    for (int c = 0; c < n; c += 2) {
        SG4_ST(1, a1, b1);
        if (c + 3 < n) SG4_LD(a1, b1, c + 3);
        SG4_MMA(0);
        __syncthreads();
        if (c + 2 < n) { SG4_ST(0, a0, b0); if (c + 4 < n) SG4_LD(a0, b0, c + 4); }
        SG4_MMA(1);
        __syncthreads();
    }
#undef SG4_ST
#undef SG4_LD
#undef SG4_MMA
#pragma unroll
    for (int mb = 0; mb < 2; ++mb)
#pragma unroll
        for (int pr = 0; pr < 2; ++pr) E(row0 + 32 * wm + 16 * mb + li, col0 + 64 * wn + 32 * pr + 4 * g, acc[mb][2 * pr], acc[mb][2 * pr + 1], g, (col0 + 64 * wn + 32 * pr) >> 5);
}
struct SEpiPart { float* part;
    DI void operator()(int row, int col, f32x4 a0, f32x4 a1, int, int) const { float* o = part + (size_t)(row - MP) * DM + col; *(f32x4*)o = a0; *(f32x4*)(o + 16) = a1; } };
struct SEpiRes { const float* basef; const bf16* baseb; bf16* xb; float* ssq;
    DI void operator()(int row, int col, f32x4 a0, f32x4 a1, int g, int slot) const { const size_t o = (size_t)row * DM + col;
        f32x4 b0, b1;
        if (basef) { b0 = *(const f32x4*)(basef + o); b1 = *(const f32x4*)(basef + o + 16); } else { b0 = unpack4(*(const u32x2*)(baseb + o)); b1 = unpack4(*(const u32x2*)(baseb + o + 16)); }
        const f32x4 v0 = b0 + a0, v1 = b1 + a1;
        *(u32x2*)(xb + o) = pack4(v0); *(u32x2*)(xb + o + 16) = pack4(v1);
        float sq = ((v0[0] * v0[0] + v0[1] * v0[1]) + (v0[2] * v0[2] + v0[3] * v0[3])) + ((v1[0] * v1[0] + v1[1] * v1[1]) + (v1[2] * v1[2] + v1[3] * v1[3]));
        sq += __shfl_xor(sq, 16); sq += __shfl_xor(sq, 32);
        if (g == 0) ssq[(size_t)row * 64 + slot] = sq; } };
template <int ACT> struct SEpiB { bf16* O; int ldc; float scale; const float* ssq;
    DI void operator()(int row, int col, f32x4 a0, f32x4 a1, int g, int slot) const { const float rs = scale * row_rstd<64>(ssq, row, g); a0 = a0 * rs; a1 = a1 * rs;
        if (ACT == 1) { a0 = __builtin_elementwise_max(a0, (f32x4){0.f, 0.f, 0.f, 0.f}); a1 = __builtin_elementwise_max(a1, (f32x4){0.f, 0.f, 0.f, 0.f}); a0 = a0 * a0; a1 = a1 * a1; }
        *(u32x2*)(O + (size_t)row * ldc + col) = pack4(a0); *(u32x2*)(O + (size_t)row * ldc + col + 16) = pack4(a1); } };

constexpr int PH_PER_LAYER = 10, NPH = 2 + 2 * PH_PER_LAYER;
constexpr int CW_BAR = 1024;
static_assert((CW_BAR + XCD_BAR_WORDS) * 4 <= (int)CTL_ZERO_BYTES, "control words inside the memset region");
struct Args { const float* in[23]; float* out; unsigned char* ws; int ph_lo, ph_hi, use_bar, pad; };

typedef const Args __attribute__((address_space(4)))* ArgsCP;
DI ArgsCP argp() { ArgsCP p = (ArgsCP)__builtin_amdgcn_kernarg_segment_ptr(); asm volatile("" : "+s"(p)); return p; }
__global__ void __launch_bounds__(512, 2) fwd(Args args_unused) {
#define args (*argp())
    extern __shared__ __attribute__((aligned(16))) unsigned char lds_raw[];
    LAS unsigned char* lds = (LAS unsigned char*)lds_raw;
    LAS unsigned char* big = lds + LDS_BIG;
    if (threadIdx.x < 256) ((LAS unsigned*)lds)[threadIdx.x] = 0u;
    __syncthreads();
    if (args.use_bar) (void)xcd_barrier_post((unsigned*)(args.ws + WS_CTL) + CW_BAR, (volatile LAS unsigned*)lds);
    const int lo = args.ph_lo, hi = args.ph_hi;
#ifndef ONLY
#define ONLY -1
#endif
#define IN(k) ((ONLY < 0 || ONLY == ((k) == 0 ? 0 : 1 + ((k) - 1) % PH_PER_LAYER)) && lo <= (k) && (k) < hi)
#ifndef PROBE_REP
#define PROBE_REP -1
#endif
#define NREP(kk) ((PROBE_REP) == (kk) ? 2 : 1)
#define SEAM(k) do { if (IN(k) && IN((k) + 1)) { XcdBarrier bb; bb.bar = (unsigned*)(ws + WS_CTL) + CW_BAR; bb.x = xb_xcc_id(); bb.st = (volatile LAS unsigned*)lds; xcd_barrier(bb); } } while (0)
#define TIDS() int tid = threadIdx.x; asm volatile("" : "+v"(tid)); const int lane = tid & 63, wid = __builtin_amdgcn_readfirstlane(tid >> 6); \
    int G = gridDim.x, bid = blockIdx.x; asm volatile("" : "+s"(G), "+s"(bid)); const int gw = bid * 8 + wid, NGW = G * 8, gt = bid * 512 + tid, NGT = G * 512; (void)lane; (void)gw; (void)NGW; (void)gt; (void)NGT
#define ws (args.ws)
#define out (args.out)
#define cosT ((float*)(ws + WS_COS))
#define sinT ((float*)(ws + WS_SIN))
#define XN ((bf16*)(ws + WS_XN))
#define Z ((bf16*)(ws + WS_Z))
#define KD ((bf16*)(ws + WS_KD))
#define PL ((bf16*)(ws + WS_PL))
#define CAT ((bf16*)(ws + WS_CAT))
#define Q2 ((bf16*)(ws + WS_Q2))
#define ATT ((bf16*)(ws + WS_ATT))
#define XA ((float*)(ws + WS_XA))
#define UP ((bf16*)(ws + WS_UP))
#define MN ((bf16*)(ws + WS_MN))
#define MKB ((bf16*)(ws + WS_MKB))
#define MVB ((bf16*)(ws + WS_MVB))
#define KVT ((bf16*)(ws + WS_KVT))
#define ST ((bf16*)(ws + WS_ST))
#define WL(off) (ws + WS_W + (size_t)l * W_LAYER + (off))

#define RETIDS() int tid_ = threadIdx.x; asm volatile("" : "+v"(tid_)); const int lane_ = tid_ & 63, wid_ = __builtin_amdgcn_readfirstlane(tid_ >> 6), gw_ = bid * 8 + wid_; (void)lane_; (void)gw_
#define SSQ(p) ((float*)(ws + WS_SSQ + (size_t)((p) & 1) * SSQ_BYTES))
#define PHASE(kk) for (int rep = 0; rep < NREP(kk); ++rep)
#define PHASE_VARS(kk) TIDS(); bf16* const XNO = (rep + 1 < NREP(kk)) ? (bf16*)(ws + WS_DUMMY) : XN; (void)XNO
    if (IN(0)) PHASE(0) {
        TIDS();
        constexpr int C_IN = 16 * 40, C_SQ = 16 * 16, C_UP = 16 * 64, C_DN = 64 * 16, C_PW = 16, C_LAYER = C_IN + 5 * C_SQ + C_UP + C_DN + C_PW;
#define CITEM(it_, t_) do { const int l_ = (it_) / C_LAYER; int r_ = (it_) - l_ * C_LAYER; unsigned char* wl_ = ws + WS_W + (size_t)l_ * W_LAYER; \
            if (r_ < C_IN) { t_ = CItem{args.in[8] + (size_t)l_ * DM * DIN, (bf16*)(wl_ + WO_IN), args.in[7] + (size_t)l_ * DM, DM, DIN, r_}; break; } r_ -= C_IN; \
            if (r_ < C_SQ) { t_ = CItem{args.in[12] + (size_t)l_ * DM * DM, (bf16*)(wl_ + WO_OUT), nullptr, DM, DM, r_}; break; } r_ -= C_SQ; \
            if (r_ < C_SQ) { t_ = CItem{args.in[15] + (size_t)l_ * DM * DM, (bf16*)(wl_ + WO_XQ), args.in[13] + (size_t)l_ * DM, DM, DM, r_}; break; } r_ -= C_SQ; \
            if (r_ < C_SQ) { t_ = CItem{args.in[16] + (size_t)l_ * DM * DM, (bf16*)(wl_ + WO_MKV), nullptr, DM, DM, r_}; break; } r_ -= C_SQ; \
            if (r_ < C_SQ) { t_ = CItem{args.in[17] + (size_t)l_ * DM * DM, (bf16*)(wl_ + WO_MKV) + (size_t)DM * DM, nullptr, DM, DM, r_}; break; } r_ -= C_SQ; \
            if (r_ < C_SQ) { t_ = CItem{args.in[18] + (size_t)l_ * DM * DM, (bf16*)(wl_ + WO_XO), nullptr, DM, DM, r_}; break; } r_ -= C_SQ; \
            if (r_ < C_UP) { t_ = CItem{args.in[20] + (size_t)l_ * DM * DFF, (bf16*)(wl_ + WO_UP), args.in[19] + (size_t)l_ * DM, DM, DFF, r_}; break; } r_ -= C_UP; \
            if (r_ < C_DN) { t_ = CItem{args.in[21] + (size_t)l_ * DFF * DM, (bf16*)(wl_ + WO_DN), nullptr, DFF, DM, r_}; break; } r_ -= C_DN; \
            t_ = CItem{args.in[10] + (size_t)(l_ * 4 + (r_ >> 2)) * 65536, (bf16*)(wl_ + WO_POOL) + (size_t)(r_ >> 2) * 65536, nullptr, 256, 256, r_ & 3}; } while (0)
        { LAS float* scr = (LAS float*)big;
          CItem ta, tb; f32x4 va[8], vb[8]; int it = bid;
          if (it < 2 * C_LAYER) { CITEM(it, ta); citem_load(ta, va, tid); }
          if (it + G < 2 * C_LAYER) { CITEM(it + G, tb); citem_load(tb, vb, tid); }
          while (it < 2 * C_LAYER) {
              citem_to_lds(ta, va, scr, tid); __syncthreads();
              const CItem tc = ta;
              if (it + 2 * G < 2 * C_LAYER) { CITEM(it + 2 * G, ta); citem_load(ta, va, tid); }
              citem_store(tc, scr, tid); __syncthreads();
              it += G; if (it >= 2 * C_LAYER) break;
              citem_to_lds(tb, vb, scr, tid); __syncthreads();
              const CItem td = tb;
              if (it + 2 * G < 2 * C_LAYER) { CITEM(it + 2 * G, tb); citem_load(tb, vb, tid); }
              citem_store(td, scr, tid); __syncthreads();
              it += G; } }
#undef CITEM
        for (int idx = gt; idx < NPOS * 128; idx += NGT) { const int p = idx >> 7, d = idx & 127;
            const double pos = (double)(p < SEQ ? p : 16384 + (p - SEQ));
            const double inv = exp2(-(double)d * (13.287712379549449 / 128.0));
            double rev = pos * inv * 0.15915494309189535; rev -= floor(rev);
            const float rf = (float)rev;
            cosT[idx] = __builtin_amdgcn_cosf(rf); sinT[idx] = __builtin_amdgcn_sinf(rf); }
        for (int m = gw; m < MT; m += NGW) { const float* xr = m < MP ? args.in[0] + (size_t)m * DM : args.in[1] + (size_t)(m - MP) * DM; row_to_xb(xr, XN + (size_t)m * DM, SSQ(0) + (size_t)m * 64, m < MP ? 32 : 64, lane); }
        for (int m = gw; m < 2 * 1024; m += NGW) { const int l = m >> 10, r = m & 1023; rms_row_bf16(args.in[2] + (size_t)r * DM, args.in[14] + (size_t)l * DM, MN + (size_t)m * DM, lane); }
    }
    SEAM(0);

    for (int l = 0; l < 2; ++l) {
        const int P = 1 + PH_PER_LAYER * l;
        if (IN(P + 0)) PHASE(1) { PHASE_VARS(1);
            { pg8::Gemm g{XN, (const bf16*)WL(WO_IN), MT, DIN, DM, DM, 0}; pg8::StaticOrder S; S.init(MT, DIN, G, bid);
              EpiZ E{Z, KD, cosT, sinT, out + OUT_PBP + (size_t)l * NB * 15 * DPOOL, out + OUT_PBS + (size_t)l * DECB * 15 * DPOOL, SSQ(3 * l)};
              pg8::gemm_phase<EpiZ, pg8::StaticOrder, true, true>(big, g, S, E); }
            { pg8::Gemm g{MN + (size_t)l * 1024 * DM, (const bf16*)WL(WO_MKV), 1024, 4096, DM, DM, 0}; pg8::StaticOrder S; S.init(1024, 4096, G, G - 1 - bid);
              EpiMemKV E{out + OUT_MK + (size_t)l * 1024 * DM, out + OUT_MV + (size_t)l * 1024 * DM, MKB, MVB};
              pg8::gemm_phase<EpiMemKV, pg8::StaticOrder, true, true>(big, g, S, E); }
        }
        SEAM(P + 0);
        if (IN(P + 1)) PHASE(2) { PHASE_VARS(2);
            for (int pass = 0; pass < 2; ++pass) {
                if ((pass == 0) == ((bid & 1) == 1)) {
                    for (int u = bid; u < 512; u += G) sret_unit(big, Z, args.in[3] + (size_t)l * DECB * 4 * 65536, out + OUT_RSS + (size_t)l * DECB * 4 * 65536, args.in[9] + (size_t)l * DRET, CAT, u >> 2, u & 3, tid, wid, lane);
                } else {
                    for (int u = bid; u < 256; u += G) kvt_unit(big, Z, KD, KVT, u >> 4, u & 15, tid, wid, lane);
                    pooled_items(Z, args.in[4] + (size_t)l * DECB * 15 * DPOOL, PL, out + OUT_PBS + (size_t)l * DECB * 15 * DPOOL, gw, NGW, lane);
                }
            }
        }
        SEAM(P + 1);
        if (IN(P + 2)) PHASE(3) { PHASE_VARS(3);
            scan_items(KVT, ST, out + OUT_RSP + (size_t)l * 16 * 65536, gt, NGT);
            { pg8::Gemm g{PL, (const bf16*)WL(WO_POOL), MT, DPOOL, 256, DPOOL, 256}; pg8::StaticOrder S; S.init(MT, DPOOL, G, bid);
              EpiB<2> E{CAT, DM, 1.0f, args.in[11] + (size_t)l * DPOOL, DRET, nullptr};
              pg8::gemm_phase<EpiB<2>, pg8::StaticOrder, true, true>(big, g, S, E); }
        }
        SEAM(P + 2);
        if (IN(P + 3)) PHASE(4) { PHASE_VARS(4);
            for (int u = bid; u < 256; u += G) ret2_unit2(big, Z, ST, args.in[9] + (size_t)l * DRET, CAT, u >> 4, u & 15, tid, wid, lane);
            { SEpiRes E{l == 0 ? args.in[1] - (size_t)MP * DM : nullptr, XN, XNO, SSQ(3 * l + 1)};
              for (int u = bid; u < 256; u += G) sgemm3_tile(big, CAT, DM, (const bf16*)WL(WO_OUT), DM, MP + (u >> 5) * 64, (u & 31) * 64, E, tid, wid, lane); }
        }
        SEAM(P + 3);
        if (IN(P + 4)) PHASE(5) { PHASE_VARS(5);
            pg8::Gemm g{CAT, (const bf16*)WL(WO_OUT), MP, DM, DM, DM, 0}; pg8::StaticOrder S; S.init(MP, DM, G, bid);
            EpiRes E{l == 0 ? args.in[0] : nullptr, XN, XNO, SSQ(3 * l + 1)};
            pg8::gemm_phase<EpiRes, pg8::StaticOrder, true, true>(big, g, S, E);
            { RETIDS(); SEpiB<0> E2{Q2, DM, 0.044194173824159216f, SSQ(3 * l + 1)};
              for (int u = bid; u < 256; u += G) sgemm3_tile(big, XN, DM, (const bf16*)WL(WO_XQ), DM, MP + (u >> 5) * 64, (u & 31) * 64, E2, tid_, wid_, lane_); }
        }
        SEAM(P + 4);
        if (IN(P + 5)) PHASE(6) { PHASE_VARS(6);
            pg8::Gemm g{XN, (const bf16*)WL(WO_XQ), MP, DM, DM, DM, 0}; pg8::StaticOrder S; S.init(MP, DM, G, bid);
            EpiB<0> E{Q2, DM, 0.044194173824159216f, nullptr, 0, SSQ(3 * l + 1)};
            if (bid & 1) { for (int u = bid; u < 512; u += G) xattn_s_unit(big, Q2, args.in[5] + (size_t)l * DECB * NMEM * DM, args.in[6] + (size_t)l * DECB * NMEM * DM, ATT, u >> 2, u & 3, tid, wid, lane); }
            pg8::gemm_phase<EpiB<0>, pg8::StaticOrder, true, true>(big, g, S, E);
            if (!(bid & 1)) { RETIDS(); for (int u = bid; u < 512; u += G) xattn_s_unit(big, Q2, args.in[5] + (size_t)l * DECB * NMEM * DM, args.in[6] + (size_t)l * DECB * NMEM * DM, ATT, u >> 2, u & 3, tid_, wid_, lane_); }
        }
        SEAM(P + 5);
        if (IN(P + 6)) PHASE(7) { PHASE_VARS(7);
            for (int u = bid; u < 256; u += G) xattn_p_unit2(big, Q2, MKB, MVB, ATT, u >> 6, (u >> 4) & 3, u & 15, tid, wid, lane);
            { SEpiRes E{nullptr, XN, XNO, SSQ(3 * l + 2)};
              for (int u = bid; u < 256; u += G) sgemm3_tile(big, ATT, DM, (const bf16*)WL(WO_XO), DM, MP + (u >> 5) * 64, (u & 31) * 64, E, tid, wid, lane); }
        }
        SEAM(P + 6);
        if (IN(P + 7)) PHASE(8) { PHASE_VARS(8);
            pg8::Gemm g{ATT, (const bf16*)WL(WO_XO), MP, DM, DM, DM, 0}; pg8::StaticOrder S; S.init(MP, DM, G, bid);
            EpiRes E{nullptr, XN, XNO, SSQ(3 * l + 2)};
            pg8::gemm_phase<EpiRes, pg8::StaticOrder, true, true>(big, g, S, E);
            { RETIDS(); SEpiB<1> E2{UP, DFF, 1.0f, SSQ(3 * l + 2)};
#ifndef PROBE_UPS
#define PROBE_UPS 1
#endif
              for (int rp = 0; rp < PROBE_UPS; ++rp)
              for (int u = bid; u < 256; u += G) sgemm4_tile(big, XN, DM, (const bf16*)WL(WO_UP), DM, 0, DM, MP + (u >> 6) * 128, (u & 63) * 128, E2, tid_, wid_, lane_); }
        }
        SEAM(P + 7);
        if (IN(P + 8)) PHASE(9) { PHASE_VARS(9);
            pg8::Gemm g{XN, (const bf16*)WL(WO_UP), MP, DFF, DM, DM, 0}; pg8::StaticOrder S; S.init(MP, DFF, G, bid);
            EpiB<1> E{UP, DFF, 1.0f, nullptr, 0, SSQ(3 * l + 2)};
            pg8::gemm_phase<EpiB<1>, pg8::StaticOrder, true, true>(big, g, S, E);
            { RETIDS();
            for (int u = bid; u < 256; u += G) { const int t = u >> 2, kq = u & 3; SEpiPart E2{(float*)(ws + WS_PART) + (size_t)kq * MS * DM};
                sgemm4_tile(big, UP, DFF, (const bf16*)WL(WO_DN), DFF, kq * 2048, kq * 2048 + 2048, MP + (t >> 4) * 128, (t & 15) * 128, E2, tid_, wid_, lane_); } }
        }
        SEAM(P + 8);
        if (IN(P + 9)) PHASE(10) { PHASE_VARS(10);
            pg8::Gemm g{UP, (const bf16*)WL(WO_DN), MP, DM, DFF, DFF, 0}; pg8::StaticOrder S; S.init(MP, DM, G, bid);
            EpiRes E{nullptr, XN, XNO, SSQ(3 * l + 3)};
            pg8::gemm_phase<EpiRes, pg8::StaticOrder, true, true>(big, g, S, E);
            { RETIDS();
            if (l == 1) { for (int m = MP + gw_; m < MT; m += NGW) rms_row_f32_b(XN + (size_t)m * DM, args.in[22], out + OUT_YS + (size_t)(m - MP) * DM, lane_, (const float*)(ws + WS_PART) + (size_t)(m - MP) * DM, (size_t)MS * DM); }
            else { for (int m = MP + gw_; m < MT; m += NGW) row_fin_bf16(XN + (size_t)m * DM, XNO + (size_t)m * DM, SSQ(3 * l + 3) + (size_t)m * 64, lane_, (const float*)(ws + WS_PART) + (size_t)(m - MP) * DM, (size_t)MS * DM); } }
        }
        SEAM(P + 9);
    }
    if (IN(NPH - 1)) { TIDS(); for (int m = gw; m < MP; m += NGW) rms_row_f32_b(XN + (size_t)m * DM, args.in[22], out + OUT_YP + (size_t)m * DM, lane); }
#undef SSQ
#undef PHASE
#undef PHASE_VARS
#undef IN
#undef SEAM
#undef NREP
#undef TIDS
#undef ws
#undef out
#undef cosT
#undef sinT
#undef XN
#undef Z
#undef KD
#undef PL
#undef CAT
#undef Q2
#undef ATT
#undef XA
#undef UP
#undef MN
#undef MKB
#undef MVB
#undef KVT
#undef ST
#undef WL
#undef args
}

extern "C" void kernel_launch(void* const* d_in, const int* in_sizes, int n_in, void* d_out, int out_size, void* d_ws, size_t ws_size, hipStream_t stream) {
    static int grid = 0;
    if (grid == 0) {
        if (n_in != 23 || (size_t)out_size != OUT_TOTAL || ws_size < WS_END) { fprintf(stderr, "kernel_launch: unexpected shapes (n_in %d, out %d, ws %zu)\n", n_in, out_size, ws_size); grid = -1; return; }
        int dev = 0, cus = 0, per_cu = 0;
        if (hipGetDevice(&dev) != hipSuccess || hipDeviceGetAttribute(&cus, hipDeviceAttributeMultiprocessorCount, dev) != hipSuccess) { grid = -1; return; }
        if (hipFuncSetAttribute((const void*)fwd, hipFuncAttributeMaxDynamicSharedMemorySize, LDS_BYTES) != hipSuccess) { fprintf(stderr, "kernel_launch: hipFuncSetAttribute failed\n"); grid = -1; return; }
        if (hipOccupancyMaxActiveBlocksPerMultiprocessor(&per_cu, (const void*)fwd, 512, LDS_BYTES) != hipSuccess || per_cu < 1) fprintf(stderr, "kernel_launch: occupancy query reports %d blocks per CU\n", per_cu);
        (void)hipGetLastError();
        grid = cus;
    }
    if (grid < 0) return;
    (void)hipMemsetAsync((char*)d_ws + WS_CTL, 0, CTL_ZERO_BYTES, stream);
    Args a{};
    for (int i = 0; i < 23; ++i) a.in[i] = (const float*)d_in[i];
    a.out = (float*)d_out; a.ws = (unsigned char*)d_ws; a.pad = 0;
#if MK_N_LAUNCHES == 1
    a.ph_lo = 0; a.ph_hi = NPH; a.use_bar = 1;
    hipLaunchKernelGGL(fwd, dim3(grid), dim3(512), LDS_BYTES, stream, a);
#else
    for (int ph = 0; ph < NPH; ++ph) { a.ph_lo = ph; a.ph_hi = ph + 1; a.use_bar = 0; hipLaunchKernelGGL(fwd, dim3(grid), dim3(512), LDS_BYTES, stream, a); }
#endif
}
```

```cpp
#include <hip/hip_runtime.h>
#include <cstdio>
#include <cstdint>

#define DI __device__ __forceinline__
#define GAS __attribute__((address_space(1)))
#define LAS __attribute__((address_space(3)))
typedef unsigned short bf16;
typedef short bf16x8 __attribute__((ext_vector_type(8)));
typedef short s16x4 __attribute__((ext_vector_type(4)));
typedef float f32x4 __attribute__((ext_vector_type(4)));
typedef float f32x2 __attribute__((ext_vector_type(2)));
typedef unsigned u32x4 __attribute__((ext_vector_type(4)));
typedef unsigned u32x2 __attribute__((ext_vector_type(2)));

#ifndef MK_N_LAUNCHES
#define MK_N_LAUNCHES 1
#endif

constexpr int DM = 2048, MP = 8192, MS = 512, MT = MP + MS, DIN = 5120, DFF = 8192, DRET = 1024, DPOOL = 1024, NMEM = 256;
constexpr int SEQ = 2048, NB = 4, DECB = 128, DECT = 4, NPOS = SEQ + DECT;
constexpr float EPS = 1e-6f;

constexpr size_t MiB = 1u << 20;
constexpr size_t WS_CTL = 0, CTL_ZERO_BYTES = 64 * 1024;
constexpr size_t WS_COS = 1 * MiB, WS_SIN = 2 * MiB + MiB / 2;
constexpr size_t WS_W = 4 * MiB, W_LAYER = 125 * MiB;
constexpr size_t WO_IN = 0, WO_OUT = 20 * MiB, WO_XQ = 28 * MiB, WO_MKV = 36 * MiB, WO_XO = 52 * MiB, WO_UP = 60 * MiB, WO_DN = 92 * MiB, WO_POOL = 124 * MiB;
constexpr size_t WS_XN = 254 * MiB;
constexpr size_t WS_Z = 288 * MiB;
constexpr size_t WS_KD = 373 * MiB;
constexpr size_t WS_PL = 389 * MiB;
constexpr size_t WS_CAT = 406 * MiB;
constexpr size_t WS_Q2 = 440 * MiB;
constexpr size_t WS_ATT = 474 * MiB;
constexpr size_t WS_XA = 508 * MiB;
constexpr size_t WS_UP = 576 * MiB;
constexpr size_t WS_MN = 712 * MiB;
constexpr size_t WS_MKB = 720 * MiB, WS_MVB = 724 * MiB;
constexpr size_t WS_KVT = 728 * MiB;
constexpr size_t WS_ST = 792 * MiB;
constexpr size_t WS_DUMMY = 824 * MiB;
constexpr size_t WS_SSQ = 892 * MiB, SSQ_BYTES = 4 * MiB;
constexpr size_t WS_PART = 900 * MiB;
constexpr size_t WS_END = 916 * MiB;

constexpr size_t OUT_YP = 0, OUT_YS = 16777216, OUT_RSP = OUT_YS + 1048576, OUT_PBP = OUT_RSP + 2097152, OUT_MK = OUT_PBP + 122880,
                 OUT_MV = OUT_MK + 4194304, OUT_RSS = OUT_MV + 4194304, OUT_PBS = OUT_RSS + 67108864, OUT_TOTAL = OUT_PBS + 3932160;

constexpr int LDS_CTL = 0, LDS_BIG = 1024, LDS_BYTES = 147456;

DI float bf2f(unsigned short b) { return __uint_as_float((unsigned)b << 16); }
typedef __bf16 bf16x2_t __attribute__((ext_vector_type(2)));
DI unsigned cvt_pk_bf16(float lo, float hi) { f32x2 v = {lo, hi}; bf16x2_t b = __builtin_convertvector(v, bf16x2_t); return __builtin_bit_cast(unsigned, b); }
DI u32x4 pack8(f32x4 a, f32x4 b) { u32x4 w; w.x = cvt_pk_bf16(a[0], a[1]); w.y = cvt_pk_bf16(a[2], a[3]); w.z = cvt_pk_bf16(b[0], b[1]); w.w = cvt_pk_bf16(b[2], b[3]); return w; }
DI u32x2 pack4(f32x4 a) { u32x2 w; w.x = cvt_pk_bf16(a[0], a[1]); w.y = cvt_pk_bf16(a[2], a[3]); return w; }
DI f32x4 unpack4(u32x2 w) { f32x4 r; r[0] = __uint_as_float(w.x << 16); r[1] = __uint_as_float(w.x & 0xffff0000u); r[2] = __uint_as_float(w.y << 16); r[3] = __uint_as_float(w.y & 0xffff0000u); return r; }
DI float wave_sum(float v) {
#pragma unroll
    for (int o = 1; o < 64; o <<= 1) v += __shfl_xor(v, o);
    return v;
}
DI float wave_max(float v) {
#pragma unroll
    for (int o = 1; o < 64; o <<= 1) v = fmaxf(v, __shfl_xor(v, o));
    return v;
}
DI float lg2gamma(int h) { return log2f(1.0f - exp2f(-5.0f - (float)h)); }
DI bf16x8 cat8(s16x4 a, s16x4 b) { return __builtin_shufflevector(a, b, 0, 1, 2, 3, 4, 5, 6, 7); }
template <int O0, int O1, int O2, int O3, int O4, int O5, int O6, int O7>
DI void tr8(unsigned a, s16x4 (&o)[8]) {
    asm volatile("ds_read_b64_tr_b16 %0, %8 offset:%9\n\tds_read_b64_tr_b16 %1, %8 offset:%10\n\tds_read_b64_tr_b16 %2, %8 offset:%11\n\tds_read_b64_tr_b16 %3, %8 offset:%12\n\t"
                 "ds_read_b64_tr_b16 %4, %8 offset:%13\n\tds_read_b64_tr_b16 %5, %8 offset:%14\n\tds_read_b64_tr_b16 %6, %8 offset:%15\n\tds_read_b64_tr_b16 %7, %8 offset:%16\n\t"
                 "s_waitcnt lgkmcnt(0)"
                 : "=&v"(o[0]), "=&v"(o[1]), "=&v"(o[2]), "=&v"(o[3]), "=&v"(o[4]), "=&v"(o[5]), "=&v"(o[6]), "=&v"(o[7])
                 : "v"(a), "i"(O0), "i"(O1), "i"(O2), "i"(O3), "i"(O4), "i"(O5), "i"(O6), "i"(O7) : "memory");
}
#define MFMA16(a, b, c) __builtin_amdgcn_mfma_f32_16x16x32_bf16((a), (b), (c), 0, 0, 0)

namespace pg8 {
#define PG8_LAS __attribute__((address_space(3)))
typedef unsigned short bf16_t;
constexpr int BM = 256, BK = 64, HALF = 128, HTB = HALF * BK * 2, STAGE_BYTES = 8 * HTB, NXCD = 8, WGM = 8;
__host__ __device__ __forceinline__ int lds_byte(int r, int c) { const int st = (r >> 4) * 2 + (c >> 5), rr = r & 15, cc = c & 31, ob = rr * 64 + cc * 2; return st * 1024 + (ob ^ (((ob >> 9) & 1) << 5)); }
__host__ __device__ __forceinline__ void stage_rc(int b, int& R, int& C) { const int st = b / 1024, sb = b % 1024, swz = sb ^ (((sb >> 9) & 1) << 5); R = (st >> 1) * 16 + swz / 64; C = (st & 1) * 32 + (swz % 64) / 2; }
__host__ __device__ __forceinline__ int perm32(int rho) { const int n = rho >> 4, i = rho & 15; return 8 * (i >> 2) + 4 * n + (i & 3); }
struct Unit { int pm, pn; };
struct Gemm { const bf16_t* A; const bf16_t* Bt; int M, N, K, lda, a_pn_off; };
struct StaticOrder {
    int nM, nN, nwg, G, c;
    __host__ __device__ void init(int M, int N, int G_, int c_) { nM = M / BM; nN = N / BM; nwg = nM * nN; G = G_; c = c_; }
    __host__ __device__ bool next(int i, Unit& u) const {
        const long L = (long)i * G + c; if (L >= nwg) return false;
        int wgid = (int)L; { const int q = nwg / NXCD, r = nwg % NXCD, xcd = wgid % NXCD, off = wgid / NXCD; wgid = (xcd < r ? xcd * (q + 1) : r * (q + 1) + (xcd - r) * q) + off; }
        const int nig = WGM * nN, gid = wgid / nig, fm = gid * WGM, gsz = (nM - fm) < WGM ? (nM - fm) : WGM;
        u.pm = fm + ((wgid % nig) % gsz); u.pn = (wgid % nig) / gsz; return true;
    }
    __device__ __forceinline__ void a_ready(const Unit&) const {}
    __device__ __forceinline__ void done(const Unit&) const {}
};
template <class Epi, class Sched, bool ALIGN_EPI = false, bool SP2 = false>
__device__ __forceinline__ void gemm_phase(PG8_LAS unsigned char* lds, const Gemm g, const Sched& S, const Epi& E) {
    int tid = threadIdx.x; asm volatile("" : "+v"(tid));
    const int wid = __builtin_amdgcn_readfirstlane(tid >> 6), lane = tid & 63, wr = wid >> 2, wc = wid & 3, fr = lane & 15, fq = lane >> 4;
    int K = g.K, lda = g.lda; asm volatile("" : "+s"(K), "+s"(lda));
    const int nt = K / BK;
    unsigned voffA[2], voffB[2];
#pragma unroll
    for (int i = 0; i < 2; ++i) { int R, C; stage_rc(tid * 16 + i * 8192, R, C); const int Rb = Epi::PERM ? ((R & ~31) + perm32(R & 31)) : R;
        voffA[i] = (unsigned)(R * lda + C) * 2u; voffB[i] = (unsigned)(Rb * K + C) * 2u; }
    const size_t kstep = (size_t)(BK * 2);
    const size_t hstepA = (size_t)HALF * lda * 2, hstepB = (size_t)HALF * K * 2;
    const size_t tstepA = 2 * hstepA, tstepB = 2 * hstepB;
    const unsigned ldsw = (unsigned)wid * 1024u;
    const int aoff = lds_byte(wr * 64 + fr, fq * 8), boff = lds_byte(wc * 32 + fr, fq * 8);
#define PG8_SA(b, h) (((b) * 2 + (h)) * HTB)
#define PG8_SB(b, h) ((4 + (b) * 2 + (h)) * HTB)
#define PG8_STAGE(bufoff, gbase, voff) do { _Pragma("unroll") for (int _i = 0; _i < 2; ++_i) \
        __builtin_amdgcn_global_load_lds((const unsigned*)((const char*)(gbase) + (voff)[_i]), (PG8_LAS unsigned*)(lds + (bufoff) + ldsw + _i * 8192), 16, 0, 0); } while (0)
#define PG8_LDA(dst, b, h) do { _Pragma("unroll") for (int m = 0; m < 4; ++m) _Pragma("unroll") for (int k = 0; k < 2; ++k) dst[m][k] = *(const PG8_LAS bf16x8*)(lds + PG8_SA(b, h) + aoff + m * 2048 + k * 1024); } while (0)
#define PG8_LDB(dst, b, h) do { _Pragma("unroll") for (int n = 0; n < 2; ++n) _Pragma("unroll") for (int k = 0; k < 2; ++k) dst[n][k] = *(const PG8_LAS bf16x8*)(lds + PG8_SB(b, h) + boff + n * 2048 + k * 1024); } while (0)
#define PG8_MMA(ai, bj, At, Bt) do { __builtin_amdgcn_s_setprio(1); _Pragma("unroll") for (int m = 0; m < 4; ++m) _Pragma("unroll") for (int n = 0; n < 2; ++n) _Pragma("unroll") for (int k = 0; k < 2; ++k) \
        acc[ai][bj][m][n] = __builtin_amdgcn_mfma_f32_16x16x32_bf16(Bt[n][k], At[m][k], acc[ai][bj][m][n], 0, 0, 0); __builtin_amdgcn_s_setprio(0); } while (0)
#define PG8_WAIT_V(n) asm volatile("s_waitcnt vmcnt(" #n ")" ::: "memory")
#define PG8_WAIT_L(n) asm volatile("s_waitcnt lgkmcnt(" #n ")" ::: "memory")
#define PG8_BAR __builtin_amdgcn_s_barrier()
#define PG8_SCHED __builtin_amdgcn_sched_barrier(0)
    Unit cur, nxt; int ui = 0;
    if (!S.next(0, cur)) return;
    f32x4 acc[2][2][4][2];
#pragma unroll
    for (int a = 0; a < 2; ++a)
#pragma unroll
        for (int b = 0; b < 2; ++b)
#pragma unroll
            for (int m = 0; m < 4; ++m)
#pragma unroll
                for (int n = 0; n < 2; ++n) acc[a][b][m][n] = (f32x4){0.f, 0.f, 0.f, 0.f};
    bf16x8 At[4][2], B0[2][2], B1[2][2];
    const char* cA = (const char*)g.A + (size_t)cur.pm * tstepA + (size_t)cur.pn * g.a_pn_off * 2; const char* cB = (const char*)g.Bt + (size_t)cur.pn * tstepB;
    S.a_ready(cur);
    if constexpr (SP2) {
        PG8_STAGE(PG8_SB(0, 0), cB, voffB); PG8_STAGE(PG8_SB(0, 1), cB + hstepB, voffB); PG8_STAGE(PG8_SA(0, 0), cA, voffA); PG8_STAGE(PG8_SA(0, 1), cA + hstepA, voffA);
        if (wr == 1) PG8_BAR;
        PG8_WAIT_V(2); PG8_BAR;
        PG8_STAGE(PG8_SB(1, 0), cB + kstep, voffB); PG8_STAGE(PG8_SA(1, 0), cA + kstep, voffA); PG8_STAGE(PG8_SB(1, 1), cB + hstepB + kstep, voffB);
        PG8_WAIT_V(6); PG8_BAR;
    } else {
        PG8_STAGE(PG8_SB(0, 0), cB, voffB); PG8_STAGE(PG8_SA(0, 0), cA, voffA); PG8_STAGE(PG8_SB(0, 1), cB + hstepB, voffB); PG8_STAGE(PG8_SA(0, 1), cA + hstepA, voffA);
        if (wr == 1) PG8_BAR;
        PG8_WAIT_V(4); PG8_BAR;
        PG8_STAGE(PG8_SB(1, 0), cB + kstep, voffB); PG8_STAGE(PG8_SA(1, 0), cA + kstep, voffA); PG8_STAGE(PG8_SB(1, 1), cB + hstepB + kstep, voffB);
        PG8_WAIT_V(6); PG8_BAR;
    }
    for (;;) {
        const bool has_next = S.next(ui + 1, nxt);
        const char* nA = has_next ? (const char*)g.A + (size_t)nxt.pm * tstepA + (size_t)nxt.pn * g.a_pn_off * 2 : cA; const char* nB = has_next ? (const char*)g.Bt + (size_t)nxt.pn * tstepB : cB;
        for (int t = 0; t < nt; t += 2) {
            const bool last = (t == nt - 2);
            const char* a1 = cA + (size_t)(t + 1) * kstep;
            const char* a2 = last ? nA : cA + (size_t)(t + 2) * kstep; const char* b2 = last ? nB : cB + (size_t)(t + 2) * kstep;
            const char* a3 = a2 + kstep; const char* b3 = b2 + kstep;
            if (last && has_next) S.a_ready(nxt);
            if constexpr (SP2) {
            PG8_LDB(B0, 0, 0); PG8_LDB(B1, 0, 1); PG8_SCHED; PG8_LDA(At, 0, 0); PG8_STAGE(PG8_SA(1, 1), a1 + hstepA, voffA);
            PG8_WAIT_V(8); PG8_WAIT_L(0); PG8_BAR; PG8_MMA(0, 0, At, B0); PG8_MMA(0, 1, At, B1); PG8_BAR; PG8_SCHED;
            PG8_LDA(At, 0, 1); PG8_STAGE(PG8_SB(0, 0), b2, voffB); PG8_STAGE(PG8_SB(0, 1), b2 + hstepB, voffB); PG8_STAGE(PG8_SA(0, 0), a2, voffA);
            PG8_WAIT_V(8); PG8_WAIT_L(0); PG8_BAR; PG8_MMA(1, 0, At, B0); PG8_MMA(1, 1, At, B1); PG8_BAR; PG8_SCHED;
            PG8_LDB(B0, 1, 0); PG8_LDB(B1, 1, 1); PG8_SCHED; PG8_LDA(At, 1, 0); PG8_STAGE(PG8_SA(0, 1), a2 + hstepA, voffA);
            PG8_WAIT_V(8); PG8_WAIT_L(0); PG8_BAR; PG8_MMA(0, 0, At, B0); PG8_MMA(0, 1, At, B1); PG8_BAR; PG8_SCHED;
            PG8_LDA(At, 1, 1); PG8_STAGE(PG8_SB(1, 0), b3, voffB); PG8_STAGE(PG8_SB(1, 1), b3 + hstepB, voffB); PG8_STAGE(PG8_SA(1, 0), a3, voffA);
            PG8_WAIT_V(8); PG8_WAIT_L(0); PG8_BAR; PG8_MMA(1, 0, At, B0); PG8_MMA(1, 1, At, B1); PG8_BAR; PG8_SCHED;
            } else {
            PG8_LDB(B0, 0, 0); PG8_SCHED; PG8_LDA(At, 0, 0); PG8_STAGE(PG8_SA(1, 1), a1 + hstepA, voffA);
            PG8_WAIT_L(8); PG8_BAR; PG8_WAIT_L(0); PG8_MMA(0, 0, At, B0); PG8_BAR; PG8_SCHED;
            PG8_LDB(B1, 0, 1); PG8_STAGE(PG8_SB(0, 0), b2, voffB);
            PG8_BAR; PG8_WAIT_L(0); PG8_MMA(0, 1, At, B1); PG8_BAR;
            PG8_LDA(At, 0, 1); PG8_STAGE(PG8_SA(0, 0), a2, voffA);
            PG8_BAR; PG8_WAIT_L(0); PG8_MMA(1, 0, At, B0); PG8_BAR; PG8_SCHED;
            PG8_STAGE(PG8_SB(0, 1), b2 + hstepB, voffB);
            PG8_WAIT_V(6); PG8_BAR; PG8_MMA(1, 1, At, B1); PG8_BAR;
            PG8_LDB(B0, 1, 0); PG8_SCHED; PG8_LDA(At, 1, 0); PG8_STAGE(PG8_SA(0, 1), a2 + hstepA, voffA);
            PG8_WAIT_L(8); PG8_BAR; PG8_WAIT_L(0); PG8_MMA(0, 0, At, B0); PG8_BAR; PG8_SCHED;
            PG8_LDB(B1, 1, 1); PG8_STAGE(PG8_SB(1, 0), b3, voffB);
            PG8_BAR; PG8_WAIT_L(0); PG8_MMA(0, 1, At, B1); PG8_BAR;
            PG8_LDA(At, 1, 1); PG8_STAGE(PG8_SA(1, 0), a3, voffA);
            PG8_BAR; PG8_WAIT_L(0); PG8_MMA(1, 0, At, B0); PG8_BAR; PG8_SCHED;
            PG8_STAGE(PG8_SB(1, 1), b3 + hstepB, voffB);
            PG8_WAIT_V(6); PG8_BAR; PG8_MMA(1, 1, At, B1); PG8_BAR;
            }
        }
        if constexpr (ALIGN_EPI) { if (wr == 0) PG8_BAR; }
        E(acc, cur, wr, wc, fr, fq); S.done(cur);
        if (!has_next) break;
#pragma unroll
        for (int a = 0; a < 2; ++a)
#pragma unroll
            for (int b = 0; b < 2; ++b)
#pragma unroll
                for (int m = 0; m < 4; ++m)
#pragma unroll
                    for (int n = 0; n < 2; ++n) acc[a][b][m][n] = (f32x4){0.f, 0.f, 0.f, 0.f};
        cur = nxt; cA = nA; cB = nB; ++ui;
        if constexpr (ALIGN_EPI) { if (wr == 1) PG8_BAR; }
    }
    PG8_WAIT_V(0);
    if constexpr (!ALIGN_EPI) { if (wr == 0) PG8_BAR; }
    PG8_BAR;
#undef PG8_SA
#undef PG8_SB
#undef PG8_STAGE
#undef PG8_LDA
#undef PG8_LDB
#undef PG8_MMA
#undef PG8_WAIT_V
#undef PG8_WAIT_L
#undef PG8_BAR
#undef PG8_SCHED
}
}
using pg8::Unit;


template <int NS> DI float row_rstd(const float* __restrict__ ssq, int row, int fq) {
    const f32x4* p = (const f32x4*)(ssq + (size_t)row * 64 + fq * (NS / 4)); float s = 0.f;
#pragma unroll
    for (int i = 0; i < NS / 16; ++i) { const f32x4 v = p[i]; s += (v[0] + v[1]) + (v[2] + v[3]); }
    s += __shfl_xor(s, 16); s += __shfl_xor(s, 32);
    return __builtin_amdgcn_rsqf(s * (1.0f / DM) + EPS);
}
struct EpiZ {
    static constexpr bool PERM = true;
    bf16* Z; bf16* KD; const float* cosT; const float* sinT; float* pbp; float* pbs; const float* ssq;
    DI void operator()(const f32x4 (&acc)[2][2][4][2], const Unit& u, int wr, int wc, int fr, int fq) const {
        asm volatile("" : "+v"(fr), "+v"(fq));
        const int type = u.pn >> 2, row0 = u.pm * 256 + wr * 64 + fr, cl = wc * 32 + 8 * fq;
        const bool sample = u.pm >= 32;
        if (type <= 1) {
            const float ksc = type == 1 ? 0.0625f : 1.0f;
#pragma unroll
            for (int ai = 0; ai < 2; ++ai)
#pragma unroll
                for (int m = 0; m < 4; ++m) {
                    const int row = row0 + ai * 128 + m * 16;
                    const int tab = sample ? (SEQ + (row & 3)) : (row & (SEQ - 1));
                    const f32x4 c0 = *(const f32x4*)(cosT + tab * 128 + cl), c1 = *(const f32x4*)(cosT + tab * 128 + cl + 4);
                    const f32x4 s0 = *(const f32x4*)(sinT + tab * 128 + cl), s1 = *(const f32x4*)(sinT + tab * 128 + cl + 4);
                    const float rs = sample ? row_rstd<64>(ssq, row, fq) : row_rstd<32>(ssq, row, fq);
                    const f32x4 a0 = acc[ai][0][m][0] * rs, a1 = acc[ai][0][m][1] * rs, b0 = acc[ai][1][m][0] * rs, b1 = acc[ai][1][m][1] * rs;
                    const f32x4 o10 = (a0 * c0 - b0 * s0) * ksc, o11 = (a1 * c1 - b1 * s1) * ksc, o20 = (b0 * c0 + a0 * s0) * ksc, o21 = (b1 * c1 + a1 * s1) * ksc;
                    bf16* zp = Z + (size_t)row * DIN + u.pn * 256 + cl;
                    *(u32x4*)zp = pack8(o10, o11); *(u32x4*)(zp + 128) = pack8(o20, o21);
                }
        } else {
#pragma unroll
            for (int ai = 0; ai < 2; ++ai)
#pragma unroll
                for (int m = 0; m < 4; ++m) {
                    const int row = row0 + ai * 128 + m * 16;
                    bf16* zp = Z + (size_t)row * DIN + u.pn * 256 + cl;
                    const float rs = sample ? row_rstd<64>(ssq, row, fq) : row_rstd<32>(ssq, row, fq);
                    f32x4 v[2][2];
#pragma unroll
                    for (int bj = 0; bj < 2; ++bj) { v[bj][0] = acc[ai][bj][m][0] * rs; v[bj][1] = acc[ai][bj][m][1] * rs; *(u32x4*)(zp + bj * 128) = pack8(v[bj][0], v[bj][1]); }
                    if (type == 4) {
                        const int cu = (u.pn - 16) * 256 + cl;
                        float* dst = nullptr;
                        if (sample) { const int rr = row - MP; dst = pbs + ((size_t)(rr >> 2) * 15 + 11 + (rr & 3)) * DPOOL + cu; }
                        else { const int t = row & (SEQ - 1); if (t >= SEQ - 15) dst = pbp + ((size_t)(row >> 11) * 15 + (t - (SEQ - 15))) * DPOOL + cu; }
                        if (dst) {
#pragma unroll
                            for (int bj = 0; bj < 2; ++bj) { *(f32x4*)(dst + bj * 128) = v[bj][0]; *(f32x4*)(dst + bj * 128 + 4) = v[bj][1]; }
                        }
                    }
                }
        }
    }
};
struct EpiMemKV {
    static constexpr bool PERM = true;
    float* ok; float* ov; bf16* kb; bf16* vb;
    DI void operator()(const f32x4 (&acc)[2][2][4][2], const Unit& u, int wr, int wc, int fr, int fq) const {
        asm volatile("" : "+v"(fr), "+v"(fq));
        const bool isv = u.pn >= 8; float* of = isv ? ov : ok; bf16* ob = isv ? vb : kb;
        const int row0 = u.pm * 256 + wr * 64 + fr, col0 = (u.pn & 7) * 256 + wc * 32 + 8 * fq;
#pragma unroll
        for (int ai = 0; ai < 2; ++ai)
#pragma unroll
            for (int m = 0; m < 4; ++m) { const size_t ro = (size_t)(row0 + ai * 128 + m * 16) * DM + col0;
#pragma unroll
                for (int bj = 0; bj < 2; ++bj) { const f32x4 v0 = acc[ai][bj][m][0], v1 = acc[ai][bj][m][1];
                    *(f32x4*)(of + ro + bj * 128) = v0; *(f32x4*)(of + ro + bj * 128 + 4) = v1; *(u32x4*)(ob + ro + bj * 128) = pack8(v0, v1); } }
    }
};
struct EpiRes {
    static constexpr bool PERM = true;
    const float* basef; const bf16* baseb; bf16* xb; float* ssq;
    DI void operator()(const f32x4 (&acc)[2][2][4][2], const Unit& u, int wr, int wc, int fr, int fq) const {
        asm volatile("" : "+v"(fr), "+v"(fq));
        const int row0 = u.pm * 256 + wr * 64 + fr, col0 = u.pn * 256 + wc * 32 + 8 * fq;
#pragma unroll
        for (int ai = 0; ai < 2; ++ai)
#pragma unroll
            for (int m = 0; m < 4; ++m) { const int row = row0 + ai * 128 + m * 16; const size_t ro = (size_t)row * DM + col0; float sq = 0.f;
#pragma unroll
                for (int bj = 0; bj < 2; ++bj) { f32x4 b0, b1;
                    if (basef) { b0 = *(const f32x4*)(basef + ro + bj * 128); b1 = *(const f32x4*)(basef + ro + bj * 128 + 4); }
                    else { const u32x4 w = *(const u32x4*)(baseb + ro + bj * 128); b0 = unpack4((u32x2){w.x, w.y}); b1 = unpack4((u32x2){w.z, w.w}); }
                    const f32x4 v0 = b0 + acc[ai][bj][m][0], v1 = b1 + acc[ai][bj][m][1];
                    *(u32x4*)(xb + ro + bj * 128) = pack8(v0, v1);
                    sq += ((v0[0] * v0[0] + v0[1] * v0[1]) + (v0[2] * v0[2] + v0[3] * v0[3])) + ((v1[0] * v1[0] + v1[1] * v1[1]) + (v1[2] * v1[2] + v1[3] * v1[3])); }
                sq += __shfl_xor(sq, 16); sq += __shfl_xor(sq, 32);
                if (fq == 0) ssq[(size_t)row * 64 + u.pn * 4 + wc] = sq; }
    }
};
template <int ACT> struct EpiB {
    static constexpr bool PERM = true;
    bf16* O; int ldc; float scale; const float* cs; int coff; const float* ssq;
    DI void operator()(const f32x4 (&acc)[2][2][4][2], const Unit& u, int wr, int wc, int fr, int fq) const {
        asm volatile("" : "+v"(fr), "+v"(fq));
        const int row0 = u.pm * 256 + wr * 64 + fr, col0 = u.pn * 256 + wc * 32 + 8 * fq;
#pragma unroll
        for (int ai = 0; ai < 2; ++ai)
#pragma unroll
            for (int m = 0; m < 4; ++m) { bf16* rp = O + (size_t)(row0 + ai * 128 + m * 16) * ldc + coff + col0;
                float rs = scale; if (ACT != 2) rs *= row_rstd<32>(ssq, row0 + ai * 128 + m * 16, fq);
#pragma unroll
                for (int bj = 0; bj < 2; ++bj) { f32x4 v0 = acc[ai][bj][m][0], v1 = acc[ai][bj][m][1];
                    if (ACT != 2) { v0 = v0 * rs; v1 = v1 * rs; }
                    if (ACT == 1) { v0 = __builtin_elementwise_max(v0, (f32x4){0.f, 0.f, 0.f, 0.f}); v1 = __builtin_elementwise_max(v1, (f32x4){0.f, 0.f, 0.f, 0.f}); v0 = v0 * v0; v1 = v1 * v1; }
                    if (ACT == 2) { v0 = v0 * *(const f32x4*)(cs + col0 + bj * 128); v1 = v1 * *(const f32x4*)(cs + col0 + bj * 128 + 4); }
                    *(u32x4*)(rp + bj * 128) = pack8(v0, v1); } }
    }
};

#define XB_TMO      128
#define XB_XCNT(j)  (256  + 64 * (j))
#define XB_XSUB(j)  (1280 + 64 * (j))
#define XB_XGEN(j)  (2304 + 64 * (j))
#define XB_TOP      3328
#define XB_TOPGEN   3392
#define XCD_BAR_WORDS 3456
#define XB_SPIN_CAP (1u << 18)
__device__ __forceinline__ unsigned xb_ld(unsigned* p)              { return __hip_atomic_load(p, __ATOMIC_RELAXED, __HIP_MEMORY_SCOPE_AGENT); }
__device__ __forceinline__ unsigned xb_add(unsigned* p, unsigned v) { return __hip_atomic_fetch_add(p, v, __ATOMIC_RELAXED, __HIP_MEMORY_SCOPE_AGENT); }
__device__ __forceinline__ unsigned xb_xcc_id() { return (unsigned)__builtin_amdgcn_s_getreg((3 << 11) | 20) & 0xFu; }
#define XB_SPIN(cond, bar) do { unsigned _sp = 0; while (cond) { __builtin_amdgcn_s_sleep(1); \
    if ((++_sp & 255u) == 0u) { if (xb_ld(&(bar)[XB_TMO])) break; if (_sp > XB_SPIN_CAP) { atomicAdd(&(bar)[XB_TMO], 1u); break; } } } } while (0)
struct XcdBarrier { unsigned* bar; unsigned x; volatile LAS unsigned* st; };
__device__ __forceinline__ XcdBarrier xcd_barrier_post(unsigned* bar, volatile LAS unsigned* st) {
    XcdBarrier b; b.bar = bar; b.x = xb_xcc_id(); b.st = st;
    if (threadIdx.x == 0) (void)xb_add(&bar[XB_XCNT(b.x)], 1u);
    return b;
}
__device__ __forceinline__ void xcd_barrier_complete(unsigned* bar, unsigned x, unsigned& nloc, unsigned& nx) {
    const unsigned G = gridDim.x * gridDim.y * gridDim.z;
    unsigned sum, cnt, mine, sp = 0u;
    for (;;) {
        sum = 0u; cnt = 0u; mine = 0u;
#pragma unroll
        for (unsigned j = 0; j < 16; ++j) { const unsigned c = xb_ld(&bar[XB_XCNT(j)]); sum += c; cnt += (c > 0u) ? 1u : 0u; }
        mine = xb_ld(&bar[XB_XCNT(x)]);
        if (sum == G) break;
        __builtin_amdgcn_s_sleep(1);
        if ((++sp & 255u) == 0u) { if (xb_ld(&bar[XB_TMO])) break; if (sp > XB_SPIN_CAP) { atomicAdd(&bar[XB_TMO], 1u); break; } }
    }
    nloc = mine > 0u ? mine : 1u; nx = cnt > 0u ? cnt : 1u;
}
__device__ __forceinline__ void xcd_barrier(const XcdBarrier& b) {
    asm volatile("s_waitcnt vmcnt(0)" ::: "memory");
    __syncthreads();
    if (threadIdx.x == 0) {
        unsigned* bar = b.bar;
        __builtin_amdgcn_s_waitcnt(0);
        unsigned nloc = b.st[0], nx = b.st[1];
        if (nloc == 0u) { xcd_barrier_complete(bar, b.x, nloc, nx); b.st[0] = nloc; b.st[1] = nx; }
        const unsigned old = xb_add(&bar[XB_XSUB(b.x)], 1u);
        const unsigned gen = old / nloc;
        if (old + 1u == (gen + 1u) * nloc) {
            __builtin_amdgcn_fence(__ATOMIC_RELEASE, "agent");
            asm volatile("s_waitcnt vmcnt(0)" ::: "memory");
            const unsigned og = xb_add(&bar[XB_TOP], 1u);
            const unsigned tg = og / nx;
            if (og + 1u == (tg + 1u) * nx) xb_add(&bar[XB_TOPGEN], 1u);
            else XB_SPIN(xb_ld(&bar[XB_TOPGEN]) == tg, bar);
            __builtin_amdgcn_fence(__ATOMIC_ACQUIRE, "agent");
            xb_add(&bar[XB_XGEN(b.x)], 1u);
            asm volatile("s_waitcnt vmcnt(0)" ::: "memory");
        } else {
            XB_SPIN(xb_ld(&bar[XB_XGEN(b.x)]) == gen, bar);
            __builtin_amdgcn_fence(__ATOMIC_ACQUIRE, "agent");
            asm volatile("s_waitcnt vmcnt(0)" ::: "memory");
        }
    }
    __syncthreads();
}

constexpr int RP = 528;
constexpr int VP = 272;
DI unsigned lds_addr(LAS unsigned char* p) { return (unsigned)(unsigned long)p; }
template <int BASE, int ST, int SF>
DI void tr_frag4(unsigned a, bf16x8 (&f)[4]) {
    s16x4 o[8];
    tr8<BASE, BASE + ST, BASE + SF, BASE + SF + ST, BASE + 2 * SF, BASE + 2 * SF + ST, BASE + 3 * SF, BASE + 3 * SF + ST>(a, o);
    f[0] = cat8(o[0], o[1]); f[1] = cat8(o[2], o[3]); f[2] = cat8(o[4], o[5]); f[3] = cat8(o[6], o[7]);
}

DI void transpose_item(const float* __restrict__ W, int K, int N, bf16* __restrict__ WT, LAS float* scr, int item, int lane, const float* __restrict__ gain = nullptr) {
    const int nblk = N >> 6, kb = item / nblk, nb = item - kb * nblk, k0 = kb * 64, n0 = nb * 64;
    const int lr = lane >> 4, lc = (lane & 15) * 4;
    f32x4 v[16];
#pragma unroll
    for (int i = 0; i < 16; ++i) v[i] = *(const f32x4*)(W + (size_t)(k0 + 4 * i + lr) * N + n0 + lc);
#pragma unroll
    for (int i = 0; i < 16; ++i) { LAS float* s = scr + (4 * i + lr) * 65 + lc; const float gn = gain ? gain[k0 + 4 * i + lr] : 1.0f;
        s[0] = v[i][0] * gn; s[1] = v[i][1] * gn; s[2] = v[i][2] * gn; s[3] = v[i][3] * gn; }
    asm volatile("s_waitcnt lgkmcnt(0)" ::: "memory");
    const int c = lane & 7;
#pragma unroll
    for (int j = 0; j < 8; ++j) { const int n = (lane >> 3) + 8 * j; const LAS float* s = scr + (8 * c) * 65 + n;
        u32x4 o; o.x = cvt_pk_bf16(s[0], s[65]); o.y = cvt_pk_bf16(s[130], s[195]); o.z = cvt_pk_bf16(s[260], s[325]); o.w = cvt_pk_bf16(s[390], s[455]);
        *(u32x4*)(WT + (size_t)(n0 + n) * K + k0 + 8 * c) = o; }
    asm volatile("s_waitcnt lgkmcnt(0)" ::: "memory");
}
struct CItem { const float* W; bf16* WT; const float* gain; int K, N, item; };
DI void citem_load(const CItem& t, f32x4 (&v)[8], int tid) {
    const int nblk = t.N >> 7, kb = t.item / nblk, nb = t.item - kb * nblk;
    const float* p = t.W + (size_t)(128 * kb + (tid >> 5)) * t.N + 128 * nb + (tid & 31) * 4;
#pragma unroll
    for (int i = 0; i < 8; ++i) v[i] = __builtin_nontemporal_load((const f32x4*)(p + (size_t)(16 * i) * t.N));
}
DI void citem_to_lds(const CItem& t, const f32x4 (&v)[8], LAS float* scr, int tid) {
    const int nblk = t.N >> 7, kb = t.item / nblk, k0 = 128 * kb;
#pragma unroll
    for (int i = 0; i < 8; ++i) { const int row = (tid >> 5) + 16 * i; LAS float* s = scr + row * 129 + (tid & 31) * 4; const float gn = t.gain ? t.gain[k0 + row] : 1.0f;
        s[0] = v[i][0] * gn; s[1] = v[i][1] * gn; s[2] = v[i][2] * gn; s[3] = v[i][3] * gn; }
}
DI void citem_store(const CItem& t, const LAS float* scr, int tid) {
    const int nblk = t.N >> 7, kb = t.item / nblk, nb = t.item - kb * nblk, k0 = 128 * kb, n0 = 128 * nb;
    const int c = tid & 15;
#pragma unroll
    for (int j = 0; j < 4; ++j) { const int n = (tid >> 4) + 32 * j; const LAS float* s = scr + (8 * c) * 129 + n;
        u32x4 o; o.x = cvt_pk_bf16(s[0], s[129]); o.y = cvt_pk_bf16(s[258], s[387]); o.z = cvt_pk_bf16(s[516], s[645]); o.w = cvt_pk_bf16(s[774], s[903]);
        *(u32x4*)(t.WT + (size_t)(n0 + n) * t.K + k0 + 8 * c) = o; }
}
DI void rms_row_bf16(const float* __restrict__ xrow, const float* __restrict__ w, bf16* __restrict__ orow, int lane) {
    const f32x4* xr = (const f32x4*)xrow + lane; const f32x4* wr = (const f32x4*)w + lane;
    f32x4 v[8]; float s = 0.f;
#pragma unroll
    for (int j = 0; j < 8; ++j) { v[j] = xr[64 * j]; s += (v[j][0] * v[j][0] + v[j][1] * v[j][1]) + (v[j][2] * v[j][2] + v[j][3] * v[j][3]); }
    const float rstd = 1.0f / sqrtf(wave_sum(s) * (1.0f / DM) + EPS);
    u32x2* o = (u32x2*)orow + lane;
#pragma unroll
    for (int j = 0; j < 8; ++j) o[64 * j] = pack4(v[j] * rstd * wr[64 * j]);
}
DI void row_to_xb(const float* __restrict__ xrow, bf16* __restrict__ orow, float* __restrict__ ssqrow, int ns, int lane, const float* __restrict__ part = nullptr, size_t pstride = 0, float* __restrict__ xw = nullptr) {
    const f32x4* xr = (const f32x4*)xrow + lane; f32x4 v[8]; float s = 0.f;
#pragma unroll
    for (int j = 0; j < 8; ++j) { v[j] = xr[64 * j];
        if (part) { for (int q = 0; q < 4; ++q) v[j] += ((const f32x4*)(part + q * pstride) + lane)[64 * j]; ((f32x4*)xw + lane)[64 * j] = v[j]; }
        s += (v[j][0] * v[j][0] + v[j][1] * v[j][1]) + (v[j][2] * v[j][2] + v[j][3] * v[j][3]); }
    s = wave_sum(s);
    u32x2* o = (u32x2*)orow + lane;
#pragma unroll
    for (int j = 0; j < 8; ++j) o[64 * j] = pack4(v[j]);
    if (lane < ns) ssqrow[lane] = lane == 0 ? s : 0.f;
}
DI void load_row_bf16(const bf16* __restrict__ xrow, f32x4 (&v)[8], int lane, const float* __restrict__ part, size_t pstride) {
    const u32x2* xr = (const u32x2*)xrow + lane;
#pragma unroll
    for (int j = 0; j < 8; ++j) { v[j] = unpack4(xr[64 * j]);
        if (part) { for (int q = 0; q < 4; ++q) v[j] += ((const f32x4*)(part + q * pstride) + lane)[64 * j]; } }
}
DI void row_fin_bf16(const bf16* __restrict__ xrow, bf16* __restrict__ orow, float* __restrict__ ssqrow, int lane, const float* __restrict__ part, size_t pstride) {
    f32x4 v[8]; load_row_bf16(xrow, v, lane, part, pstride); float s = 0.f;
#pragma unroll
    for (int j = 0; j < 8; ++j) s += (v[j][0] * v[j][0] + v[j][1] * v[j][1]) + (v[j][2] * v[j][2] + v[j][3] * v[j][3]);
    s = wave_sum(s);
    u32x2* o = (u32x2*)orow + lane;
#pragma unroll
    for (int j = 0; j < 8; ++j) o[64 * j] = pack4(v[j]);
    ssqrow[lane] = lane == 0 ? s : 0.f;
}
DI void rms_row_f32_b(const bf16* __restrict__ xrow, const float* __restrict__ w, float* __restrict__ orow, int lane, const float* __restrict__ part = nullptr, size_t pstride = 0) {
    f32x4 v[8]; load_row_bf16(xrow, v, lane, part, pstride); float s = 0.f; const f32x4* wr = (const f32x4*)w + lane;
#pragma unroll
    for (int j = 0; j < 8; ++j) s += (v[j][0] * v[j][0] + v[j][1] * v[j][1]) + (v[j][2] * v[j][2] + v[j][3] * v[j][3]);
    const float rstd = 1.0f / sqrtf(wave_sum(s) * (1.0f / DM) + EPS);
    f32x4* o = (f32x4*)orow + lane;
#pragma unroll
    for (int j = 0; j < 8; ++j) o[64 * j] = v[j] * rstd * wr[64 * j];
}
DI u32x4 pair16(u32x2 a, u32x2 b, bool odd) {
    const u32x2 send = odd ? a : b; u32x2 recv;
    recv.x = (unsigned)__shfl_xor((int)send.x, 16); recv.y = (unsigned)__shfl_xor((int)send.y, 16);
    return odd ? (u32x4){recv.x, recv.y, b.x, b.y} : (u32x4){a.x, a.y, recv.x, recv.y};
}
template <int KS, int NG>
DI void kvt_sub(unsigned aV, const bf16x8 af, f32x4 (&acc)[16]) {
    bf16x8 bf[4]; tr_frag4<(32 * KS) * RP + NG * 128, 4 * RP, 32>(aV, bf);
#pragma unroll
    for (int f = 0; f < 4; ++f) acc[4 * NG + f] = MFMA16(af, bf[f], acc[4 * NG + f]);
}
DI void kvt_unit(LAS unsigned char* big, const bf16* __restrict__ Z, const bf16* __restrict__ KD, bf16* __restrict__ KVT, int bh, int c, int tid, int wid, int lane) {
    const int b = bh >> 2, h = bh & 3, r0 = b * SEQ + c * 128;
    LAS unsigned char* Vs = big; LAS unsigned char* Ks = big + 128 * RP;
    const float l2g = lg2gamma(h);
#pragma unroll
    for (int i = 0; i < 8; ++i) { const int id = tid + 512 * i, row = id >> 5, ch = id & 31;
        const u32x4 v = *(const u32x4*)(Z + (size_t)(r0 + row) * DIN + 2048 + h * 256 + ch * 8);
        const u32x4 k = *(const u32x4*)(Z + (size_t)(r0 + row) * DIN + 1024 + h * 256 + ch * 8);
        const float dk = exp2f(l2g * (float)(127 - row));
        const f32x4 k0 = unpack4((u32x2){k.x, k.y}) * dk, k1 = unpack4((u32x2){k.z, k.w}) * dk;
        *(LAS u32x4*)(Vs + row * RP + ch * 16) = v; *(LAS u32x4*)(Ks + row * RP + ch * 16) = pack8(k0, k1); }
    __syncthreads();
    const int g = lane >> 4, q = (lane >> 2) & 3, p = lane & 3;
    const unsigned aV = lds_addr(Vs) + (8 * g + q) * RP + 8 * p;
    bf16* o = KVT + ((size_t)(bh * 16 + c) * 256) * 256;
    for (int mb = 0; mb < 2; ++mb) {
        const unsigned aK = lds_addr(Ks) + (8 * g + q) * RP + (32 * wid + 16 * mb + 4 * p) * 2;
        bf16x8 af[4]; tr_frag4<0, 4 * RP, 32 * RP>(aK, af);
        f32x4 acc[16];
#pragma unroll
        for (int n = 0; n < 16; ++n) acc[n] = (f32x4){0.f, 0.f, 0.f, 0.f};
        kvt_sub<0, 0>(aV, af[0], acc); kvt_sub<0, 1>(aV, af[0], acc); kvt_sub<0, 2>(aV, af[0], acc); kvt_sub<0, 3>(aV, af[0], acc);
        kvt_sub<1, 0>(aV, af[1], acc); kvt_sub<1, 1>(aV, af[1], acc); kvt_sub<1, 2>(aV, af[1], acc); kvt_sub<1, 3>(aV, af[1], acc);
        kvt_sub<2, 0>(aV, af[2], acc); kvt_sub<2, 1>(aV, af[2], acc); kvt_sub<2, 2>(aV, af[2], acc); kvt_sub<2, 3>(aV, af[2], acc);
        kvt_sub<3, 0>(aV, af[3], acc); kvt_sub<3, 1>(aV, af[3], acc); kvt_sub<3, 2>(aV, af[3], acc); kvt_sub<3, 3>(aV, af[3], acc);
#pragma unroll
        for (int nb = 0; nb < 16; ++nb) *(u32x2*)(o + (size_t)(16 * nb + (lane & 15)) * 256 + 32 * wid + 16 * mb + 4 * g) = pack4(acc[nb]);
    }
    __syncthreads();
}

DI void sret_unit(LAS unsigned char* big, const bf16* __restrict__ Z, const float* __restrict__ S0, float* __restrict__ Sout, const float* __restrict__ rnw, bf16* __restrict__ CAT,
                  int b, int h, int tid, int wid, int lane) {
    LAS float* qs = (LAS float*)big; LAS float* ks_ = qs + 1024; LAS float* vs = qs + 2048; LAS float* sc = qs + 3072; LAS float* red = qs + 3136;
    const int rs = MP + 4 * b; const float l2g = lg2gamma(h);
#pragma unroll
    for (int i = 0; i < 6; ++i) { const int id = tid + 512 * i, which = id >> 10, t = (id >> 8) & 3, d = id & 255;
        qs[id] = bf2f(Z[(size_t)(rs + t) * DIN + which * 1024 + h * 256 + d]); }
    __syncthreads();
#pragma unroll
    for (int pp = 0; pp < 2; ++pp) { const int pi = 2 * wid + pp, i = pi >> 2, j = pi & 3; float s = 0.f;
#pragma unroll
        for (int m = 0; m < 4; ++m) s += qs[i * 256 + lane + 64 * m] * ks_[j * 256 + lane + 64 * m];
        s = wave_sum(s); if (lane == 0) sc[pi] = (i >= j) ? s * exp2f(l2g * (float)(i - j)) : 0.f; }
    const float g4 = exp2f(l2g * 4.0f), gk0 = exp2f(l2g * 3.0f), gk1 = exp2f(l2g * 2.0f), gk2 = exp2f(l2g), gk3 = 1.0f;
    const size_t sbase = ((size_t)(b * 4 + h)) * 65536 + 4 * lane;
    f32x4 vv[4];
#pragma unroll
    for (int j = 0; j < 4; ++j) vv[j] = *(LAS f32x4*)(vs + j * 256 + 4 * lane);
    f32x4 oi[4];
#pragma unroll
    for (int i = 0; i < 4; ++i) oi[i] = (f32x4){0.f, 0.f, 0.f, 0.f};
    float ql[4], kl[4];
    { const int dl = wid + 8 * (lane & 31);
      ql[0] = qs[dl]; ql[1] = qs[256 + dl]; ql[2] = qs[512 + dl]; ql[3] = qs[768 + dl];
      kl[0] = ks_[dl] * gk0; kl[1] = ks_[256 + dl] * gk1; kl[2] = ks_[512 + dl] * gk2; kl[3] = ks_[768 + dl] * gk3; }
#pragma unroll
    for (int rb = 0; rb < 2; ++rb) {
        f32x4 sv[16];
#pragma unroll
        for (int r8 = 0; r8 < 16; ++r8) sv[r8] = __builtin_nontemporal_load((const f32x4*)(S0 + sbase + (size_t)(wid + 8 * (16 * rb + r8)) * 256));
#pragma unroll
        for (int r8 = 0; r8 < 16; ++r8) { const int r = 16 * rb + r8; const f32x4 s = sv[r8];
            const float fq0 = __int_as_float(__builtin_amdgcn_readlane(__float_as_int(ql[0]), r)), fq1 = __int_as_float(__builtin_amdgcn_readlane(__float_as_int(ql[1]), r));
            const float fq2 = __int_as_float(__builtin_amdgcn_readlane(__float_as_int(ql[2]), r)), fq3 = __int_as_float(__builtin_amdgcn_readlane(__float_as_int(ql[3]), r));
            const float fk0 = __int_as_float(__builtin_amdgcn_readlane(__float_as_int(kl[0]), r)), fk1 = __int_as_float(__builtin_amdgcn_readlane(__float_as_int(kl[1]), r));
            const float fk2 = __int_as_float(__builtin_amdgcn_readlane(__float_as_int(kl[2]), r)), fk3 = __int_as_float(__builtin_amdgcn_readlane(__float_as_int(kl[3]), r));
            oi[0] += s * fq0; oi[1] += s * fq1; oi[2] += s * fq2; oi[3] += s * fq3;
            const f32x4 sn = s * g4 + vv[0] * fk0 + vv[1] * fk1 + vv[2] * fk2 + vv[3] * fk3;
            __builtin_nontemporal_store(sn, (f32x4*)(Sout + sbase + (size_t)(wid + 8 * r) * 256)); }
    }
#pragma unroll
    for (int i = 0; i < 4; ++i) *(LAS f32x4*)(red + (wid * 4 + i) * 256 + 4 * lane) = oi[i];
    __syncthreads();
    if (wid < 4) { const int i = wid; f32x4 o = (f32x4){0.f, 0.f, 0.f, 0.f};
#pragma unroll
        for (int w = 0; w < 8; ++w) o += *(LAS f32x4*)(red + (w * 4 + i) * 256 + 4 * lane);
        o = o * exp2f(l2g * (float)(i + 1));
#pragma unroll
        for (int j = 0; j < 4; ++j) if (j <= i) o += vv[j] * sc[i * 4 + j];
        const float ss = wave_sum((o[0] * o[0] + o[1] * o[1]) + (o[2] * o[2] + o[3] * o[3]));
        const float rstd = 1.0f / sqrtf(ss * (1.0f / 256.0f) + EPS);
        const f32x4 w4 = *(const f32x4*)(rnw + h * 256 + 4 * lane);
        const f32x4 gt = unpack4(*(const u32x2*)(Z + (size_t)(rs + i) * DIN + 3072 + h * 256 + 4 * lane));
        f32x4 r;
#pragma unroll
        for (int e = 0; e < 4; ++e) r[e] = o[e] * rstd * w4[e] * (gt[e] / (1.0f + __expf(-gt[e])));
        *(u32x2*)(CAT + (size_t)(rs + i) * DM + h * 256 + 4 * lane) = pack4(r); }
    __syncthreads();
}

DI void pooled_items(const bf16* __restrict__ Z, const float* __restrict__ spool, bf16* __restrict__ PL, float* __restrict__ pbs, int gw, int NGW, int lane) {
    for (int it = gw; it < MT * 2; it += NGW) {
        const int row = it >> 1, col = (it & 1) * 512 + lane * 8, w = 2 << (col >> 8);
        float s[8], u0[8];
#pragma unroll
        for (int e = 0; e < 8; ++e) { s[e] = 0.f; u0[e] = 0.f; }
        float inv;
        if (row < MP) {
            const int t = row & (SEQ - 1), n = (t + 1 < w) ? t + 1 : w; inv = 1.0f / (float)n;
#pragma unroll
            for (int k = 0; k < 16; ++k) if (k < n) { const u32x4 v = *(const u32x4*)(Z + (size_t)(row - k) * DIN + 4096 + col);
                const f32x4 a = unpack4((u32x2){v.x, v.y}), c = unpack4((u32x2){v.z, v.w});
#pragma unroll
                for (int e = 0; e < 4; ++e) { s[e] += a[e]; s[4 + e] += c[e]; if (k == 0) { u0[e] = a[e]; u0[4 + e] = c[e]; } } }
        } else {
            const int rr = row - MP, b = rr >> 2, t = rr & 3; inv = 1.0f / (float)w;
#pragma unroll
            for (int k = 0; k < 16; ++k) if (k < w) { const int idx = 15 + t - k; f32x4 a, c;
                if (idx >= 15) { const u32x4 v = *(const u32x4*)(Z + (size_t)(MP + 4 * b + idx - 15) * DIN + 4096 + col); a = unpack4((u32x2){v.x, v.y}); c = unpack4((u32x2){v.z, v.w}); }
                else { const float* sp = spool + ((size_t)b * 15 + idx) * DPOOL + col; a = *(const f32x4*)sp; c = *(const f32x4*)(sp + 4); }
#pragma unroll
                for (int e = 0; e < 4; ++e) { s[e] += a[e]; s[4 + e] += c[e]; if (k == 0) { u0[e] = a[e]; u0[4 + e] = c[e]; } } }
        }
        f32x4 o0, o1;
#pragma unroll
        for (int e = 0; e < 4; ++e) { o0[e] = s[e] * inv - u0[e]; o1[e] = s[4 + e] * inv - u0[4 + e]; }
        *(u32x4*)(PL + (size_t)row * DPOOL + col) = pack8(o0, o1);
    }
    for (int it = gw; it < DECB * 11; it += NGW) { const int b = it / 11, r = it - b * 11;
        const f32x4* src = (const f32x4*)(spool + ((size_t)b * 15 + r + 4) * DPOOL) + lane; f32x4* dst = (f32x4*)(pbs + ((size_t)b * 15 + r) * DPOOL) + lane;
#pragma unroll
        for (int j = 0; j < 4; ++j) dst[64 * j] = src[64 * j]; }
}

DI void scan_items(const bf16* __restrict__ KVT, bf16* __restrict__ ST, float* __restrict__ rsp  , int gt, int NGT) {
    for (int it = gt; it < 16 * 8192; it += NGT) {
        const int bh = it >> 13, q8 = it & 8191; const float g128 = exp2f(lg2gamma(bh & 3) * 128.0f);
        f32x4 S0 = (f32x4){0.f, 0.f, 0.f, 0.f}, S1 = (f32x4){0.f, 0.f, 0.f, 0.f};
        u32x4 kv[16];
#pragma unroll
        for (int c = 0; c < 16; ++c) kv[c] = *(const u32x4*)(KVT + ((size_t)(bh * 16 + c) * 8192 + q8) * 8);
#pragma unroll
        for (int c = 0; c < 16; ++c) { S0 = S0 * g128 + unpack4((u32x2){kv[c].x, kv[c].y}); S1 = S1 * g128 + unpack4((u32x2){kv[c].z, kv[c].w});
            if (c < 15) *(u32x4*)(ST + ((size_t)(bh * 16 + c) * 8192 + q8) * 8) = pack8(S0, S1); }
        const int dv = q8 >> 5, dk = (q8 & 31) * 8;
        float* o = rsp + (size_t)bh * 65536 + (size_t)dk * 256 + dv;
        o[0] = S0[0]; o[256] = S0[1]; o[512] = S0[2]; o[768] = S0[3]; o[1024] = S1[0]; o[1280] = S1[1]; o[1536] = S1[2]; o[1792] = S1[3];
    }
}

template <int KS2, int NG>
DI void ret2_pv(unsigned aV, const bf16x8 pf, f32x4 (&oacc)[16]) {
    bf16x8 vf[4]; tr_frag4<(32 * KS2) * RP + NG * 128, 16 * RP, 32>(aV, vf);
#pragma unroll
    for (int f = 0; f < 4; ++f) oacc[4 * NG + f] = MFMA16(vf[f], pf, oacc[4 * NG + f]);
}
template <int KS2, int MG>
DI void xat_pv(unsigned aV, const bf16x8 pf, f32x4 (&oacc)[8]) {
    bf16x8 vf[4]; tr_frag4<(32 * KS2) * VP + MG * 128, 16 * VP, 32>(aV, vf);
#pragma unroll
    for (int f = 0; f < 4; ++f) oacc[4 * MG + f] = MFMA16(vf[f], pf, oacc[4 * MG + f]);
}
template <int PPR> DI void chunk_ld(u32x4 (&r)[8], const bf16* __restrict__ src, size_t src_pitch, int tid) {
    const bf16* p = src + (size_t)(tid / PPR) * src_pitch + (tid % PPR) * 8;
#pragma unroll
    for (int i = 0; i < 8; ++i) r[i] = *(const u32x4*)(p + (size_t)i * (512 / PPR) * src_pitch);
}
template <int PPR, int PITCH> DI void chunk_st(LAS unsigned char* dst, const u32x4 (&r)[8], int tid) {
    LAS unsigned char* d = dst + (tid / PPR) * PITCH + (tid % PPR) * 16;
#pragma unroll
    for (int i = 0; i < 8; ++i) *(LAS u32x4*)(d + i * (512 / PPR) * PITCH) = r[i];
}
constexpr int KP = 1040;
constexpr int XBUF = 69632;

DI void xattn_p_unit2(LAS unsigned char* big, const bf16* __restrict__ Q2, const bf16* __restrict__ MKB, const bf16* __restrict__ MVB, bf16* __restrict__ ATT, int b, int h, int qt, int tid, int wid, int lane) {
    const int g = lane >> 4, li = lane & 15, q = (lane >> 2) & 3, p = lane & 3;
    const int myrow = b * SEQ + qt * 128 + 16 * wid + li;
    LAS unsigned char* buf0 = big; LAS unsigned char* buf1 = big + XBUF;
    const bf16* kbase = MKB + (size_t)(b * NMEM) * DM + h * 512;
    const bf16* vbase = MVB + (size_t)(b * NMEM) * DM + h * 512;
    u32x4 r[8];
    chunk_ld<64>(r, kbase, DM, tid);
    bf16x8 qf[16];
#pragma unroll
    for (int ks = 0; ks < 16; ++ks) qf[ks] = *(const bf16x8*)(Q2 + (size_t)myrow * DM + h * 512 + 32 * ks + 8 * g);
    chunk_st<64, KP>(buf0, r, tid);
    __syncthreads();
    f32x4 sacc[16];
#pragma unroll
    for (int c = 0; c < 4; ++c) {
        if (c < 3) chunk_ld<64>(r, kbase + (size_t)(64 * (c + 1)) * DM, DM, tid);
        else chunk_ld<16>(r, vbase, DM, tid);
        const LAS unsigned char* cur = (c & 1) ? buf1 : buf0;
#pragma unroll
        for (int j = 0; j < 4; ++j) { const int nb = 4 * c + j; sacc[nb] = (f32x4){0.f, 0.f, 0.f, 0.f};
#pragma unroll
            for (int ks = 0; ks < 16; ++ks) sacc[nb] = MFMA16(*(const LAS bf16x8*)(cur + (16 * j + li) * KP + (32 * ks + 8 * g) * 2), qf[ks], sacc[nb]);
            __builtin_amdgcn_sched_barrier(0); }
        if (c < 3) { chunk_st<64, KP>((c & 1) ? buf0 : buf1, r, tid); __syncthreads(); }
    }
    float mx = -3.0e38f;
#pragma unroll
    for (int nb = 0; nb < 16; ++nb) mx = fmaxf(mx, fmaxf(fmaxf(sacc[nb][0], sacc[nb][1]), fmaxf(sacc[nb][2], sacc[nb][3])));
    mx = fmaxf(mx, __shfl_xor(mx, 16)); mx = fmaxf(mx, __shfl_xor(mx, 32));
    float sum = 0.f;
#pragma unroll
    for (int nb = 0; nb < 16; ++nb)
#pragma unroll
        for (int e = 0; e < 4; ++e) { const float pe = exp2f((sacc[nb][e] - mx) * 1.44269504089f); sacc[nb][e] = pe; sum += pe; }
    sum += __shfl_xor(sum, 16); sum += __shfl_xor(sum, 32);
    const float inv = 1.0f / sum;
    bf16x8 pf[8];
#pragma unroll
    for (int ks2 = 0; ks2 < 8; ++ks2) { u32x4 w; const f32x4 a = sacc[2 * ks2] * inv, c = sacc[2 * ks2 + 1] * inv;
        w.x = cvt_pk_bf16(a[0], a[1]); w.y = cvt_pk_bf16(a[2], a[3]); w.z = cvt_pk_bf16(c[0], c[1]); w.w = cvt_pk_bf16(c[2], c[3]); pf[ks2] = __builtin_bit_cast(bf16x8, w); }
    __syncthreads();
    chunk_st<16, VP>(buf0, r, tid);
    __syncthreads();
    for (int dq = 0; dq < 4; ++dq) {
        if (dq < 3) chunk_ld<16>(r, vbase + (dq + 1) * 128, DM, tid);
        const unsigned aV = lds_addr((dq & 1) ? buf1 : buf0) + (4 * g + q) * VP + 8 * p;
        f32x4 oacc[8];
#pragma unroll
        for (int mb = 0; mb < 8; ++mb) oacc[mb] = (f32x4){0.f, 0.f, 0.f, 0.f};
        xat_pv<0, 0>(aV, pf[0], oacc); xat_pv<0, 1>(aV, pf[0], oacc); xat_pv<1, 0>(aV, pf[1], oacc); xat_pv<1, 1>(aV, pf[1], oacc);
        xat_pv<2, 0>(aV, pf[2], oacc); xat_pv<2, 1>(aV, pf[2], oacc); xat_pv<3, 0>(aV, pf[3], oacc); xat_pv<3, 1>(aV, pf[3], oacc);
        xat_pv<4, 0>(aV, pf[4], oacc); xat_pv<4, 1>(aV, pf[4], oacc); xat_pv<5, 0>(aV, pf[5], oacc); xat_pv<5, 1>(aV, pf[5], oacc);
        xat_pv<6, 0>(aV, pf[6], oacc); xat_pv<6, 1>(aV, pf[6], oacc); xat_pv<7, 0>(aV, pf[7], oacc); xat_pv<7, 1>(aV, pf[7], oacc);
#pragma unroll
        for (int mb = 0; mb < 8; mb += 2) { const bool odd = (g & 1) != 0; const u32x4 w = pair16(pack4(oacc[mb]), pack4(oacc[mb + 1]), odd);
            *(u32x4*)(ATT + (size_t)myrow * DM + h * 512 + dq * 128 + 16 * (mb + (odd ? 1 : 0)) + 4 * (g & 2)) = w; }
        if (dq < 3) chunk_st<16, VP>((dq & 1) ? buf0 : buf1, r, tid);
        __syncthreads();
    }
}

DI void ret2_unit2(LAS unsigned char* big, const bf16* __restrict__ Z, const bf16* __restrict__ ST, const float* __restrict__ rnw, bf16* __restrict__ CAT, int bh, int c, int tid, int wid, int lane) {
    const int b = bh >> 2, h = bh & 3, r0 = b * SEQ + c * 128;
    const int g = lane >> 4, li = lane & 15, q = (lane >> 2) & 3, p = lane & 3;
    LAS unsigned char* buf0 = big; LAS unsigned char* buf1 = big + 128 * RP;
    const bf16* kbase = Z + (size_t)r0 * DIN + 1024 + h * 256;
    const bf16* vbase = Z + (size_t)r0 * DIN + 2048 + h * 256;
    const bf16* sbase = ST + ((size_t)(bh * 16 + (c > 0 ? c - 1 : 0)) * 256) * 256;
    const int myrow = r0 + 16 * wid + li;
    u32x4 r[8];
    chunk_ld<32>(r, kbase, DIN, tid);
    bf16x8 qf[8];
#pragma unroll
    for (int ks = 0; ks < 8; ++ks) qf[ks] = *(const bf16x8*)(Z + (size_t)myrow * DIN + h * 256 + 32 * ks + 8 * g);
    chunk_st<32, RP>(buf0, r, tid);
    __syncthreads();
    if (c > 0) chunk_ld<32>(r, sbase, 256, tid); else chunk_ld<32>(r, vbase, DIN, tid);
    f32x4 sacc[8];
#pragma unroll
    for (int jb = 0; jb < 8; ++jb) { sacc[jb] = (f32x4){0.f, 0.f, 0.f, 0.f};
        if (jb <= wid) {
#pragma unroll
            for (int ks = 0; ks < 8; ++ks) sacc[jb] = MFMA16(*(const LAS bf16x8*)(buf0 + (16 * jb + li) * RP + (32 * ks + 8 * g) * 2), qf[ks], sacc[jb]); }
        __builtin_amdgcn_sched_barrier(0); }
    const float l2g = lg2gamma(h); const int i = 16 * wid + li;
    bf16x8 pf[4];
#pragma unroll
    for (int ks2 = 0; ks2 < 4; ++ks2) { u32x4 w;
#pragma unroll
        for (int hf = 0; hf < 2; ++hf) { const int jb = 2 * ks2 + hf; float d[4];
#pragma unroll
            for (int e = 0; e < 4; ++e) { const int j = 16 * jb + 4 * g + e; d[e] = (i >= j) ? sacc[jb][e] * exp2f(l2g * (float)(i - j)) : 0.f; }
            w[2 * hf] = cvt_pk_bf16(d[0], d[1]); w[2 * hf + 1] = cvt_pk_bf16(d[2], d[3]); }
        pf[ks2] = __builtin_bit_cast(bf16x8, w); }
    chunk_st<32, RP>(buf1, r, tid);
    __syncthreads();
    f32x4 oacc[16];
#pragma unroll
    for (int nb = 0; nb < 16; ++nb) oacc[nb] = (f32x4){0.f, 0.f, 0.f, 0.f};
    if (c > 0) {
        chunk_ld<32>(r, sbase + (size_t)128 * 256, 256, tid);
#pragma unroll
        for (int nb = 0; nb < 8; ++nb) {
#pragma unroll
            for (int ks = 0; ks < 8; ++ks) oacc[nb] = MFMA16(*(const LAS bf16x8*)(buf1 + (16 * nb + li) * RP + (32 * ks + 8 * g) * 2), qf[ks], oacc[nb]);
            __builtin_amdgcn_sched_barrier(0); }
        chunk_st<32, RP>(buf0, r, tid);
        __syncthreads();
        chunk_ld<32>(r, vbase, DIN, tid);
#pragma unroll
        for (int nb = 0; nb < 8; ++nb) {
#pragma unroll
            for (int ks = 0; ks < 8; ++ks) oacc[8 + nb] = MFMA16(*(const LAS bf16x8*)(buf0 + (16 * nb + li) * RP + (32 * ks + 8 * g) * 2), qf[ks], oacc[8 + nb]);
            __builtin_amdgcn_sched_barrier(0); }
        const float dq = exp2f(l2g * (float)(i + 1));
#pragma unroll
        for (int nb = 0; nb < 16; ++nb) oacc[nb] = oacc[nb] * dq;
        chunk_st<32, RP>(buf1, r, tid);
        __syncthreads();
    }
    const unsigned aV = lds_addr(buf1) + (4 * g + q) * RP + 8 * p;
    { ret2_pv<0, 0>(aV, pf[0], oacc); ret2_pv<0, 1>(aV, pf[0], oacc); ret2_pv<0, 2>(aV, pf[0], oacc); ret2_pv<0, 3>(aV, pf[0], oacc); }
    if (wid >= 2) { ret2_pv<1, 0>(aV, pf[1], oacc); ret2_pv<1, 1>(aV, pf[1], oacc); ret2_pv<1, 2>(aV, pf[1], oacc); ret2_pv<1, 3>(aV, pf[1], oacc); }
    if (wid >= 4) { ret2_pv<2, 0>(aV, pf[2], oacc); ret2_pv<2, 1>(aV, pf[2], oacc); ret2_pv<2, 2>(aV, pf[2], oacc); ret2_pv<2, 3>(aV, pf[2], oacc); }
    if (wid >= 6) { ret2_pv<3, 0>(aV, pf[3], oacc); ret2_pv<3, 1>(aV, pf[3], oacc); ret2_pv<3, 2>(aV, pf[3], oacc); ret2_pv<3, 3>(aV, pf[3], oacc); }
    float ss = 0.f;
#pragma unroll
    for (int nb = 0; nb < 16; ++nb) ss += (oacc[nb][0] * oacc[nb][0] + oacc[nb][1] * oacc[nb][1]) + (oacc[nb][2] * oacc[nb][2] + oacc[nb][3] * oacc[nb][3]);
    ss += __shfl_xor(ss, 16); ss += __shfl_xor(ss, 32);
    const float rstd = 1.0f / sqrtf(ss * (1.0f / 256.0f) + EPS);
#pragma unroll
    for (int nb = 0; nb < 16; ++nb) { const int dv = h * 256 + 16 * nb + 4 * g;
        const f32x4 w4 = *(const f32x4*)(rnw + dv); const f32x4 gt = unpack4(*(const u32x2*)(Z + (size_t)myrow * DIN + 3072 + dv));
        f32x4 rr;
#pragma unroll
        for (int e = 0; e < 4; ++e) rr[e] = oacc[nb][e] * rstd * w4[e] * (gt[e] / (1.0f + __expf(-gt[e])));
        *(u32x2*)(CAT + (size_t)myrow * DM + dv) = pack4(rr); }
    __syncthreads();
}

DI void xs_scores(const f32x4 (&x)[16], const f32x4 (&qa)[4], const f32x4 (&qb)[4], LAS float* sc, int keybase, int lane) {
    float v[32];
#pragma unroll
    for (int j = 0; j < 8; ++j)
#pragma unroll
        for (int t = 0; t < 4; ++t) { const f32x4 m = x[2 * j] * qa[t] + x[2 * j + 1] * qb[t]; v[4 * j + t] = (m[0] + m[1]) + (m[2] + m[3]); }
    const bool h32 = (lane & 32) != 0, h16 = (lane & 16) != 0, h8 = (lane & 8) != 0, h4 = (lane & 4) != 0, h2 = (lane & 2) != 0;
#pragma unroll
    for (int i = 0; i < 16; ++i) { const float keep = h32 ? v[i + 16] : v[i], send = h32 ? v[i] : v[i + 16]; v[i] = keep + __shfl_xor(send, 32); }
#pragma unroll
    for (int i = 0; i < 8; ++i) { const float keep = h16 ? v[i + 8] : v[i], send = h16 ? v[i] : v[i + 8]; v[i] = keep + __shfl_xor(send, 16); }
#pragma unroll
    for (int i = 0; i < 4; ++i) { const float keep = h8 ? v[i + 4] : v[i], send = h8 ? v[i] : v[i + 4]; v[i] = keep + __shfl_xor(send, 8); }
#pragma unroll
    for (int i = 0; i < 2; ++i) { const float keep = h4 ? v[i + 2] : v[i], send = h4 ? v[i] : v[i + 2]; v[i] = keep + __shfl_xor(send, 4); }
    { const float keep = h2 ? v[1] : v[0], send = h2 ? v[0] : v[1]; v[0] = keep + __shfl_xor(send, 2); }
    v[0] += __shfl_xor(v[0], 1);
    const int idx = ((lane >> 5) & 1) * 16 + ((lane >> 4) & 1) * 8 + ((lane >> 3) & 1) * 4 + ((lane >> 2) & 1) * 2 + ((lane >> 1) & 1);
    if (!(lane & 1)) sc[(idx & 3) * 256 + keybase + (idx >> 2)] = v[0];
}
DI void xattn_s_unit(LAS unsigned char* big, const bf16* __restrict__ Q2, const float* __restrict__ Kc, const float* __restrict__ Vc, bf16* __restrict__ ATT, int b, int h, int tid, int wid, int lane) {
    LAS float* sc = (LAS float*)big; LAS float* red = sc + 1024;
    const int rs = MP + 4 * b;
    const float* ku = Kc + ((size_t)b * NMEM + 32 * wid) * DM + h * 512;
    const float* vu = Vc + ((size_t)b * NMEM + 32 * wid) * DM + h * 512;
    const unsigned vlo = (unsigned)(4 * lane);
    f32x4 xa[16], xb[16];
#define XS_LD(dst, base, bt) do { _Pragma("unroll") for (int j = 0; j < 8; ++j) { const float* vr_ = base + (8 * (bt) + j) * DM; \
        dst[2 * j] = __builtin_nontemporal_load((const f32x4*)(vr_ + vlo)); dst[2 * j + 1] = __builtin_nontemporal_load((const f32x4*)(vr_ + 256 + vlo)); } } while (0)
    XS_LD(xa, ku, 0);
    f32x4 qa[4], qb[4];
#pragma unroll
    for (int t = 0; t < 4; ++t) { const bf16* qp = Q2 + (size_t)(rs + t) * DM + h * 512 + 4 * lane; qa[t] = unpack4(*(const u32x2*)qp); qb[t] = unpack4(*(const u32x2*)(qp + 256)); }
    __syncthreads();
    XS_LD(xb, ku, 1); xs_scores(xa, qa, qb, sc, 32 * wid, lane); __builtin_amdgcn_sched_barrier(0);
    XS_LD(xa, ku, 2); xs_scores(xb, qa, qb, sc, 32 * wid + 8, lane); __builtin_amdgcn_sched_barrier(0);
    XS_LD(xb, ku, 3); xs_scores(xa, qa, qb, sc, 32 * wid + 16, lane); __builtin_amdgcn_sched_barrier(0);
    XS_LD(xa, vu, 0); xs_scores(xb, qa, qb, sc, 32 * wid + 24, lane); __builtin_amdgcn_sched_barrier(0);
    __syncthreads();
    if (wid < 4) { LAS f32x4* sp = (LAS f32x4*)(sc + wid * 256) + lane; f32x4 s = *sp;
        const float mx = wave_max(fmaxf(fmaxf(s[0], s[1]), fmaxf(s[2], s[3])));
#pragma unroll
        for (int e = 0; e < 4; ++e) s[e] = exp2f((s[e] - mx) * 1.44269504089f);
        const float inv = 1.0f / wave_sum((s[0] + s[1]) + (s[2] + s[3]));
        *sp = s * inv; }
    __syncthreads();
    f32x4 oa[4], ob[4];
#pragma unroll
    for (int t = 0; t < 4; ++t) { oa[t] = (f32x4){0.f, 0.f, 0.f, 0.f}; ob[t] = (f32x4){0.f, 0.f, 0.f, 0.f}; }
#define XS_PV(src, bt) do { _Pragma("unroll") for (int j = 0; j < 8; ++j) { _Pragma("unroll") for (int t = 0; t < 4; ++t) { const float pw = sc[t * 256 + 32 * wid + 8 * (bt) + j]; oa[t] += src[2 * j] * pw; ob[t] += src[2 * j + 1] * pw; } } \
        __builtin_amdgcn_sched_barrier(0); } while (0)
    XS_LD(xb, vu, 1); XS_PV(xa, 0);
    XS_LD(xa, vu, 2); XS_PV(xb, 1);
    XS_LD(xb, vu, 3); XS_PV(xa, 2);
    XS_PV(xb, 3);
#undef XS_LD
#undef XS_PV
#pragma unroll
    for (int t = 0; t < 4; ++t) { *(LAS f32x4*)(red + (wid * 4 + t) * 512 + 4 * lane) = oa[t]; *(LAS f32x4*)(red + (wid * 4 + t) * 512 + 256 + 4 * lane) = ob[t]; }
    __syncthreads();
    { const int t = tid >> 7, d4 = (tid & 127) * 4; f32x4 o = (f32x4){0.f, 0.f, 0.f, 0.f};
#pragma unroll
        for (int w = 0; w < 8; ++w) o += *(LAS f32x4*)(red + (w * 4 + t) * 512 + d4);
        *(u32x2*)(ATT + (size_t)(rs + t) * DM + h * 512 + d4) = pack4(o); }
    __syncthreads();
}

template <int PPR> DI void hchunk_ld(u32x4 (&r)[4], const bf16* __restrict__ src, size_t src_pitch, int tid) {
    const bf16* p = src + (size_t)(tid / PPR) * src_pitch + (tid % PPR) * 8;
#pragma unroll
    for (int i = 0; i < 4; ++i) r[i] = *(const u32x4*)(p + (size_t)i * (512 / PPR) * src_pitch);
}
template <int PPR, int PITCH> DI void hchunk_st(LAS unsigned char* dst, const u32x4 (&r)[4], int tid) {
    LAS unsigned char* d = dst + (tid / PPR) * PITCH + (tid % PPR) * 16;
#pragma unroll
    for (int i = 0; i < 4; ++i) *(LAS u32x4*)(d + i * (512 / PPR) * PITCH) = r[i];
}
constexpr int SG3_BUF = 2 * 64 * RP;
template <class Epi>
DI void sgemm3_tile(LAS unsigned char* big, const bf16* __restrict__ A, size_t lda, const bf16* __restrict__ Bt, int K, int row0, int col0, const Epi& E, int tid, int wid, int lane) {
    const int g = lane >> 4, li = lane & 15, wm = wid & 3, wn = wid >> 2;
    const bf16* ab = A + (size_t)row0 * lda; const bf16* bb = Bt + (size_t)col0 * K;
    const int n = K >> 8;
    u32x4 a0[4], b0[4], a1[4], b1[4];
    hchunk_ld<32>(a0, ab, lda, tid); hchunk_ld<32>(b0, bb, (size_t)K, tid);
    hchunk_ld<32>(a1, ab + 256, lda, tid); hchunk_ld<32>(b1, bb + 256, (size_t)K, tid);
    f32x4 acc[2] = {(f32x4){0.f, 0.f, 0.f, 0.f}, (f32x4){0.f, 0.f, 0.f, 0.f}};
    const int fao = (16 * wm + li) * RP + 16 * g, fbo = 64 * RP + (32 * wn + li) * RP + 16 * g;
#define SG3_ST(bufi, ra_, rb_) do { hchunk_st<32, RP>(big + (bufi) * SG3_BUF, ra_, tid); hchunk_st<32, RP>(big + (bufi) * SG3_BUF + 64 * RP, rb_, tid); } while (0)
#define SG3_LD(ra_, rb_, c_) do { hchunk_ld<32>(ra_, ab + (size_t)(c_) * 256, lda, tid); hchunk_ld<32>(rb_, bb + (size_t)(c_) * 256, (size_t)K, tid); } while (0)
#define SG3_MMA(bufi) do { const LAS unsigned char* fa_ = big + (bufi) * SG3_BUF + fao; const LAS unsigned char* fb_ = big + (bufi) * SG3_BUF + fbo; \
        _Pragma("unroll") for (int ks = 0; ks < 8; ++ks) { const bf16x8 af = *(const LAS bf16x8*)(fa_ + 64 * ks); \
            _Pragma("unroll") for (int nb = 0; nb < 2; ++nb) acc[nb] = MFMA16(*(const LAS bf16x8*)(fb_ + 16 * nb * RP + 64 * ks), af, acc[nb]); } } while (0)
    __syncthreads();
    SG3_ST(0, a0, b0);
    if (2 < n) SG3_LD(a0, b0, 2);
    __syncthreads();
    for (int c = 0; c < n; c += 2) {
        SG3_ST(1, a1, b1);
        if (c + 3 < n) SG3_LD(a1, b1, c + 3);
        SG3_MMA(0);
        __syncthreads();
        if (c + 2 < n) { SG3_ST(0, a0, b0); if (c + 4 < n) SG3_LD(a0, b0, c + 4); }
        SG3_MMA(1);
        __syncthreads();
    }
#undef SG3_ST
#undef SG3_LD
#undef SG3_MMA
    E(row0 + 16 * wm + li, col0 + 32 * wn + 4 * g, acc[0], acc[1], g, (col0 >> 6) * 2 + wn);
}
constexpr int SG4_BUF = 2 * 128 * VP;
template <class Epi>
DI void sgemm4_tile(LAS unsigned char* big, const bf16* __restrict__ A, size_t lda, const bf16* __restrict__ Bt, size_t ldb, int kbeg, int kend, int row0, int col0, const Epi& E, int tid, int wid, int lane) {
    const int g = lane >> 4, li = lane & 15, wm = wid & 3, wn = wid >> 2;
    const bf16* ab = A + (size_t)row0 * lda + kbeg; const bf16* bb = Bt + (size_t)col0 * ldb + kbeg;
    const int n = (kend - kbeg) >> 7;
    u32x4 a0[4], b0[4], a1[4], b1[4];
    hchunk_ld<16>(a0, ab, lda, tid); hchunk_ld<16>(b0, bb, ldb, tid);
    hchunk_ld<16>(a1, ab + 128, lda, tid); hchunk_ld<16>(b1, bb + 128, ldb, tid);
    f32x4 acc[2][4];
#pragma unroll
    for (int mb = 0; mb < 2; ++mb)
#pragma unroll
        for (int nb = 0; nb < 4; ++nb) acc[mb][nb] = (f32x4){0.f, 0.f, 0.f, 0.f};
    const int fao = (32 * wm + li) * VP + 16 * g, fbo = 128 * VP + (64 * wn + li) * VP + 16 * g;
#define SG4_ST(bufi, ra_, rb_) do { hchunk_st<16, VP>(big + (bufi) * SG4_BUF, ra_, tid); hchunk_st<16, VP>(big + (bufi) * SG4_BUF + 128 * VP, rb_, tid); } while (0)
#define SG4_LD(ra_, rb_, c_) do { hchunk_ld<16>(ra_, ab + (size_t)(c_) * 128, lda, tid); hchunk_ld<16>(rb_, bb + (size_t)(c_) * 128, ldb, tid); } while (0)
#define SG4_MMA(bufi) do { const LAS unsigned char* fa_ = big + (bufi) * SG4_BUF + fao; const LAS unsigned char* fb_ = big + (bufi) * SG4_BUF + fbo; \
        _Pragma("unroll") for (int ks = 0; ks < 4; ++ks) { const bf16x8 x0 = *(const LAS bf16x8*)(fa_ + 64 * ks), x1 = *(const LAS bf16x8*)(fa_ + 16 * VP + 64 * ks); \
            _Pragma("unroll") for (int nb = 0; nb < 4; ++nb) { const bf16x8 bfr = *(const LAS bf16x8*)(fb_ + 16 * nb * VP + 64 * ks); \
                acc[0][nb] = MFMA16(bfr, x0, acc[0][nb]); acc[1][nb] = MFMA16(bfr, x1, acc[1][nb]); } } } while (0)
    __syncthreads();
    SG4_ST(0, a0, b0);
    if (2 < n) SG4_LD(a0, b0, 2);
    __syncthreads();
    for (int c = 0; c < n; c += 2) {
        SG4_ST(1, a1, b1);
        if (c + 3 < n) SG4_LD(a1, b1, c + 3);
        SG4_MMA(0);
        __syncthreads();
        if (c + 2 < n) { SG4_ST(0, a0, b0); if (c + 4 < n) SG4_LD(a0, b0, c + 4); }
        SG4_MMA(1);
        __syncthreads();
    }
#undef SG4_ST
#undef SG4_LD
#undef SG4_MMA
#pragma unroll
    for (int mb = 0; mb < 2; ++mb)
#pragma unroll
        for (int pr = 0; pr < 2; ++pr) E(row0 + 32 * wm + 16 * mb + li, col0 + 64 * wn + 32 * pr + 4 * g, acc[mb][2 * pr], acc[mb][2 * pr + 1], g, (col0 + 64 * wn + 32 * pr) >> 5);
}
struct SEpiPart { float* part;
    DI void operator()(int row, int col, f32x4 a0, f32x4 a1, int, int) const { float* o = part + (size_t)(row - MP) * DM + col; *(f32x4*)o = a0; *(f32x4*)(o + 16) = a1; } };
struct SEpiRes { const float* basef; const bf16* baseb; bf16* xb; float* ssq;
    DI void operator()(int row, int col, f32x4 a0, f32x4 a1, int g, int slot) const { const size_t o = (size_t)row * DM + col;
        f32x4 b0, b1;
        if (basef) { b0 = *(const f32x4*)(basef + o); b1 = *(const f32x4*)(basef + o + 16); } else { b0 = unpack4(*(const u32x2*)(baseb + o)); b1 = unpack4(*(const u32x2*)(baseb + o + 16)); }
        const f32x4 v0 = b0 + a0, v1 = b1 + a1;
        *(u32x2*)(xb + o) = pack4(v0); *(u32x2*)(xb + o + 16) = pack4(v1);
        float sq = ((v0[0] * v0[0] + v0[1] * v0[1]) + (v0[2] * v0[2] + v0[3] * v0[3])) + ((v1[0] * v1[0] + v1[1] * v1[1]) + (v1[2] * v1[2] + v1[3] * v1[3]));
        sq += __shfl_xor(sq, 16); sq += __shfl_xor(sq, 32);
        if (g == 0) ssq[(size_t)row * 64 + slot] = sq; } };
template <int ACT> struct SEpiB { bf16* O; int ldc; float scale; const float* ssq;
    DI void operator()(int row, int col, f32x4 a0, f32x4 a1, int g, int slot) const { const float rs = scale * row_rstd<64>(ssq, row, g); a0 = a0 * rs; a1 = a1 * rs;
        if (ACT == 1) { a0 = __builtin_elementwise_max(a0, (f32x4){0.f, 0.f, 0.f, 0.f}); a1 = __builtin_elementwise_max(a1, (f32x4){0.f, 0.f, 0.f, 0.f}); a0 = a0 * a0; a1 = a1 * a1; }
        *(u32x2*)(O + (size_t)row * ldc + col) = pack4(a0); *(u32x2*)(O + (size_t)row * ldc + col + 16) = pack4(a1); } };

constexpr int PH_PER_LAYER = 10, NPH = 2 + 2 * PH_PER_LAYER;
constexpr int CW_BAR = 1024;
static_assert((CW_BAR + XCD_BAR_WORDS) * 4 <= (int)CTL_ZERO_BYTES, "control words inside the memset region");
struct Args { const float* in[23]; float* out; unsigned char* ws; int ph_lo, ph_hi, use_bar, pad; };

typedef const Args __attribute__((address_space(4)))* ArgsCP;
DI ArgsCP argp() { ArgsCP p = (ArgsCP)__builtin_amdgcn_kernarg_segment_ptr(); asm volatile("" : "+s"(p)); return p; }
__global__ void __launch_bounds__(512, 2) fwd(Args args_unused) {
#define args (*argp())
    extern __shared__ __attribute__((aligned(16))) unsigned char lds_raw[];
    LAS unsigned char* lds = (LAS unsigned char*)lds_raw;
    LAS unsigned char* big = lds + LDS_BIG;
    if (threadIdx.x < 256) ((LAS unsigned*)lds)[threadIdx.x] = 0u;
    __syncthreads();
    if (args.use_bar) (void)xcd_barrier_post((unsigned*)(args.ws + WS_CTL) + CW_BAR, (volatile LAS unsigned*)lds);
    const int lo = args.ph_lo, hi = args.ph_hi;
#ifndef ONLY
#define ONLY -1
#endif
#define IN(k) ((ONLY < 0 || ONLY == ((k) == 0 ? 0 : 1 + ((k) - 1) % PH_PER_LAYER)) && lo <= (k) && (k) < hi)
#ifndef PROBE_REP
#define PROBE_REP -1
#endif
#define NREP(kk) ((PROBE_REP) == (kk) ? 2 : 1)
#define SEAM(k) do { if (IN(k) && IN((k) + 1)) { XcdBarrier bb; bb.bar = (unsigned*)(ws + WS_CTL) + CW_BAR; bb.x = xb_xcc_id(); bb.st = (volatile LAS unsigned*)lds; xcd_barrier(bb); } } while (0)
#define TIDS() int tid = threadIdx.x; asm volatile("" : "+v"(tid)); const int lane = tid & 63, wid = __builtin_amdgcn_readfirstlane(tid >> 6); \
    int G = gridDim.x, bid = blockIdx.x; asm volatile("" : "+s"(G), "+s"(bid)); const int gw = bid * 8 + wid, NGW = G * 8, gt = bid * 512 + tid, NGT = G * 512; (void)lane; (void)gw; (void)NGW; (void)gt; (void)NGT
#define ws (args.ws)
#define out (args.out)
#define cosT ((float*)(ws + WS_COS))
#define sinT ((float*)(ws + WS_SIN))
#define XN ((bf16*)(ws + WS_XN))
#define Z ((bf16*)(ws + WS_Z))
#define KD ((bf16*)(ws + WS_KD))
#define PL ((bf16*)(ws + WS_PL))
#define CAT ((bf16*)(ws + WS_CAT))
#define Q2 ((bf16*)(ws + WS_Q2))
#define ATT ((bf16*)(ws + WS_ATT))
#define XA ((float*)(ws + WS_XA))
#define UP ((bf16*)(ws + WS_UP))
#define MN ((bf16*)(ws + WS_MN))
#define MKB ((bf16*)(ws + WS_MKB))
#define MVB ((bf16*)(ws + WS_MVB))
#define KVT ((bf16*)(ws + WS_KVT))
#define ST ((bf16*)(ws + WS_ST))
#define WL(off) (ws + WS_W + (size_t)l * W_LAYER + (off))

#define RETIDS() int tid_ = threadIdx.x; asm volatile("" : "+v"(tid_)); const int lane_ = tid_ & 63, wid_ = __builtin_amdgcn_readfirstlane(tid_ >> 6), gw_ = bid * 8 + wid_; (void)lane_; (void)gw_
#define SSQ(p) ((float*)(ws + WS_SSQ + (size_t)((p) & 1) * SSQ_BYTES))
#define PHASE(kk) for (int rep = 0; rep < NREP(kk); ++rep)
#define PHASE_VARS(kk) TIDS(); bf16* const XNO = (rep + 1 < NREP(kk)) ? (bf16*)(ws + WS_DUMMY) : XN; (void)XNO
    if (IN(0)) PHASE(0) {
        TIDS();
        constexpr int C_IN = 16 * 40, C_SQ = 16 * 16, C_UP = 16 * 64, C_DN = 64 * 16, C_PW = 16, C_LAYER = C_IN + 5 * C_SQ + C_UP + C_DN + C_PW;
#define CITEM(it_, t_) do { const int l_ = (it_) / C_LAYER; int r_ = (it_) - l_ * C_LAYER; unsigned char* wl_ = ws + WS_W + (size_t)l_ * W_LAYER; \
            if (r_ < C_IN) { t_ = CItem{args.in[8] + (size_t)l_ * DM * DIN, (bf16*)(wl_ + WO_IN), args.in[7] + (size_t)l_ * DM, DM, DIN, r_}; break; } r_ -= C_IN; \
            if (r_ < C_SQ) { t_ = CItem{args.in[12] + (size_t)l_ * DM * DM, (bf16*)(wl_ + WO_OUT), nullptr, DM, DM, r_}; break; } r_ -= C_SQ; \
            if (r_ < C_SQ) { t_ = CItem{args.in[15] + (size_t)l_ * DM * DM, (bf16*)(wl_ + WO_XQ), args.in[13] + (size_t)l_ * DM, DM, DM, r_}; break; } r_ -= C_SQ; \
            if (r_ < C_SQ) { t_ = CItem{args.in[16] + (size_t)l_ * DM * DM, (bf16*)(wl_ + WO_MKV), nullptr, DM, DM, r_}; break; } r_ -= C_SQ; \
            if (r_ < C_SQ) { t_ = CItem{args.in[17] + (size_t)l_ * DM * DM, (bf16*)(wl_ + WO_MKV) + (size_t)DM * DM, nullptr, DM, DM, r_}; break; } r_ -= C_SQ; \
            if (r_ < C_SQ) { t_ = CItem{args.in[18] + (size_t)l_ * DM * DM, (bf16*)(wl_ + WO_XO), nullptr, DM, DM, r_}; break; } r_ -= C_SQ; \
            if (r_ < C_UP) { t_ = CItem{args.in[20] + (size_t)l_ * DM * DFF, (bf16*)(wl_ + WO_UP), args.in[19] + (size_t)l_ * DM, DM, DFF, r_}; break; } r_ -= C_UP; \
            if (r_ < C_DN) { t_ = CItem{args.in[21] + (size_t)l_ * DFF * DM, (bf16*)(wl_ + WO_DN), nullptr, DFF, DM, r_}; break; } r_ -= C_DN; \
            t_ = CItem{args.in[10] + (size_t)(l_ * 4 + (r_ >> 2)) * 65536, (bf16*)(wl_ + WO_POOL) + (size_t)(r_ >> 2) * 65536, nullptr, 256, 256, r_ & 3}; } while (0)
        { LAS float* scr = (LAS float*)big;
          CItem ta, tb; f32x4 va[8], vb[8]; int it = bid;
          if (it < 2 * C_LAYER) { CITEM(it, ta); citem_load(ta, va, tid); }
          if (it + G < 2 * C_LAYER) { CITEM(it + G, tb); citem_load(tb, vb, tid); }
          while (it < 2 * C_LAYER) {
              citem_to_lds(ta, va, scr, tid); __syncthreads();
              const CItem tc = ta;
              if (it + 2 * G < 2 * C_LAYER) { CITEM(it + 2 * G, ta); citem_load(ta, va, tid); }
              citem_store(tc, scr, tid); __syncthreads();
              it += G; if (it >= 2 * C_LAYER) break;
              citem_to_lds(tb, vb, scr, tid); __syncthreads();
              const CItem td = tb;
              if (it + 2 * G < 2 * C_LAYER) { CITEM(it + 2 * G, tb); citem_load(tb, vb, tid); }
              citem_store(td, scr, tid); __syncthreads();
              it += G; } }
#undef CITEM
        for (int idx = gt; idx < NPOS * 128; idx += NGT) { const int p = idx >> 7, d = idx & 127;
            const double pos = (double)(p < SEQ ? p : 16384 + (p - SEQ));
            const double inv = exp2(-(double)d * (13.287712379549449 / 128.0));
            double rev = pos * inv * 0.15915494309189535; rev -= floor(rev);
            const float rf = (float)rev;
            cosT[idx] = __builtin_amdgcn_cosf(rf); sinT[idx] = __builtin_amdgcn_sinf(rf); }
        for (int m = gw; m < MT; m += NGW) { const float* xr = m < MP ? args.in[0] + (size_t)m * DM : args.in[1] + (size_t)(m - MP) * DM; row_to_xb(xr, XN + (size_t)m * DM, SSQ(0) + (size_t)m * 64, m < MP ? 32 : 64, lane); }
        for (int m = gw; m < 2 * 1024; m += NGW) { const int l = m >> 10, r = m & 1023; rms_row_bf16(args.in[2] + (size_t)r * DM, args.in[14] + (size_t)l * DM, MN + (size_t)m * DM, lane); }
    }
    SEAM(0);

    for (int l = 0; l < 2; ++l) {
        const int P = 1 + PH_PER_LAYER * l;
        if (IN(P + 0)) PHASE(1) { PHASE_VARS(1);
            { pg8::Gemm g{XN, (const bf16*)WL(WO_IN), MT, DIN, DM, DM, 0}; pg8::StaticOrder S; S.init(MT, DIN, G, bid);
              EpiZ E{Z, KD, cosT, sinT, out + OUT_PBP + (size_t)l * NB * 15 * DPOOL, out + OUT_PBS + (size_t)l * DECB * 15 * DPOOL, SSQ(3 * l)};
              pg8::gemm_phase<EpiZ, pg8::StaticOrder, true, true>(big, g, S, E); }
            { pg8::Gemm g{MN + (size_t)l * 1024 * DM, (const bf16*)WL(WO_MKV), 1024, 4096, DM, DM, 0}; pg8::StaticOrder S; S.init(1024, 4096, G, G - 1 - bid);
              EpiMemKV E{out + OUT_MK + (size_t)l * 1024 * DM, out + OUT_MV + (size_t)l * 1024 * DM, MKB, MVB};
              pg8::gemm_phase<EpiMemKV, pg8::StaticOrder, true, true>(big, g, S, E); }
        }
        SEAM(P + 0);
        if (IN(P + 1)) PHASE(2) { PHASE_VARS(2);
            for (int pass = 0; pass < 2; ++pass) {
                if ((pass == 0) == ((bid & 1) == 1)) {
                    for (int u = bid; u < 512; u += G) sret_unit(big, Z, args.in[3] + (size_t)l * DECB * 4 * 65536, out + OUT_RSS + (size_t)l * DECB * 4 * 65536, args.in[9] + (size_t)l * DRET, CAT, u >> 2, u & 3, tid, wid, lane);
                } else {
                    for (int u = bid; u < 256; u += G) kvt_unit(big, Z, KD, KVT, u >> 4, u & 15, tid, wid, lane);
                    pooled_items(Z, args.in[4] + (size_t)l * DECB * 15 * DPOOL, PL, out + OUT_PBS + (size_t)l * DECB * 15 * DPOOL, gw, NGW, lane);
                }
            }
        }
        SEAM(P + 1);
        if (IN(P + 2)) PHASE(3) { PHASE_VARS(3);
            scan_items(KVT, ST, out + OUT_RSP + (size_t)l * 16 * 65536, gt, NGT);
            { pg8::Gemm g{PL, (const bf16*)WL(WO_POOL), MT, DPOOL, 256, DPOOL, 256}; pg8::StaticOrder S; S.init(MT, DPOOL, G, bid);
              EpiB<2> E{CAT, DM, 1.0f, args.in[11] + (size_t)l * DPOOL, DRET, nullptr};
              pg8::gemm_phase<EpiB<2>, pg8::StaticOrder, true, true>(big, g, S, E); }
        }
        SEAM(P + 2);
        if (IN(P + 3)) PHASE(4) { PHASE_VARS(4);
            for (int u = bid; u < 256; u += G) ret2_unit2(big, Z, ST, args.in[9] + (size_t)l * DRET, CAT, u >> 4, u & 15, tid, wid, lane);
            { SEpiRes E{l == 0 ? args.in[1] - (size_t)MP * DM : nullptr, XN, XNO, SSQ(3 * l + 1)};
              for (int u = bid; u < 256; u += G) sgemm3_tile(big, CAT, DM, (const bf16*)WL(WO_OUT), DM, MP + (u >> 5) * 64, (u & 31) * 64, E, tid, wid, lane); }
        }
        SEAM(P + 3);
        if (IN(P + 4)) PHASE(5) { PHASE_VARS(5);
            pg8::Gemm g{CAT, (const bf16*)WL(WO_OUT), MP, DM, DM, DM, 0}; pg8::StaticOrder S; S.init(MP, DM, G, bid);
            EpiRes E{l == 0 ? args.in[0] : nullptr, XN, XNO, SSQ(3 * l + 1)};
            pg8::gemm_phase<EpiRes, pg8::StaticOrder, true, true>(big, g, S, E);
            { RETIDS(); SEpiB<0> E2{Q2, DM, 0.044194173824159216f, SSQ(3 * l + 1)};
              for (int u = bid; u < 256; u += G) sgemm3_tile(big, XN, DM, (const bf16*)WL(WO_XQ), DM, MP + (u >> 5) * 64, (u & 31) * 64, E2, tid_, wid_, lane_); }
        }
        SEAM(P + 4);
        if (IN(P + 5)) PHASE(6) { PHASE_VARS(6);
            pg8::Gemm g{XN, (const bf16*)WL(WO_XQ), MP, DM, DM, DM, 0}; pg8::StaticOrder S; S.init(MP, DM, G, bid);
            EpiB<0> E{Q2, DM, 0.044194173824159216f, nullptr, 0, SSQ(3 * l + 1)};
            if (bid & 1) { for (int u = bid; u < 512; u += G) xattn_s_unit(big, Q2, args.in[5] + (size_t)l * DECB * NMEM * DM, args.in[6] + (size_t)l * DECB * NMEM * DM, ATT, u >> 2, u & 3, tid, wid, lane); }
            pg8::gemm_phase<EpiB<0>, pg8::StaticOrder, true, true>(big, g, S, E);
            if (!(bid & 1)) { RETIDS(); for (int u = bid; u < 512; u += G) xattn_s_unit(big, Q2, args.in[5] + (size_t)l * DECB * NMEM * DM, args.in[6] + (size_t)l * DECB * NMEM * DM, ATT, u >> 2, u & 3, tid_, wid_, lane_); }
        }
        SEAM(P + 5);
        if (IN(P + 6)) PHASE(7) { PHASE_VARS(7);
            for (int u = bid; u < 256; u += G) xattn_p_unit2(big, Q2, MKB, MVB, ATT, u >> 6, (u >> 4) & 3, u & 15, tid, wid, lane);
            { SEpiRes E{nullptr, XN, XNO, SSQ(3 * l + 2)};
              for (int u = bid; u < 256; u += G) sgemm3_tile(big, ATT, DM, (const bf16*)WL(WO_XO), DM, MP + (u >> 5) * 64, (u & 31) * 64, E, tid, wid, lane); }
        }
        SEAM(P + 6);
        if (IN(P + 7)) PHASE(8) { PHASE_VARS(8);
            pg8::Gemm g{ATT, (const bf16*)WL(WO_XO), MP, DM, DM, DM, 0}; pg8::StaticOrder S; S.init(MP, DM, G, bid);
            EpiRes E{nullptr, XN, XNO, SSQ(3 * l + 2)};
            pg8::gemm_phase<EpiRes, pg8::StaticOrder, true, true>(big, g, S, E);
            { RETIDS(); SEpiB<1> E2{UP, DFF, 1.0f, SSQ(3 * l + 2)};
#ifndef PROBE_UPS
#define PROBE_UPS 1
#endif
              for (int rp = 0; rp < PROBE_UPS; ++rp)
              for (int u = bid; u < 256; u += G) sgemm4_tile(big, XN, DM, (const bf16*)WL(WO_UP), DM, 0, DM, MP + (u >> 6) * 128, (u & 63) * 128, E2, tid_, wid_, lane_); }
        }
        SEAM(P + 7);
        if (IN(P + 8)) PHASE(9) { PHASE_VARS(9);
            pg8::Gemm g{XN, (const bf16*)WL(WO_UP), MP, DFF, DM, DM, 0}; pg8::StaticOrder S; S.init(MP, DFF, G, bid);
            EpiB<1> E{UP, DFF, 1.0f, nullptr, 0, SSQ(3 * l + 2)};
            pg8::gemm_phase<EpiB<1>, pg8::StaticOrder, true, true>(big, g, S, E);
            { RETIDS();
            for (int u = bid; u < 256; u += G) { const int t = u >> 2, kq = u & 3; SEpiPart E2{(float*)(ws + WS_PART) + (size_t)kq * MS * DM};
                sgemm4_tile(big, UP, DFF, (const bf16*)WL(WO_DN), DFF, kq * 2048, kq * 2048 + 2048, MP + (t >> 4) * 128, (t & 15) * 128, E2, tid_, wid_, lane_); } }
        }
        SEAM(P + 8);
        if (IN(P + 9)) PHASE(10) { PHASE_VARS(10);
            pg8::Gemm g{UP, (const bf16*)WL(WO_DN), MP, DM, DFF, DFF, 0}; pg8::StaticOrder S; S.init(MP, DM, G, bid);
            EpiRes E{nullptr, XN, XNO, SSQ(3 * l + 3)};
            pg8::gemm_phase<EpiRes, pg8::StaticOrder, true, true>(big, g, S, E);
            { RETIDS();
            if (l == 1) { for (int m = MP + gw_; m < MT; m += NGW) rms_row_f32_b(XN + (size_t)m * DM, args.in[22], out + OUT_YS + (size_t)(m - MP) * DM, lane_, (const float*)(ws + WS_PART) + (size_t)(m - MP) * DM, (size_t)MS * DM); }
            else { for (int m = MP + gw_; m < MT; m += NGW) row_fin_bf16(XN + (size_t)m * DM, XNO + (size_t)m * DM, SSQ(3 * l + 3) + (size_t)m * 64, lane_, (const float*)(ws + WS_PART) + (size_t)(m - MP) * DM, (size_t)MS * DM); } }
        }
        SEAM(P + 9);
    }
    if (IN(NPH - 1)) { TIDS(); for (int m = gw; m < MP; m += NGW) rms_row_f32_b(XN + (size_t)m * DM, args.in[22], out + OUT_YP + (size_t)m * DM, lane); }
#undef SSQ
#undef PHASE
#undef PHASE_VARS
#undef IN
#undef SEAM
#undef NREP
#undef TIDS
#undef ws
#undef out
#undef cosT
#undef sinT
#undef XN
#undef Z
#undef KD
#undef PL
#undef CAT
#undef Q2
#undef ATT
#undef XA
#undef UP
#undef MN
#undef MKB
#undef MVB
#undef KVT
#undef ST
#undef WL
#undef args
}

extern "C" void kernel_launch(void* const* d_in, const int* in_sizes, int n_in, void* d_out, int out_size, void* d_ws, size_t ws_size, hipStream_t stream) {
    static int grid = 0;
    if (grid == 0) {
        if (n_in != 23 || (size_t)out_size != OUT_TOTAL || ws_size < WS_END) { fprintf(stderr, "kernel_launch: unexpected shapes (n_in %d, out %d, ws %zu)\n", n_in, out_size, ws_size); grid = -1; return; }
        int dev = 0, cus = 0, per_cu = 0;
        if (hipGetDevice(&dev) != hipSuccess || hipDeviceGetAttribute(&cus, hipDeviceAttributeMultiprocessorCount, dev) != hipSuccess) { grid = -1; return; }
        if (hipFuncSetAttribute((const void*)fwd, hipFuncAttributeMaxDynamicSharedMemorySize, LDS_BYTES) != hipSuccess) { fprintf(stderr, "kernel_launch: hipFuncSetAttribute failed\n"); grid = -1; return; }
        if (hipOccupancyMaxActiveBlocksPerMultiprocessor(&per_cu, (const void*)fwd, 512, LDS_BYTES) != hipSuccess || per_cu < 1) fprintf(stderr, "kernel_launch: occupancy query reports %d blocks per CU\n", per_cu);
        (void)hipGetLastError();
        grid = cus;
    }
    if (grid < 0) return;
    (void)hipMemsetAsync((char*)d_ws + WS_CTL, 0, CTL_ZERO_BYTES, stream);
    Args a{};
    for (int i = 0; i < 23; ++i) a.in[i] = (const float*)d_in[i];
    a.out = (float*)d_out; a.ws = (unsigned char*)d_ws; a.pad = 0;
#if MK_N_LAUNCHES == 1
    a.ph_lo = 0; a.ph_hi = NPH; a.use_bar = 1;
    hipLaunchKernelGGL(fwd, dim3(grid), dim3(512), LDS_BYTES, stream, a);
#else
    for (int ph = 0; ph < NPH; ++ph) { a.ph_lo = ph; a.ph_hi = ph + 1; a.use_bar = 0; hipLaunchKernelGGL(fwd, dim3(grid), dim3(512), LDS_BYTES, stream, a); }
#endif
}
```

```cpp
#include <hip/hip_runtime.h>
#include <cstdio>
#include <cstdint>

#define DI __device__ __forceinline__
#define GAS __attribute__((address_space(1)))
#define LAS __attribute__((address_space(3)))
typedef unsigned short bf16;
typedef short bf16x8 __attribute__((ext_vector_type(8)));
typedef short s16x4 __attribute__((ext_vector_type(4)));
typedef float f32x4 __attribute__((ext_vector_type(4)));
typedef float f32x2 __attribute__((ext_vector_type(2)));
typedef unsigned u32x4 __attribute__((ext_vector_type(4)));
typedef unsigned u32x2 __attribute__((ext_vector_type(2)));

#ifndef MK_N_LAUNCHES
#define MK_N_LAUNCHES 1
#endif

constexpr int DM = 2048, MP = 8192, MS = 512, MT = MP + MS, DIN = 5120, DFF = 8192, DRET = 1024, DPOOL = 1024, NMEM = 256;
constexpr int SEQ = 2048, NB = 4, DECB = 128, DECT = 4, NPOS = SEQ + DECT;
constexpr float EPS = 1e-6f;

constexpr size_t MiB = 1u << 20;
constexpr size_t WS_CTL = 0, CTL_ZERO_BYTES = 64 * 1024;
constexpr size_t WS_COS = 1 * MiB, WS_SIN = 2 * MiB + MiB / 2;
constexpr size_t WS_W = 4 * MiB, W_LAYER = 125 * MiB;
constexpr size_t WO_IN = 0, WO_OUT = 20 * MiB, WO_XQ = 28 * MiB, WO_MKV = 36 * MiB, WO_XO = 52 * MiB, WO_UP = 60 * MiB, WO_DN = 92 * MiB, WO_POOL = 124 * MiB;
constexpr size_t WS_XN = 254 * MiB;
constexpr size_t WS_Z = 288 * MiB;
constexpr size_t WS_KD = 373 * MiB;
constexpr size_t WS_PL = 389 * MiB;
constexpr size_t WS_CAT = 406 * MiB;
constexpr size_t WS_Q2 = 440 * MiB;
constexpr size_t WS_ATT = 474 * MiB;
constexpr size_t WS_XA = 508 * MiB;
constexpr size_t WS_UP = 576 * MiB;
constexpr size_t WS_MN = 712 * MiB;
constexpr size_t WS_MKB = 720 * MiB, WS_MVB = 724 * MiB;
constexpr size_t WS_KVT = 728 * MiB;
constexpr size_t WS_ST = 792 * MiB;
constexpr size_t WS_DUMMY = 824 * MiB;
constexpr size_t WS_SSQ = 892 * MiB, SSQ_BYTES = 4 * MiB;
constexpr size_t WS_PART = 900 * MiB;
constexpr size_t WS_END = 916 * MiB;

constexpr size_t OUT_YP = 0, OUT_YS = 16777216, OUT_RSP = OUT_YS + 1048576, OUT_PBP = OUT_RSP + 2097152, OUT_MK = OUT_PBP + 122880,
                 OUT_MV = OUT_MK + 4194304, OUT_RSS = OUT_MV + 4194304, OUT_PBS = OUT_RSS + 67108864, OUT_TOTAL = OUT_PBS + 3932160;

constexpr int LDS_CTL = 0, LDS_BIG = 1024, LDS_BYTES = 147456;

DI float bf2f(unsigned short b) { return __uint_as_float((unsigned)b << 16); }
typedef __bf16 bf16x2_t __attribute__((ext_vector_type(2)));
DI unsigned cvt_pk_bf16(float lo, float hi) { f32x2 v = {lo, hi}; bf16x2_t b = __builtin_convertvector(v, bf16x2_t); return __builtin_bit_cast(unsigned, b); }
DI u32x4 pack8(f32x4 a, f32x4 b) { u32x4 w; w.x = cvt_pk_bf16(a[0], a[1]); w.y = cvt_pk_bf16(a[2], a[3]); w.z = cvt_pk_bf16(b[0], b[1]); w.w = cvt_pk_bf16(b[2], b[3]); return w; }
DI u32x2 pack4(f32x4 a) { u32x2 w; w.x = cvt_pk_bf16(a[0], a[1]); w.y = cvt_pk_bf16(a[2], a[3]); return w; }
DI f32x4 unpack4(u32x2 w) { f32x4 r; r[0] = __uint_as_float(w.x << 16); r[1] = __uint_as_float(w.x & 0xffff0000u); r[2] = __uint_as_float(w.y << 16); r[3] = __uint_as_float(w.y & 0xffff0000u); return r; }
DI float wave_sum(float v) {
#pragma unroll
    for (int o = 1; o < 64; o <<= 1) v += __shfl_xor(v, o);
    return v;
}
DI float wave_max(float v) {
#pragma unroll
    for (int o = 1; o < 64; o <<= 1) v = fmaxf(v, __shfl_xor(v, o));
    return v;
}
DI float lg2gamma(int h) { return log2f(1.0f - exp2f(-5.0f - (float)h)); }
DI bf16x8 cat8(s16x4 a, s16x4 b) { return __builtin_shufflevector(a, b, 0, 1, 2, 3, 4, 5, 6, 7); }
template <int O0, int O1, int O2, int O3, int O4, int O5, int O6, int O7>
DI void tr8(unsigned a, s16x4 (&o)[8]) {
    asm volatile("ds_read_b64_tr_b16 %0, %8 offset:%9\n\tds_read_b64_tr_b16 %1, %8 offset:%10\n\tds_read_b64_tr_b16 %2, %8 offset:%11\n\tds_read_b64_tr_b16 %3, %8 offset:%12\n\t"
                 "ds_read_b64_tr_b16 %4, %8 offset:%13\n\tds_read_b64_tr_b16 %5, %8 offset:%14\n\tds_read_b64_tr_b16 %6, %8 offset:%15\n\tds_read_b64_tr_b16 %7, %8 offset:%16\n\t"
                 "s_waitcnt lgkmcnt(0)"
                 : "=&v"(o[0]), "=&v"(o[1]), "=&v"(o[2]), "=&v"(o[3]), "=&v"(o[4]), "=&v"(o[5]), "=&v"(o[6]), "=&v"(o[7])
                 : "v"(a), "i"(O0), "i"(O1), "i"(O2), "i"(O3), "i"(O4), "i"(O5), "i"(O6), "i"(O7) : "memory");
}
#define MFMA16(a, b, c) __builtin_amdgcn_mfma_f32_16x16x32_bf16((a), (b), (c), 0, 0, 0)

namespace pg8 {
#define PG8_LAS __attribute__((address_space(3)))
typedef unsigned short bf16_t;
constexpr int BM = 256, BK = 64, HALF = 128, HTB = HALF * BK * 2, STAGE_BYTES = 8 * HTB, NXCD = 8, WGM = 8;
__host__ __device__ __forceinline__ int lds_byte(int r, int c) { const int st = (r >> 4) * 2 + (c >> 5), rr = r & 15, cc = c & 31, ob = rr * 64 + cc * 2; return st * 1024 + (ob ^ (((ob >> 9) & 1) << 5)); }
__host__ __device__ __forceinline__ void stage_rc(int b, int& R, int& C) { const int st = b / 1024, sb = b % 1024, swz = sb ^ (((sb >> 9) & 1) << 5); R = (st >> 1) * 16 + swz / 64; C = (st & 1) * 32 + (swz % 64) / 2; }
__host__ __device__ __forceinline__ int perm32(int rho) { const int n = rho >> 4, i = rho & 15; return 8 * (i >> 2) + 4 * n + (i & 3); }
struct Unit { int pm, pn; };
struct Gemm { const bf16_t* A; const bf16_t* Bt; int M, N, K, lda, a_pn_off; };
struct StaticOrder {
    int nM, nN, nwg, G, c;
    __host__ __device__ void init(int M, int N, int G_, int c_) { nM = M / BM; nN = N / BM; nwg = nM * nN; G = G_; c = c_; }
    __host__ __device__ bool next(int i, Unit& u) const {
        const long L = (long)i * G + c; if (L >= nwg) return false;
        int wgid = (int)L; { const int q = nwg / NXCD, r = nwg % NXCD, xcd = wgid % NXCD, off = wgid / NXCD; wgid = (xcd < r ? xcd * (q + 1) : r * (q + 1) + (xcd - r) * q) + off; }
        const int nig = WGM * nN, gid = wgid / nig, fm = gid * WGM, gsz = (nM - fm) < WGM ? (nM - fm) : WGM;
        u.pm = fm + ((wgid % nig) % gsz); u.pn = (wgid % nig) / gsz; return true;
    }
    __device__ __forceinline__ void a_ready(const Unit&) const {}
    __device__ __forceinline__ void done(const Unit&) const {}
};
template <class Epi, class Sched, bool ALIGN_EPI = false, bool SP2 = false>
__device__ __forceinline__ void gemm_phase(PG8_LAS unsigned char* lds, const Gemm g, const Sched& S, const Epi& E) {
    int tid = threadIdx.x; asm volatile("" : "+v"(tid));
    const int wid = __builtin_amdgcn_readfirstlane(tid >> 6), lane = tid & 63, wr = wid >> 2, wc = wid & 3, fr = lane & 15, fq = lane >> 4;
    int K = g.K, lda = g.lda; asm volatile("" : "+s"(K), "+s"(lda));
    const int nt = K / BK;
    unsigned voffA[2], voffB[2];
#pragma unroll
    for (int i = 0; i < 2; ++i) { int R, C; stage_rc(tid * 16 + i * 8192, R, C); const int Rb = Epi::PERM ? ((R & ~31) + perm32(R & 31)) : R;
        voffA[i] = (unsigned)(R * lda + C) * 2u; voffB[i] = (unsigned)(Rb * K + C) * 2u; }
    const size_t kstep = (size_t)(BK * 2);
    const size_t hstepA = (size_t)HALF * lda * 2, hstepB = (size_t)HALF * K * 2;
    const size_t tstepA = 2 * hstepA, tstepB = 2 * hstepB;
    const unsigned ldsw = (unsigned)wid * 1024u;
    const int aoff = lds_byte(wr * 64 + fr, fq * 8), boff = lds_byte(wc * 32 + fr, fq * 8);
#define PG8_SA(b, h) (((b) * 2 + (h)) * HTB)
#define PG8_SB(b, h) ((4 + (b) * 2 + (h)) * HTB)
#define PG8_STAGE(bufoff, gbase, voff) do { _Pragma("unroll") for (int _i = 0; _i < 2; ++_i) \
        __builtin_amdgcn_global_load_lds((const unsigned*)((const char*)(gbase) + (voff)[_i]), (PG8_LAS unsigned*)(lds + (bufoff) + ldsw + _i * 8192), 16, 0, 0); } while (0)
#define PG8_LDA(dst, b, h) do { _Pragma("unroll") for (int m = 0; m < 4; ++m) _Pragma("unroll") for (int k = 0; k < 2; ++k) dst[m][k] = *(const PG8_LAS bf16x8*)(lds + PG8_SA(b, h) + aoff + m * 2048 + k * 1024); } while (0)
#define PG8_LDB(dst, b, h) do { _Pragma("unroll") for (int n = 0; n < 2; ++n) _Pragma("unroll") for (int k = 0; k < 2; ++k) dst[n][k] = *(const PG8_LAS bf16x8*)(lds + PG8_SB(b, h) + boff + n * 2048 + k * 1024); } while (0)
#define PG8_MMA(ai, bj, At, Bt) do { __builtin_amdgcn_s_setprio(1); _Pragma("unroll") for (int m = 0; m < 4; ++m) _Pragma("unroll") for (int n = 0; n < 2; ++n) _Pragma("unroll") for (int k = 0; k < 2; ++k) \
        acc[ai][bj][m][n] = __builtin_amdgcn_mfma_f32_16x16x32_bf16(Bt[n][k], At[m][k], acc[ai][bj][m][n], 0, 0, 0); __builtin_amdgcn_s_setprio(0); } while (0)
#define PG8_WAIT_V(n) asm volatile("s_waitcnt vmcnt(" #n ")" ::: "memory")
#define PG8_WAIT_L(n) asm volatile("s_waitcnt lgkmcnt(" #n ")" ::: "memory")
#define PG8_BAR __builtin_amdgcn_s_barrier()
#define PG8_SCHED __builtin_amdgcn_sched_barrier(0)
    Unit cur, nxt; int ui = 0;
    if (!S.next(0, cur)) return;
    f32x4 acc[2][2][4][2];
#pragma unroll
    for (int a = 0; a < 2; ++a)
#pragma unroll
        for (int b = 0; b < 2; ++b)
#pragma unroll
            for (int m = 0; m < 4; ++m)
#pragma unroll
                for (int n = 0; n < 2; ++n) acc[a][b][m][n] = (f32x4){0.f, 0.f, 0.f, 0.f};
    bf16x8 At[4][2], B0[2][2], B1[2][2];
    const char* cA = (const char*)g.A + (size_t)cur.pm * tstepA + (size_t)cur.pn * g.a_pn_off * 2; const char* cB = (const char*)g.Bt + (size_t)cur.pn * tstepB;
    S.a_ready(cur);
    if constexpr (SP2) {
        PG8_STAGE(PG8_SB(0, 0), cB, voffB); PG8_STAGE(PG8_SB(0, 1), cB + hstepB, voffB); PG8_STAGE(PG8_SA(0, 0), cA, voffA); PG8_STAGE(PG8_SA(0, 1), cA + hstepA, voffA);
        if (wr == 1) PG8_BAR;
        PG8_WAIT_V(2); PG8_BAR;
        PG8_STAGE(PG8_SB(1, 0), cB + kstep, voffB); PG8_STAGE(PG8_SA(1, 0), cA + kstep, voffA); PG8_STAGE(PG8_SB(1, 1), cB + hstepB + kstep, voffB);
        PG8_WAIT_V(6); PG8_BAR;
    } else {
        PG8_STAGE(PG8_SB(0, 0), cB, voffB); PG8_STAGE(PG8_SA(0, 0), cA, voffA); PG8_STAGE(PG8_SB(0, 1), cB + hstepB, voffB); PG8_STAGE(PG8_SA(0, 1), cA + hstepA, voffA);
        if (wr == 1) PG8_BAR;
        PG8_WAIT_V(4); PG8_BAR;
        PG8_STAGE(PG8_SB(1, 0), cB + kstep, voffB); PG8_STAGE(PG8_SA(1, 0), cA + kstep, voffA); PG8_STAGE(PG8_SB(1, 1), cB + hstepB + kstep, voffB);
        PG8_WAIT_V(6); PG8_BAR;
    }
    for (;;) {
        const bool has_next = S.next(ui + 1, nxt);
        const char* nA = has_next ? (const char*)g.A + (size_t)nxt.pm * tstepA + (size_t)nxt.pn * g.a_pn_off * 2 : cA; const char* nB = has_next ? (const char*)g.Bt + (size_t)nxt.pn * tstepB : cB;
        for (int t = 0; t < nt; t += 2) {
            const bool last = (t == nt - 2);
            const char* a1 = cA + (size_t)(t + 1) * kstep;
            const char* a2 = last ? nA : cA + (size_t)(t + 2) * kstep; const char* b2 = last ? nB : cB + (size_t)(t + 2) * kstep;
            const char* a3 = a2 + kstep; const char* b3 = b2 + kstep;
            if (last && has_next) S.a_ready(nxt);
            if constexpr (SP2) {
            PG8_LDB(B0, 0, 0); PG8_LDB(B1, 0, 1); PG8_SCHED; PG8_LDA(At, 0, 0); PG8_STAGE(PG8_SA(1, 1), a1 + hstepA, voffA);
            PG8_WAIT_V(8); PG8_WAIT_L(0); PG8_BAR; PG8_MMA(0, 0, At, B0); PG8_MMA(0, 1, At, B1); PG8_BAR; PG8_SCHED;
            PG8_LDA(At, 0, 1); PG8_STAGE(PG8_SB(0, 0), b2, voffB); PG8_STAGE(PG8_SB(0, 1), b2 + hstepB, voffB); PG8_STAGE(PG8_SA(0, 0), a2, voffA);
            PG8_WAIT_V(8); PG8_WAIT_L(0); PG8_BAR; PG8_MMA(1, 0, At, B0); PG8_MMA(1, 1, At, B1); PG8_BAR; PG8_SCHED;
            PG8_LDB(B0, 1, 0); PG8_LDB(B1, 1, 1); PG8_SCHED; PG8_LDA(At, 1, 0); PG8_STAGE(PG8_SA(0, 1), a2 + hstepA, voffA);
            PG8_WAIT_V(8); PG8_WAIT_L(0); PG8_BAR; PG8_MMA(0, 0, At, B0); PG8_MMA(0, 1, At, B1); PG8_BAR; PG8_SCHED;
            PG8_LDA(At, 1, 1); PG8_STAGE(PG8_SB(1, 0), b3, voffB); PG8_STAGE(PG8_SB(1, 1), b3 + hstepB, voffB); PG8_STAGE(PG8_SA(1, 0), a3, voffA);
            PG8_WAIT_V(8); PG8_WAIT_L(0); PG8_BAR; PG8_MMA(1, 0, At, B0); PG8_MMA(1, 1, At, B1); PG8_BAR; PG8_SCHED;
            } else {
            PG8_LDB(B0, 0, 0); PG8_SCHED; PG8_LDA(At, 0, 0); PG8_STAGE(PG8_SA(1, 1), a1 + hstepA, voffA);
            PG8_WAIT_L(8); PG8_BAR; PG8_WAIT_L(0); PG8_MMA(0, 0, At, B0); PG8_BAR; PG8_SCHED;
            PG8_LDB(B1, 0, 1); PG8_STAGE(PG8_SB(0, 0), b2, voffB);
            PG8_BAR; PG8_WAIT_L(0); PG8_MMA(0, 1, At, B1); PG8_BAR;
            PG8_LDA(At, 0, 1); PG8_STAGE(PG8_SA(0, 0), a2, voffA);
            PG8_BAR; PG8_WAIT_L(0); PG8_MMA(1, 0, At, B0); PG8_BAR; PG8_SCHED;
            PG8_STAGE(PG8_SB(0, 1), b2 + hstepB, voffB);
            PG8_WAIT_V(6); PG8_BAR; PG8_MMA(1, 1, At, B1); PG8_BAR;
            PG8_LDB(B0, 1, 0); PG8_SCHED; PG8_LDA(At, 1, 0); PG8_STAGE(PG8_SA(0, 1), a2 + hstepA, voffA);
            PG8_WAIT_L(8); PG8_BAR; PG8_WAIT_L(0); PG8_MMA(0, 0, At, B0); PG8_BAR; PG8_SCHED;
            PG8_LDB(B1, 1, 1); PG8_STAGE(PG8_SB(1, 0), b3, voffB);
            PG8_BAR; PG8_WAIT_L(0); PG8_MMA(0, 1, At, B1); PG8_BAR;
            PG8_LDA(At, 1, 1); PG8_STAGE(PG8_SA(1, 0), a3, voffA);
            PG8_BAR; PG8_WAIT_L(0); PG8_MMA(1, 0, At, B0); PG8_BAR; PG8_SCHED;
            PG8_STAGE(PG8_SB(1, 1), b3 + hstepB, voffB);
            PG8_WAIT_V(6); PG8_BAR; PG8_MMA(1, 1, At, B1); PG8_BAR;
            }
        }
        if constexpr (ALIGN_EPI) { if (wr == 0) PG8_BAR; }
        E(acc, cur, wr, wc, fr, fq); S.done(cur);
        if (!has_next) break;
#pragma unroll
        for (int a = 0; a < 2; ++a)
#pragma unroll
            for (int b = 0; b < 2; ++b)
#pragma unroll
                for (int m = 0; m < 4; ++m)
#pragma unroll
                    for (int n = 0; n < 2; ++n) acc[a][b][m][n] = (f32x4){0.f, 0.f, 0.f, 0.f};
        cur = nxt; cA = nA; cB = nB; ++ui;
        if constexpr (ALIGN_EPI) { if (wr == 1) PG8_BAR; }
    }
    PG8_WAIT_V(0);
    if constexpr (!ALIGN_EPI) { if (wr == 0) PG8_BAR; }
    PG8_BAR;
#undef PG8_SA
#undef PG8_SB
#undef PG8_STAGE
#undef PG8_LDA
#undef PG8_LDB
#undef PG8_MMA
#undef PG8_WAIT_V
#undef PG8_WAIT_L
#undef PG8_BAR
#undef PG8_SCHED
}
}
using pg8::Unit;


template <int NS> DI float row_rstd(const float* __restrict__ ssq, int row, int fq) {
    const f32x4* p = (const f32x4*)(ssq + (size_t)row * 64 + fq * (NS / 4)); float s = 0.f;
#pragma unroll
    for (int i = 0; i < NS / 16; ++i) { const f32x4 v = p[i]; s += (v[0] + v[1]) + (v[2] + v[3]); }
    s += __shfl_xor(s, 16); s += __shfl_xor(s, 32);
    return __builtin_amdgcn_rsqf(s * (1.0f / DM) + EPS);
}
struct EpiZ {
    static constexpr bool PERM = true;
    bf16* Z; bf16* KD; const float* cosT; const float* sinT; float* pbp; float* pbs; const float* ssq;
    DI void operator()(const f32x4 (&acc)[2][2][4][2], const Unit& u, int wr, int wc, int fr, int fq) const {
        asm volatile("" : "+v"(fr), "+v"(fq));
        const int type = u.pn >> 2, row0 = u.pm * 256 + wr * 64 + fr, cl = wc * 32 + 8 * fq;
        const bool sample = u.pm >= 32;
        if (type <= 1) {
            const float ksc = type == 1 ? 0.0625f : 1.0f;
#pragma unroll
            for (int ai = 0; ai < 2; ++ai)
#pragma unroll
                for (int m = 0; m < 4; ++m) {
                    const int row = row0 + ai * 128 + m * 16;
                    const int tab = sample ? (SEQ + (row & 3)) : (row & (SEQ - 1));
                    const f32x4 c0 = *(const f32x4*)(cosT + tab * 128 + cl), c1 = *(const f32x4*)(cosT + tab * 128 + cl + 4);
                    const f32x4 s0 = *(const f32x4*)(sinT + tab * 128 + cl), s1 = *(const f32x4*)(sinT + tab * 128 + cl + 4);
                    const float rs = sample ? row_rstd<64>(ssq, row, fq) : row_rstd<32>(ssq, row, fq);
                    const f32x4 a0 = acc[ai][0][m][0] * rs, a1 = acc[ai][0][m][1] * rs, b0 = acc[ai][1][m][0] * rs, b1 = acc[ai][1][m][1] * rs;
                    const f32x4 o10 = (a0 * c0 - b0 * s0) * ksc, o11 = (a1 * c1 - b1 * s1) * ksc, o20 = (b0 * c0 + a0 * s0) * ksc, o21 = (b1 * c1 + a1 * s1) * ksc;
                    bf16* zp = Z + (size_t)row * DIN + u.pn * 256 + cl;
                    *(u32x4*)zp = pack8(o10, o11); *(u32x4*)(zp + 128) = pack8(o20, o21);
                }
        } else {
#pragma unroll
            for (int ai = 0; ai < 2; ++ai)
#pragma unroll
                for (int m = 0; m < 4; ++m) {
                    const int row = row0 + ai * 128 + m * 16;
                    bf16* zp = Z + (size_t)row * DIN + u.pn * 256 + cl;
                    const float rs = sample ? row_rstd<64>(ssq, row, fq) : row_rstd<32>(ssq, row, fq);
                    f32x4 v[2][2];
#pragma unroll
                    for (int bj = 0; bj < 2; ++bj) { v[bj][0] = acc[ai][bj][m][0] * rs; v[bj][1] = acc[ai][bj][m][1] * rs; *(u32x4*)(zp + bj * 128) = pack8(v[bj][0], v[bj][1]); }
                    if (type == 4) {
                        const int cu = (u.pn - 16) * 256 + cl;
                        float* dst = nullptr;
                        if (sample) { const int rr = row - MP; dst = pbs + ((size_t)(rr >> 2) * 15 + 11 + (rr & 3)) * DPOOL + cu; }
                        else { const int t = row & (SEQ - 1); if (t >= SEQ - 15) dst = pbp + ((size_t)(row >> 11) * 15 + (t - (SEQ - 15))) * DPOOL + cu; }
                        if (dst) {
#pragma unroll
                            for (int bj = 0; bj < 2; ++bj) { *(f32x4*)(dst + bj * 128) = v[bj][0]; *(f32x4*)(dst + bj * 128 + 4) = v[bj][1]; }
                        }
                    }
                }
        }
    }
};
struct EpiMemKV {
    static constexpr bool PERM = true;
    float* ok; float* ov; bf16* kb; bf16* vb;
    DI void operator()(const f32x4 (&acc)[2][2][4][2], const Unit& u, int wr, int wc, int fr, int fq) const {
        asm volatile("" : "+v"(fr), "+v"(fq));
        const bool isv = u.pn >= 8; float* of = isv ? ov : ok; bf16* ob = isv ? vb : kb;
        const int row0 = u.pm * 256 + wr * 64 + fr, col0 = (u.pn & 7) * 256 + wc * 32 + 8 * fq;
#pragma unroll
        for (int ai = 0; ai < 2; ++ai)
#pragma unroll
            for (int m = 0; m < 4; ++m) { const size_t ro = (size_t)(row0 + ai * 128 + m * 16) * DM + col0;
#pragma unroll
                for (int bj = 0; bj < 2; ++bj) { const f32x4 v0 = acc[ai][bj][m][0], v1 = acc[ai][bj][m][1];
                    *(f32x4*)(of + ro + bj * 128) = v0; *(f32x4*)(of + ro + bj * 128 + 4) = v1; *(u32x4*)(ob + ro + bj * 128) = pack8(v0, v1); } }
    }
};
struct EpiRes {
    static constexpr bool PERM = true;
    const float* basef; const bf16* baseb; bf16* xb; float* ssq;
    DI void operator()(const f32x4 (&acc)[2][2][4][2], const Unit& u, int wr, int wc, int fr, int fq) const {
        asm volatile("" : "+v"(fr), "+v"(fq));
        const int row0 = u.pm * 256 + wr * 64 + fr, col0 = u.pn * 256 + wc * 32 + 8 * fq;
#pragma unroll
        for (int ai = 0; ai < 2; ++ai)
#pragma unroll
            for (int m = 0; m < 4; ++m) { const int row = row0 + ai * 128 + m * 16; const size_t ro = (size_t)row * DM + col0; float sq = 0.f;
#pragma unroll
                for (int bj = 0; bj < 2; ++bj) { f32x4 b0, b1;
                    if (basef) { b0 = *(const f32x4*)(basef + ro + bj * 128); b1 = *(const f32x4*)(basef + ro + bj * 128 + 4); }
                    else { const u32x4 w = *(const u32x4*)(baseb + ro + bj * 128); b0 = unpack4((u32x2){w.x, w.y}); b1 = unpack4((u32x2){w.z, w.w}); }
                    const f32x4 v0 = b0 + acc[ai][bj][m][0], v1 = b1 + acc[ai][bj][m][1];
                    *(u32x4*)(xb + ro + bj * 128) = pack8(v0, v1);
                    sq += ((v0[0] * v0[0] + v0[1] * v0[1]) + (v0[2] * v0[2] + v0[3] * v0[3])) + ((v1[0] * v1[0] + v1[1] * v1[1]) + (v1[2] * v1[2] + v1[3] * v1[3])); }
                sq += __shfl_xor(sq, 16); sq += __shfl_xor(sq, 32);
                if (fq == 0) ssq[(size_t)row * 64 + u.pn * 4 + wc] = sq; }
    }
};
template <int ACT> struct EpiB {
    static constexpr bool PERM = true;
    bf16* O; int ldc; float scale; const float* cs; int coff; const float* ssq;
    DI void operator()(const f32x4 (&acc)[2][2][4][2], const Unit& u, int wr, int wc, int fr, int fq) const {
        asm volatile("" : "+v"(fr), "+v"(fq));
        const int row0 = u.pm * 256 + wr * 64 + fr, col0 = u.pn * 256 + wc * 32 + 8 * fq;
#pragma unroll
        for (int ai = 0; ai < 2; ++ai)
#pragma unroll
            for (int m = 0; m < 4; ++m) { bf16* rp = O + (size_t)(row0 + ai * 128 + m * 16) * ldc + coff + col0;
                float rs = scale; if (ACT != 2) rs *= row_rstd<32>(ssq, row0 + ai * 128 + m * 16, fq);
#pragma unroll
                for (int bj = 0; bj < 2; ++bj) { f32x4 v0 = acc[ai][bj][m][0], v1 = acc[ai][bj][m][1];
                    if (ACT != 2) { v0 = v0 * rs; v1 = v1 * rs; }
                    if (ACT == 1) { v0 = __builtin_elementwise_max(v0, (f32x4){0.f, 0.f, 0.f, 0.f}); v1 = __builtin_elementwise_max(v1, (f32x4){0.f, 0.f, 0.f, 0.f}); v0 = v0 * v0; v1 = v1 * v1; }
                    if (ACT == 2) { v0 = v0 * *(const f32x4*)(cs + col0 + bj * 128); v1 = v1 * *(const f32x4*)(cs + col0 + bj * 128 + 4); }
                    *(u32x4*)(rp + bj * 128) = pack8(v0, v1); } }
    }
};

#define XB_TMO      128
#define XB_XCNT(j)  (256  + 64 * (j))
#define XB_XSUB(j)  (1280 + 64 * (j))
#define XB_XGEN(j)  (2304 + 64 * (j))
#define XB_TOP      3328
#define XB_TOPGEN   3392
#define XCD_BAR_WORDS 3456
#define XB_SPIN_CAP (1u << 18)
__device__ __forceinline__ unsigned xb_ld(unsigned* p)              { return __hip_atomic_load(p, __ATOMIC_RELAXED, __HIP_MEMORY_SCOPE_AGENT); }
__device__ __forceinline__ unsigned xb_add(unsigned* p, unsigned v) { return __hip_atomic_fetch_add(p, v, __ATOMIC_RELAXED, __HIP_MEMORY_SCOPE_AGENT); }
__device__ __forceinline__ unsigned xb_xcc_id() { return (unsigned)__builtin_amdgcn_s_getreg((3 << 11) | 20) & 0xFu; }
#define XB_SPIN(cond, bar) do { unsigned _sp = 0; while (cond) { __builtin_amdgcn_s_sleep(1); \
    if ((++_sp & 255u) == 0u) { if (xb_ld(&(bar)[XB_TMO])) break; if (_sp > XB_SPIN_CAP) { atomicAdd(&(bar)[XB_TMO], 1u); break; } } } } while (0)
struct XcdBarrier { unsigned* bar; unsigned x; volatile LAS unsigned* st; };
__device__ __forceinline__ XcdBarrier xcd_barrier_post(unsigned* bar, volatile LAS unsigned* st) {
    XcdBarrier b; b.bar = bar; b.x = xb_xcc_id(); b.st = st;
    if (threadIdx.x == 0) (void)xb_add(&bar[XB_XCNT(b.x)], 1u);
    return b;
}
__device__ __forceinline__ void xcd_barrier_complete(unsigned* bar, unsigned x, unsigned& nloc, unsigned& nx) {
    const unsigned G = gridDim.x * gridDim.y * gridDim.z;
    unsigned sum, cnt, mine, sp = 0u;
    for (;;) {
        sum = 0u; cnt = 0u; mine = 0u;
#pragma unroll
        for (unsigned j = 0; j < 16; ++j) { const unsigned c = xb_ld(&bar[XB_XCNT(j)]); sum += c; cnt += (c > 0u) ? 1u : 0u; }
        mine = xb_ld(&bar[XB_XCNT(x)]);
        if (sum == G) break;
        __builtin_amdgcn_s_sleep(1);
        if ((++sp & 255u) == 0u) { if (xb_ld(&bar[XB_TMO])) break; if (sp > XB_SPIN_CAP) { atomicAdd(&bar[XB_TMO], 1u); break; } }
    }
    nloc = mine > 0u ? mine : 1u; nx = cnt > 0u ? cnt : 1u;
}
__device__ __forceinline__ void xcd_barrier(const XcdBarrier& b) {
    asm volatile("s_waitcnt vmcnt(0)" ::: "memory");
    __syncthreads();
    if (threadIdx.x == 0) {
        unsigned* bar = b.bar;
        __builtin_amdgcn_s_waitcnt(0);
        unsigned nloc = b.st[0], nx = b.st[1];
        if (nloc == 0u) { xcd_barrier_complete(bar, b.x, nloc, nx); b.st[0] = nloc; b.st[1] = nx; }
        const unsigned old = xb_add(&bar[XB_XSUB(b.x)], 1u);
        const unsigned gen = old / nloc;
        if (old + 1u == (gen + 1u) * nloc) {
            __builtin_amdgcn_fence(__ATOMIC_RELEASE, "agent");
            asm volatile("s_waitcnt vmcnt(0)" ::: "memory");
            const unsigned og = xb_add(&bar[XB_TOP], 1u);
            const unsigned tg = og / nx;
            if (og + 1u == (tg + 1u) * nx) xb_add(&bar[XB_TOPGEN], 1u);
            else XB_SPIN(xb_ld(&bar[XB_TOPGEN]) == tg, bar);
            __builtin_amdgcn_fence(__ATOMIC_ACQUIRE, "agent");
            xb_add(&bar[XB_XGEN(b.x)], 1u);
            asm volatile("s_waitcnt vmcnt(0)" ::: "memory");
        } else {
            XB_SPIN(xb_ld(&bar[XB_XGEN(b.x)]) == gen, bar);
            __builtin_amdgcn_fence(__ATOMIC_ACQUIRE, "agent");
            asm volatile("s_waitcnt vmcnt(0)" ::: "memory");
        }
    }
    __syncthreads();
}

constexpr int RP = 528;
constexpr int VP = 272;
DI unsigned lds_addr(LAS unsigned char* p) { return (unsigned)(unsigned long)p; }
template <int BASE, int ST, int SF>
DI void tr_frag4(unsigned a, bf16x8 (&f)[4]) {
    s16x4 o[8];
    tr8<BASE, BASE + ST, BASE + SF, BASE + SF + ST, BASE + 2 * SF, BASE + 2 * SF + ST, BASE + 3 * SF, BASE + 3 * SF + ST>(a, o);
    f[0] = cat8(o[0], o[1]); f[1] = cat8(o[2], o[3]); f[2] = cat8(o[4], o[5]); f[3] = cat8(o[6], o[7]);
}

DI void transpose_item(const float* __restrict__ W, int K, int N, bf16* __restrict__ WT, LAS float* scr, int item, int lane, const float* __restrict__ gain = nullptr) {
    const int nblk = N >> 6, kb = item / nblk, nb = item - kb * nblk, k0 = kb * 64, n0 = nb * 64;
    const int lr = lane >> 4, lc = (lane & 15) * 4;
    f32x4 v[16];
#pragma unroll
    for (int i = 0; i < 16; ++i) v[i] = *(const f32x4*)(W + (size_t)(k0 + 4 * i + lr) * N + n0 + lc);
#pragma unroll
    for (int i = 0; i < 16; ++i) { LAS float* s = scr + (4 * i + lr) * 65 + lc; const float gn = gain ? gain[k0 + 4 * i + lr] : 1.0f;
        s[0] = v[i][0] * gn; s[1] = v[i][1] * gn; s[2] = v[i][2] * gn; s[3] = v[i][3] * gn; }
    asm volatile("s_waitcnt lgkmcnt(0)" ::: "memory");
    const int c = lane & 7;
#pragma unroll
    for (int j = 0; j < 8; ++j) { const int n = (lane >> 3) + 8 * j; const LAS float* s = scr + (8 * c) * 65 + n;
        u32x4 o; o.x = cvt_pk_bf16(s[0], s[65]); o.y = cvt_pk_bf16(s[130], s[195]); o.z = cvt_pk_bf16(s[260], s[325]); o.w = cvt_pk_bf16(s[390], s[455]);
        *(u32x4*)(WT + (size_t)(n0 + n) * K + k0 + 8 * c) = o; }
    asm volatile("s_waitcnt lgkmcnt(0)" ::: "memory");
}
struct CItem { const float* W; bf16* WT; const float* gain; int K, N, item; };
DI void citem_load(const CItem& t, f32x4 (&v)[8], int tid) {
    const int nblk = t.N >> 7, kb = t.item / nblk, nb = t.item - kb * nblk;
    const float* p = t.W + (size_t)(128 * kb + (tid >> 5)) * t.N + 128 * nb + (tid & 31) * 4;
#pragma unroll
    for (int i = 0; i < 8; ++i) v[i] = __builtin_nontemporal_load((const f32x4*)(p + (size_t)(16 * i) * t.N));
}
DI void citem_to_lds(const CItem& t, const f32x4 (&v)[8], LAS float* scr, int tid) {
    const int nblk = t.N >> 7, kb = t.item / nblk, k0 = 128 * kb;
#pragma unroll
    for (int i = 0; i < 8; ++i) { const int row = (tid >> 5) + 16 * i; LAS float* s = scr + row * 129 + (tid & 31) * 4; const float gn = t.gain ? t.gain[k0 + row] : 1.0f;
        s[0] = v[i][0] * gn; s[1] = v[i][1] * gn; s[2] = v[i][2] * gn; s[3] = v[i][3] * gn; }
}
DI void citem_store(const CItem& t, const LAS float* scr, int tid) {
    const int nblk = t.N >> 7, kb = t.item / nblk, nb = t.item - kb * nblk, k0 = 128 * kb, n0 = 128 * nb;
    const int c = tid & 15;
#pragma unroll
    for (int j = 0; j < 4; ++j) { const int n = (tid >> 4) + 32 * j; const LAS float* s = scr + (8 * c) * 129 + n;
        u32x4 o; o.x = cvt_pk_bf16(s[0], s[129]); o.y = cvt_pk_bf16(s[258], s[387]); o.z = cvt_pk_bf16(s[516], s[645]); o.w = cvt_pk_bf16(s[774], s[903]);
        *(u32x4*)(t.WT + (size_t)(n0 + n) * t.K + k0 + 8 * c) = o; }
}
DI void rms_row_bf16(const float* __restrict__ xrow, const float* __restrict__ w, bf16* __restrict__ orow, int lane) {
    const f32x4* xr = (const f32x4*)xrow + lane; const f32x4* wr = (const f32x4*)w + lane;
    f32x4 v[8]; float s = 0.f;
#pragma unroll
    for (int j = 0; j < 8; ++j) { v[j] = xr[64 * j]; s += (v[j][0] * v[j][0] + v[j][1] * v[j][1]) + (v[j][2] * v[j][2] + v[j][3] * v[j][3]); }
    const float rstd = 1.0f / sqrtf(wave_sum(s) * (1.0f / DM) + EPS);
    u32x2* o = (u32x2*)orow + lane;
#pragma unroll
    for (int j = 0; j < 8; ++j) o[64 * j] = pack4(v[j] * rstd * wr[64 * j]);
}
DI void row_to_xb(const float* __restrict__ xrow, bf16* __restrict__ orow, float* __restrict__ ssqrow, int ns, int lane, const float* __restrict__ part = nullptr, size_t pstride = 0, float* __restrict__ xw = nullptr) {
    const f32x4* xr = (const f32x4*)xrow + lane; f32x4 v[8]; float s = 0.f;
#pragma unroll
    for (int j = 0; j < 8; ++j) { v[j] = xr[64 * j];
        if (part) { for (int q = 0; q < 4; ++q) v[j] += ((const f32x4*)(part + q * pstride) + lane)[64 * j]; ((f32x4*)xw + lane)[64 * j] = v[j]; }
        s += (v[j][0] * v[j][0] + v[j][1] * v[j][1]) + (v[j][2] * v[j][2] + v[j][3] * v[j][3]); }
    s = wave_sum(s);
    u32x2* o = (u32x2*)orow + lane;
#pragma unroll
    for (int j = 0; j < 8; ++j) o[64 * j] = pack4(v[j]);
    if (lane < ns) ssqrow[lane] = lane == 0 ? s : 0.f;
}
DI void load_row_bf16(const bf16* __restrict__ xrow, f32x4 (&v)[8], int lane, const float* __restrict__ part, size_t pstride) {
    const u32x2* xr = (const u32x2*)xrow + lane;
#pragma unroll
    for (int j = 0; j < 8; ++j) { v[j] = unpack4(xr[64 * j]);
        if (part) { for (int q = 0; q < 4; ++q) v[j] += ((const f32x4*)(part + q * pstride) + lane)[64 * j]; } }
}
DI void row_fin_bf16(const bf16* __restrict__ xrow, bf16* __restrict__ orow, float* __restrict__ ssqrow, int lane, const float* __restrict__ part, size_t pstride) {
    f32x4 v[8]; load_row_bf16(xrow, v, lane, part, pstride); float s = 0.f;
#pragma unroll
    for (int j = 0; j < 8; ++j) s += (v[j][0] * v[j][0] + v[j][1] * v[j][1]) + (v[j][2] * v[j][2] + v[j][3] * v[j][3]);
    s = wave_sum(s);
    u32x2* o = (u32x2*)orow + lane;
#pragma unroll
    for (int j = 0; j < 8; ++j) o[64 * j] = pack4(v[j]);
    ssqrow[lane] = lane == 0 ? s : 0.f;
}
DI void rms_row_f32_b(const bf16* __restrict__ xrow, const float* __restrict__ w, float* __restrict__ orow, int lane, const float* __restrict__ part = nullptr, size_t pstride = 0) {
    f32x4 v[8]; load_row_bf16(xrow, v, lane, part, pstride); float s = 0.f; const f32x4* wr = (const f32x4*)w + lane;
#pragma unroll
    for (int j = 0; j < 8; ++j) s += (v[j][0] * v[j][0] + v[j][1] * v[j][1]) + (v[j][2] * v[j][2] + v[j][3] * v[j][3]);
    const float rstd = 1.0f / sqrtf(wave_sum(s) * (1.0f / DM) + EPS);
    f32x4* o = (f32x4*)orow + lane;
#pragma unroll
    for (int j = 0; j < 8; ++j) o[64 * j] = v[j] * rstd * wr[64 * j];
}
template <int KS, int NG>
DI void kvt_sub(unsigned aV, const bf16x8 af, f32x4 (&acc)[16]) {
    bf16x8 bf[4]; tr_frag4<(32 * KS) * RP + NG * 128, 4 * RP, 32>(aV, bf);
#pragma unroll
    for (int f = 0; f < 4; ++f) acc[4 * NG + f] = MFMA16(af, bf[f], acc[4 * NG + f]);
}
DI void kvt_unit(LAS unsigned char* big, const bf16* __restrict__ Z, const bf16* __restrict__ KD, bf16* __restrict__ KVT, int bh, int c, int tid, int wid, int lane) {
    const int b = bh >> 2, h = bh & 3, r0 = b * SEQ + c * 128;
    LAS unsigned char* Vs = big; LAS unsigned char* Ks = big + 128 * RP;
    const float l2g = lg2gamma(h);
#pragma unroll
    for (int i = 0; i < 8; ++i) { const int id = tid + 512 * i, row = id >> 5, ch = id & 31;
        const u32x4 v = *(const u32x4*)(Z + (size_t)(r0 + row) * DIN + 2048 + h * 256 + ch * 8);
        const u32x4 k = *(const u32x4*)(Z + (size_t)(r0 + row) * DIN + 1024 + h * 256 + ch * 8);
        const float dk = exp2f(l2g * (float)(127 - row));
        const f32x4 k0 = unpack4((u32x2){k.x, k.y}) * dk, k1 = unpack4((u32x2){k.z, k.w}) * dk;
        *(LAS u32x4*)(Vs + row * RP + ch * 16) = v; *(LAS u32x4*)(Ks + row * RP + ch * 16) = pack8(k0, k1); }
    __syncthreads();
    const int g = lane >> 4, q = (lane >> 2) & 3, p = lane & 3;
    const unsigned aV = lds_addr(Vs) + (8 * g + q) * RP + 8 * p;
    bf16* o = KVT + ((size_t)(bh * 16 + c) * 256) * 256;
    for (int mb = 0; mb < 2; ++mb) {
        const unsigned aK = lds_addr(Ks) + (8 * g + q) * RP + (32 * wid + 16 * mb + 4 * p) * 2;
        bf16x8 af[4]; tr_frag4<0, 4 * RP, 32 * RP>(aK, af);
        f32x4 acc[16];
#pragma unroll
        for (int n = 0; n < 16; ++n) acc[n] = (f32x4){0.f, 0.f, 0.f, 0.f};
        kvt_sub<0, 0>(aV, af[0], acc); kvt_sub<0, 1>(aV, af[0], acc); kvt_sub<0, 2>(aV, af[0], acc); kvt_sub<0, 3>(aV, af[0], acc);
        kvt_sub<1, 0>(aV, af[1], acc); kvt_sub<1, 1>(aV, af[1], acc); kvt_sub<1, 2>(aV, af[1], acc); kvt_sub<1, 3>(aV, af[1], acc);
        kvt_sub<2, 0>(aV, af[2], acc); kvt_sub<2, 1>(aV, af[2], acc); kvt_sub<2, 2>(aV, af[2], acc); kvt_sub<2, 3>(aV, af[2], acc);
        kvt_sub<3, 0>(aV, af[3], acc); kvt_sub<3, 1>(aV, af[3], acc); kvt_sub<3, 2>(aV, af[3], acc); kvt_sub<3, 3>(aV, af[3], acc);
#pragma unroll
        for (int nb = 0; nb < 16; ++nb) *(u32x2*)(o + (size_t)(16 * nb + (lane & 15)) * 256 + 32 * wid + 16 * mb + 4 * g) = pack4(acc[nb]);
    }
    __syncthreads();
}

DI void sret_unit(LAS unsigned char* big, const bf16* __restrict__ Z, const float* __restrict__ S0, float* __restrict__ Sout, const float* __restrict__ rnw, bf16* __restrict__ CAT,
                  int b, int h, int tid, int wid, int lane) {
    LAS float* qs = (LAS float*)big; LAS float* ks_ = qs + 1024; LAS float* vs = qs + 2048; LAS float* sc = qs + 3072; LAS float* red = qs + 3136;
    const int rs = MP + 4 * b; const float l2g = lg2gamma(h);
#pragma unroll
    for (int i = 0; i < 6; ++i) { const int id = tid + 512 * i, which = id >> 10, t = (id >> 8) & 3, d = id & 255;
        qs[id] = bf2f(Z[(size_t)(rs + t) * DIN + which * 1024 + h * 256 + d]); }
    __syncthreads();
#pragma unroll
    for (int pp = 0; pp < 2; ++pp) { const int pi = 2 * wid + pp, i = pi >> 2, j = pi & 3; float s = 0.f;
#pragma unroll
        for (int m = 0; m < 4; ++m) s += qs[i * 256 + lane + 64 * m] * ks_[j * 256 + lane + 64 * m];
        s = wave_sum(s); if (lane == 0) sc[pi] = (i >= j) ? s * exp2f(l2g * (float)(i - j)) : 0.f; }
    const float g4 = exp2f(l2g * 4.0f), gk0 = exp2f(l2g * 3.0f), gk1 = exp2f(l2g * 2.0f), gk2 = exp2f(l2g), gk3 = 1.0f;
    const size_t sbase = ((size_t)(b * 4 + h)) * 65536 + 4 * lane;
    f32x4 vv[4];
#pragma unroll
    for (int j = 0; j < 4; ++j) vv[j] = *(LAS f32x4*)(vs + j * 256 + 4 * lane);
    f32x4 oi[4];
#pragma unroll
    for (int i = 0; i < 4; ++i) oi[i] = (f32x4){0.f, 0.f, 0.f, 0.f};
    float ql[4], kl[4];
    { const int dl = wid + 8 * (lane & 31);
      ql[0] = qs[dl]; ql[1] = qs[256 + dl]; ql[2] = qs[512 + dl]; ql[3] = qs[768 + dl];
      kl[0] = ks_[dl] * gk0; kl[1] = ks_[256 + dl] * gk1; kl[2] = ks_[512 + dl] * gk2; kl[3] = ks_[768 + dl] * gk3; }
#pragma unroll
    for (int rb = 0; rb < 2; ++rb) {
        f32x4 sv[16];
#pragma unroll
        for (int r8 = 0; r8 < 16; ++r8) sv[r8] = __builtin_nontemporal_load((const f32x4*)(S0 + sbase + (size_t)(wid + 8 * (16 * rb + r8)) * 256));
#pragma unroll
        for (int r8 = 0; r8 < 16; ++r8) { const int r = 16 * rb + r8; const f32x4 s = sv[r8];
            const float fq0 = __int_as_float(__builtin_amdgcn_readlane(__float_as_int(ql[0]), r)), fq1 = __int_as_float(__builtin_amdgcn_readlane(__float_as_int(ql[1]), r));
            const float fq2 = __int_as_float(__builtin_amdgcn_readlane(__float_as_int(ql[2]), r)), fq3 = __int_as_float(__builtin_amdgcn_readlane(__float_as_int(ql[3]), r));
            const float fk0 = __int_as_float(__builtin_amdgcn_readlane(__float_as_int(kl[0]), r)), fk1 = __int_as_float(__builtin_amdgcn_readlane(__float_as_int(kl[1]), r));
            const float fk2 = __int_as_float(__builtin_amdgcn_readlane(__float_as_int(kl[2]), r)), fk3 = __int_as_float(__builtin_amdgcn_readlane(__float_as_int(kl[3]), r));
            oi[0] += s * fq0; oi[1] += s * fq1; oi[2] += s * fq2; oi[3] += s * fq3;
            const f32x4 sn = s * g4 + vv[0] * fk0 + vv[1] * fk1 + vv[2] * fk2 + vv[3] * fk3;
            __builtin_nontemporal_store(sn, (f32x4*)(Sout + sbase + (size_t)(wid + 8 * r) * 256)); }
    }
#pragma unroll
    for (int i = 0; i < 4; ++i) *(LAS f32x4*)(red + (wid * 4 + i) * 256 + 4 * lane) = oi[i];
    __syncthreads();
    if (wid < 4) { const int i = wid; f32x4 o = (f32x4){0.f, 0.f, 0.f, 0.f};
#pragma unroll
        for (int w = 0; w < 8; ++w) o += *(LAS f32x4*)(red + (w * 4 + i) * 256 + 4 * lane);
        o = o * exp2f(l2g * (float)(i + 1));
#pragma unroll
        for (int j = 0; j < 4; ++j) if (j <= i) o += vv[j] * sc[i * 4 + j];
        const float ss = wave_sum((o[0] * o[0] + o[1] * o[1]) + (o[2] * o[2] + o[3] * o[3]));
        const float rstd = 1.0f / sqrtf(ss * (1.0f / 256.0f) + EPS);
        const f32x4 w4 = *(const f32x4*)(rnw + h * 256 + 4 * lane);
        const f32x4 gt = unpack4(*(const u32x2*)(Z + (size_t)(rs + i) * DIN + 3072 + h * 256 + 4 * lane));
        f32x4 r;
#pragma unroll
        for (int e = 0; e < 4; ++e) r[e] = o[e] * rstd * w4[e] * (gt[e] / (1.0f + __expf(-gt[e])));
        *(u32x2*)(CAT + (size_t)(rs + i) * DM + h * 256 + 4 * lane) = pack4(r); }
    __syncthreads();
}

DI void pooled_items(const bf16* __restrict__ Z, const float* __restrict__ spool, bf16* __restrict__ PL, float* __restrict__ pbs, int gw, int NGW, int lane) {
    for (int it = gw; it < MT * 2; it += NGW) {
        const int row = it >> 1, col = (it & 1) * 512 + lane * 8, w = 2 << (col >> 8);
        float s[8], u0[8];
#pragma unroll
        for (int e = 0; e < 8; ++e) { s[e] = 0.f; u0[e] = 0.f; }
        float inv;
        if (row < MP) {
            const int t = row & (SEQ - 1), n = (t + 1 < w) ? t + 1 : w; inv = 1.0f / (float)n;
#pragma unroll
            for (int k = 0; k < 16; ++k) if (k < n) { const u32x4 v = *(const u32x4*)(Z + (size_t)(row - k) * DIN + 4096 + col);
                const f32x4 a = unpack4((u32x2){v.x, v.y}), c = unpack4((u32x2){v.z, v.w});
#pragma unroll
                for (int e = 0; e < 4; ++e) { s[e] += a[e]; s[4 + e] += c[e]; if (k == 0) { u0[e] = a[e]; u0[4 + e] = c[e]; } } }
        } else {
            const int rr = row - MP, b = rr >> 2, t = rr & 3; inv = 1.0f / (float)w;
#pragma unroll
            for (int k = 0; k < 16; ++k) if (k < w) { const int idx = 15 + t - k; f32x4 a, c;
                if (idx >= 15) { const u32x4 v = *(const u32x4*)(Z + (size_t)(MP + 4 * b + idx - 15) * DIN + 4096 + col); a = unpack4((u32x2){v.x, v.y}); c = unpack4((u32x2){v.z, v.w}); }
                else { const float* sp = spool + ((size_t)b * 15 + idx) * DPOOL + col; a = *(const f32x4*)sp; c = *(const f32x4*)(sp + 4); }
#pragma unroll
                for (int e = 0; e < 4; ++e) { s[e] += a[e]; s[4 + e] += c[e]; if (k == 0) { u0[e] = a[e]; u0[4 + e] = c[e]; } } }
        }
        f32x4 o0, o1;
#pragma unroll
        for (int e = 0; e < 4; ++e) { o0[e] = s[e] * inv - u0[e]; o1[e] = s[4 + e] * inv - u0[4 + e]; }
        *(u32x4*)(PL + (size_t)row * DPOOL + col) = pack8(o0, o1);
    }
    for (int it = gw; it < DECB * 11; it += NGW) { const int b = it / 11, r = it - b * 11;
        const f32x4* src = (const f32x4*)(spool + ((size_t)b * 15 + r + 4) * DPOOL) + lane; f32x4* dst = (f32x4*)(pbs + ((size_t)b * 15 + r) * DPOOL) + lane;
#pragma unroll
        for (int j = 0; j < 4; ++j) dst[64 * j] = src[64 * j]; }
}

DI void scan_items(const bf16* __restrict__ KVT, bf16* __restrict__ ST, float* __restrict__ rsp  , int gt, int NGT) {
    for (int it = gt; it < 16 * 8192; it += NGT) {
        const int bh = it >> 13, q8 = it & 8191; const float g128 = exp2f(lg2gamma(bh & 3) * 128.0f);
        f32x4 S0 = (f32x4){0.f, 0.f, 0.f, 0.f}, S1 = (f32x4){0.f, 0.f, 0.f, 0.f};
        u32x4 kv[16];
#pragma unroll
        for (int c = 0; c < 16; ++c) kv[c] = *(const u32x4*)(KVT + ((size_t)(bh * 16 + c) * 8192 + q8) * 8);
#pragma unroll
        for (int c = 0; c < 16; ++c) { S0 = S0 * g128 + unpack4((u32x2){kv[c].x, kv[c].y}); S1 = S1 * g128 + unpack4((u32x2){kv[c].z, kv[c].w});
            if (c < 15) *(u32x4*)(ST + ((size_t)(bh * 16 + c) * 8192 + q8) * 8) = pack8(S0, S1); }
        const int dv = q8 >> 5, dk = (q8 & 31) * 8;
        float* o = rsp + (size_t)bh * 65536 + (size_t)dk * 256 + dv;
        o[0] = S0[0]; o[256] = S0[1]; o[512] = S0[2]; o[768] = S0[3]; o[1024] = S1[0]; o[1280] = S1[1]; o[1536] = S1[2]; o[1792] = S1[3];
    }
}

template <int KS2, int NG>
DI void ret2_pv(unsigned aV, const bf16x8 pf, f32x4 (&oacc)[16]) {
    bf16x8 vf[4]; tr_frag4<(32 * KS2) * RP + NG * 128, 16 * RP, 32>(aV, vf);
#pragma unroll
    for (int f = 0; f < 4; ++f) oacc[4 * NG + f] = MFMA16(vf[f], pf, oacc[4 * NG + f]);
}
template <int KS2, int MG>
DI void xat_pv(unsigned aV, const bf16x8 pf, f32x4 (&oacc)[8]) {
    bf16x8 vf[4]; tr_frag4<(32 * KS2) * VP + MG * 128, 16 * VP, 32>(aV, vf);
#pragma unroll
    for (int f = 0; f < 4; ++f) oacc[4 * MG + f] = MFMA16(vf[f], pf, oacc[4 * MG + f]);
}
template <int PPR> DI void chunk_ld(u32x4 (&r)[8], const bf16* __restrict__ src, size_t src_pitch, int tid) {
    const bf16* p = src + (size_t)(tid / PPR) * src_pitch + (tid % PPR) * 8;
#pragma unroll
    for (int i = 0; i < 8; ++i) r[i] = *(const u32x4*)(p + (size_t)i * (512 / PPR) * src_pitch);
}
template <int PPR, int PITCH> DI void chunk_st(LAS unsigned char* dst, const u32x4 (&r)[8], int tid) {
    LAS unsigned char* d = dst + (tid / PPR) * PITCH + (tid % PPR) * 16;
#pragma unroll
    for (int i = 0; i < 8; ++i) *(LAS u32x4*)(d + i * (512 / PPR) * PITCH) = r[i];
}
constexpr int KP = 1040;
constexpr int XBUF = 69632;

DI void xattn_p_unit2(LAS unsigned char* big, const bf16* __restrict__ Q2, const bf16* __restrict__ MKB, const bf16* __restrict__ MVB, bf16* __restrict__ ATT, int b, int h, int qt, int tid, int wid, int lane) {
    const int g = lane >> 4, li = lane & 15, q = (lane >> 2) & 3, p = lane & 3;
    const int myrow = b * SEQ + qt * 128 + 16 * wid + li;
    LAS unsigned char* buf0 = big; LAS unsigned char* buf1 = big + XBUF;
    const bf16* kbase = MKB + (size_t)(b * NMEM) * DM + h * 512;
    const bf16* vbase = MVB + (size_t)(b * NMEM) * DM + h * 512;
    u32x4 r[8];
    chunk_ld<64>(r, kbase, DM, tid);
    bf16x8 qf[16];
#pragma unroll
    for (int ks = 0; ks < 16; ++ks) qf[ks] = *(const bf16x8*)(Q2 + (size_t)myrow * DM + h * 512 + 32 * ks + 8 * g);
    chunk_st<64, KP>(buf0, r, tid);
    __syncthreads();
    f32x4 sacc[16];
#pragma unroll
    for (int c = 0; c < 4; ++c) {
        if (c < 3) chunk_ld<64>(r, kbase + (size_t)(64 * (c + 1)) * DM, DM, tid);
        else chunk_ld<16>(r, vbase, DM, tid);
        const LAS unsigned char* cur = (c & 1) ? buf1 : buf0;
#pragma unroll
        for (int j = 0; j < 4; ++j) { const int nb = 4 * c + j; sacc[nb] = (f32x4){0.f, 0.f, 0.f, 0.f};
#pragma unroll
            for (int ks = 0; ks < 16; ++ks) sacc[nb] = MFMA16(*(const LAS bf16x8*)(cur + (16 * j + li) * KP + (32 * ks + 8 * g) * 2), qf[ks], sacc[nb]);
            __builtin_amdgcn_sched_barrier(0); }
        if (c < 3) { chunk_st<64, KP>((c & 1) ? buf0 : buf1, r, tid); __syncthreads(); }
    }
    float mx = -3.0e38f;
#pragma unroll
    for (int nb = 0; nb < 16; ++nb) mx = fmaxf(mx, fmaxf(fmaxf(sacc[nb][0], sacc[nb][1]), fmaxf(sacc[nb][2], sacc[nb][3])));
    mx = fmaxf(mx, __shfl_xor(mx, 16)); mx = fmaxf(mx, __shfl_xor(mx, 32));
    float sum = 0.f;
#pragma unroll
    for (int nb = 0; nb < 16; ++nb)
#pragma unroll
        for (int e = 0; e < 4; ++e) { const float pe = exp2f((sacc[nb][e] - mx) * 1.44269504089f); sacc[nb][e] = pe; sum += pe; }
    sum += __shfl_xor(sum, 16); sum += __shfl_xor(sum, 32);
    const float inv = 1.0f / sum;
    bf16x8 pf[8];
#pragma unroll
    for (int ks2 = 0; ks2 < 8; ++ks2) { u32x4 w; const f32x4 a = sacc[2 * ks2] * inv, c = sacc[2 * ks2 + 1] * inv;
        w.x = cvt_pk_bf16(a[0], a[1]); w.y = cvt_pk_bf16(a[2], a[3]); w.z = cvt_pk_bf16(c[0], c[1]); w.w = cvt_pk_bf16(c[2], c[3]); pf[ks2] = __builtin_bit_cast(bf16x8, w); }
    __syncthreads();
    chunk_st<16, VP>(buf0, r, tid);
    __syncthreads();
    for (int dq = 0; dq < 4; ++dq) {
        if (dq < 3) chunk_ld<16>(r, vbase + (dq + 1) * 128, DM, tid);
        const unsigned aV = lds_addr((dq & 1) ? buf1 : buf0) + (4 * g + q) * VP + 8 * p;
        f32x4 oacc[8];
#pragma unroll
        for (int mb = 0; mb < 8; ++mb) oacc[mb] = (f32x4){0.f, 0.f, 0.f, 0.f};
        xat_pv<0, 0>(aV, pf[0], oacc); xat_pv<0, 1>(aV, pf[0], oacc); xat_pv<1, 0>(aV, pf[1], oacc); xat_pv<1, 1>(aV, pf[1], oacc);
        xat_pv<2, 0>(aV, pf[2], oacc); xat_pv<2, 1>(aV, pf[2], oacc); xat_pv<3, 0>(aV, pf[3], oacc); xat_pv<3, 1>(aV, pf[3], oacc);
        xat_pv<4, 0>(aV, pf[4], oacc); xat_pv<4, 1>(aV, pf[4], oacc); xat_pv<5, 0>(aV, pf[5], oacc); xat_pv<5, 1>(aV, pf[5], oacc);
        xat_pv<6, 0>(aV, pf[6], oacc); xat_pv<6, 1>(aV, pf[6], oacc); xat_pv<7, 0>(aV, pf[7], oacc); xat_pv<7, 1>(aV, pf[7], oacc);
#pragma unroll
        for (int mb = 0; mb < 8; ++mb) *(u32x2*)(ATT + (size_t)myrow * DM + h * 512 + dq * 128 + 16 * mb + 4 * g) = pack4(oacc[mb]);
        if (dq < 3) chunk_st<16, VP>((dq & 1) ? buf0 : buf1, r, tid);
        __syncthreads();
    }
}

DI void ret2_unit2(LAS unsigned char* big, const bf16* __restrict__ Z, const bf16* __restrict__ ST, const float* __restrict__ rnw, bf16* __restrict__ CAT, int bh, int c, int tid, int wid, int lane) {
    const int b = bh >> 2, h = bh & 3, r0 = b * SEQ + c * 128;
    const int g = lane >> 4, li = lane & 15, q = (lane >> 2) & 3, p = lane & 3;
    LAS unsigned char* buf0 = big; LAS unsigned char* buf1 = big + 128 * RP;
    const bf16* kbase = Z + (size_t)r0 * DIN + 1024 + h * 256;
    const bf16* vbase = Z + (size_t)r0 * DIN + 2048 + h * 256;
    const bf16* sbase = ST + ((size_t)(bh * 16 + (c > 0 ? c - 1 : 0)) * 256) * 256;
    const int myrow = r0 + 16 * wid + li;
    u32x4 ra[8], rb[8];
    chunk_ld<32>(ra, kbase, DIN, tid);
    if (c > 0) chunk_ld<32>(rb, sbase, 256, tid); else chunk_ld<32>(rb, vbase, DIN, tid);
    bf16x8 qf[8];
#pragma unroll
    for (int ks = 0; ks < 8; ++ks) qf[ks] = *(const bf16x8*)(Z + (size_t)myrow * DIN + h * 256 + 32 * ks + 8 * g);
    chunk_st<32, RP>(buf0, ra, tid);
    __syncthreads();
    if (c > 0) chunk_ld<32>(ra, sbase + (size_t)128 * 256, 256, tid);
    f32x4 sacc[8];
#pragma unroll
    for (int jb = 0; jb < 8; ++jb) { sacc[jb] = (f32x4){0.f, 0.f, 0.f, 0.f};
        if (jb <= wid) {
#pragma unroll
            for (int ks = 0; ks < 8; ++ks) sacc[jb] = MFMA16(*(const LAS bf16x8*)(buf0 + (16 * jb + li) * RP + (32 * ks + 8 * g) * 2), qf[ks], sacc[jb]); }
        __builtin_amdgcn_sched_barrier(0); }
    const float l2g = lg2gamma(h); const int i = 16 * wid + li;
    bf16x8 pf[4];
#pragma unroll
    for (int ks2 = 0; ks2 < 4; ++ks2) { u32x4 w;
#pragma unroll
        for (int hf = 0; hf < 2; ++hf) { const int jb = 2 * ks2 + hf; float d[4];
#pragma unroll
            for (int e = 0; e < 4; ++e) { const int j = 16 * jb + 4 * g + e; d[e] = (i >= j) ? sacc[jb][e] * exp2f(l2g * (float)(i - j)) : 0.f; }
            w[2 * hf] = cvt_pk_bf16(d[0], d[1]); w[2 * hf + 1] = cvt_pk_bf16(d[2], d[3]); }
        pf[ks2] = __builtin_bit_cast(bf16x8, w); }
    chunk_st<32, RP>(buf1, rb, tid);
    __syncthreads();
    f32x4 oacc[16];
#pragma unroll
    for (int nb = 0; nb < 16; ++nb) oacc[nb] = (f32x4){0.f, 0.f, 0.f, 0.f};
    if (c > 0) {
        chunk_ld<32>(rb, vbase, DIN, tid);
#pragma unroll
        for (int nb = 0; nb < 8; ++nb) {
#pragma unroll
            for (int ks = 0; ks < 8; ++ks) oacc[nb] = MFMA16(*(const LAS bf16x8*)(buf1 + (16 * nb + li) * RP + (32 * ks + 8 * g) * 2), qf[ks], oacc[nb]);
            __builtin_amdgcn_sched_barrier(0); }
        chunk_st<32, RP>(buf0, ra, tid);
        __syncthreads();
#pragma unroll
        for (int nb = 0; nb < 8; ++nb) {
#pragma unroll
            for (int ks = 0; ks < 8; ++ks) oacc[8 + nb] = MFMA16(*(const LAS bf16x8*)(buf0 + (16 * nb + li) * RP + (32 * ks + 8 * g) * 2), qf[ks], oacc[8 + nb]);
            __builtin_amdgcn_sched_barrier(0); }
        const float dq = exp2f(l2g * (float)(i + 1));
#pragma unroll
        for (int nb = 0; nb < 16; ++nb) oacc[nb] = oacc[nb] * dq;
        chunk_st<32, RP>(buf1, rb, tid);
        __syncthreads();
    }
    const unsigned aV = lds_addr(buf1) + (4 * g + q) * RP + 8 * p;
    { ret2_pv<0, 0>(aV, pf[0], oacc); ret2_pv<0, 1>(aV, pf[0], oacc); ret2_pv<0, 2>(aV, pf[0], oacc); ret2_pv<0, 3>(aV, pf[0], oacc); }
    if (wid >= 2) { ret2_pv<1, 0>(aV, pf[1], oacc); ret2_pv<1, 1>(aV, pf[1], oacc); ret2_pv<1, 2>(aV, pf[1], oacc); ret2_pv<1, 3>(aV, pf[1], oacc); }
    if (wid >= 4) { ret2_pv<2, 0>(aV, pf[2], oacc); ret2_pv<2, 1>(aV, pf[2], oacc); ret2_pv<2, 2>(aV, pf[2], oacc); ret2_pv<2, 3>(aV, pf[2], oacc); }
    if (wid >= 6) { ret2_pv<3, 0>(aV, pf[3], oacc); ret2_pv<3, 1>(aV, pf[3], oacc); ret2_pv<3, 2>(aV, pf[3], oacc); ret2_pv<3, 3>(aV, pf[3], oacc); }
    float ss = 0.f;
#pragma unroll
    for (int nb = 0; nb < 16; ++nb) ss += (oacc[nb][0] * oacc[nb][0] + oacc[nb][1] * oacc[nb][1]) + (oacc[nb][2] * oacc[nb][2] + oacc[nb][3] * oacc[nb][3]);
    ss += __shfl_xor(ss, 16); ss += __shfl_xor(ss, 32);
    const float rstd = 1.0f / sqrtf(ss * (1.0f / 256.0f) + EPS);
#pragma unroll
    for (int nb = 0; nb < 16; ++nb) { const int dv = h * 256 + 16 * nb + 4 * g;
        const f32x4 w4 = *(const f32x4*)(rnw + dv); const f32x4 gt = unpack4(*(const u32x2*)(Z + (size_t)myrow * DIN + 3072 + dv));
        f32x4 rr;
#pragma unroll
        for (int e = 0; e < 4; ++e) rr[e] = oacc[nb][e] * rstd * w4[e] * (gt[e] / (1.0f + __expf(-gt[e])));
        *(u32x2*)(CAT + (size_t)myrow * DM + dv) = pack4(rr); }
    __syncthreads();
}

DI void xs_scores(const f32x4 (&x)[16], const f32x4 (&qa)[4], const f32x4 (&qb)[4], LAS float* sc, int keybase, int lane) {
    float v[32];
#pragma unroll
    for (int j = 0; j < 8; ++j)
#pragma unroll
        for (int t = 0; t < 4; ++t) { const f32x4 m = x[2 * j] * qa[t] + x[2 * j + 1] * qb[t]; v[4 * j + t] = (m[0] + m[1]) + (m[2] + m[3]); }
    const bool h32 = (lane & 32) != 0, h16 = (lane & 16) != 0, h8 = (lane & 8) != 0, h4 = (lane & 4) != 0, h2 = (lane & 2) != 0;
#pragma unroll
    for (int i = 0; i < 16; ++i) { const float keep = h32 ? v[i + 16] : v[i], send = h32 ? v[i] : v[i + 16]; v[i] = keep + __shfl_xor(send, 32); }
#pragma unroll
    for (int i = 0; i < 8; ++i) { const float keep = h16 ? v[i + 8] : v[i], send = h16 ? v[i] : v[i + 8]; v[i] = keep + __shfl_xor(send, 16); }
#pragma unroll
    for (int i = 0; i < 4; ++i) { const float keep = h8 ? v[i + 4] : v[i], send = h8 ? v[i] : v[i + 4]; v[i] = keep + __shfl_xor(send, 8); }
#pragma unroll
    for (int i = 0; i < 2; ++i) { const float keep = h4 ? v[i + 2] : v[i], send = h4 ? v[i] : v[i + 2]; v[i] = keep + __shfl_xor(send, 4); }
    { const float keep = h2 ? v[1] : v[0], send = h2 ? v[0] : v[1]; v[0] = keep + __shfl_xor(send, 2); }
    v[0] += __shfl_xor(v[0], 1);
    const int idx = ((lane >> 5) & 1) * 16 + ((lane >> 4) & 1) * 8 + ((lane >> 3) & 1) * 4 + ((lane >> 2) & 1) * 2 + ((lane >> 1) & 1);
    if (!(lane & 1)) sc[(idx & 3) * 256 + keybase + (idx >> 2)] = v[0];
}
DI void xattn_s_unit(LAS unsigned char* big, const bf16* __restrict__ Q2, const float* __restrict__ Kc, const float* __restrict__ Vc, bf16* __restrict__ ATT, int b, int h, int tid, int wid, int lane) {
    LAS float* sc = (LAS float*)big; LAS float* red = sc + 1024;
    const int rs = MP + 4 * b;
    const float* ku = Kc + ((size_t)b * NMEM + 32 * wid) * DM + h * 512;
    const float* vu = Vc + ((size_t)b * NMEM + 32 * wid) * DM + h * 512;
    const unsigned vlo = (unsigned)(4 * lane);
    f32x4 xa[16], xb[16];
#define XS_LD(dst, base, bt) do { _Pragma("unroll") for (int j = 0; j < 8; ++j) { const float* vr_ = base + (8 * (bt) + j) * DM; \
        dst[2 * j] = __builtin_nontemporal_load((const f32x4*)(vr_ + vlo)); dst[2 * j + 1] = __builtin_nontemporal_load((const f32x4*)(vr_ + 256 + vlo)); } } while (0)
    XS_LD(xa, ku, 0);
    f32x4 qa[4], qb[4];
#pragma unroll
    for (int t = 0; t < 4; ++t) { const bf16* qp = Q2 + (size_t)(rs + t) * DM + h * 512 + 4 * lane; qa[t] = unpack4(*(const u32x2*)qp); qb[t] = unpack4(*(const u32x2*)(qp + 256)); }
    __syncthreads();
    XS_LD(xb, ku, 1); xs_scores(xa, qa, qb, sc, 32 * wid, lane); __builtin_amdgcn_sched_barrier(0);
    XS_LD(xa, ku, 2); xs_scores(xb, qa, qb, sc, 32 * wid + 8, lane); __builtin_amdgcn_sched_barrier(0);
    XS_LD(xb, ku, 3); xs_scores(xa, qa, qb, sc, 32 * wid + 16, lane); __builtin_amdgcn_sched_barrier(0);
    XS_LD(xa, vu, 0); xs_scores(xb, qa, qb, sc, 32 * wid + 24, lane); __builtin_amdgcn_sched_barrier(0);
    __syncthreads();
    if (wid < 4) { LAS f32x4* sp = (LAS f32x4*)(sc + wid * 256) + lane; f32x4 s = *sp;
        const float mx = wave_max(fmaxf(fmaxf(s[0], s[1]), fmaxf(s[2], s[3])));
#pragma unroll
        for (int e = 0; e < 4; ++e) s[e] = exp2f((s[e] - mx) * 1.44269504089f);
        const float inv = 1.0f / wave_sum((s[0] + s[1]) + (s[2] + s[3]));
        *sp = s * inv; }
    __syncthreads();
    f32x4 oa[4], ob[4];
#pragma unroll
    for (int t = 0; t < 4; ++t) { oa[t] = (f32x4){0.f, 0.f, 0.f, 0.f}; ob[t] = (f32x4){0.f, 0.f, 0.f, 0.f}; }
#define XS_PV(src, bt) do { _Pragma("unroll") for (int j = 0; j < 8; ++j) { _Pragma("unroll") for (int t = 0; t < 4; ++t) { const float pw = sc[t * 256 + 32 * wid + 8 * (bt) + j]; oa[t] += src[2 * j] * pw; ob[t] += src[2 * j + 1] * pw; } } \
        __builtin_amdgcn_sched_barrier(0); } while (0)
    XS_LD(xb, vu, 1); XS_PV(xa, 0);
    XS_LD(xa, vu, 2); XS_PV(xb, 1);
    XS_LD(xb, vu, 3); XS_PV(xa, 2);
    XS_PV(xb, 3);
#undef XS_LD
#undef XS_PV
#pragma unroll
    for (int t = 0; t < 4; ++t) { *(LAS f32x4*)(red + (wid * 4 + t) * 512 + 4 * lane) = oa[t]; *(LAS f32x4*)(red + (wid * 4 + t) * 512 + 256 + 4 * lane) = ob[t]; }
    __syncthreads();
    { const int t = tid >> 7, d4 = (tid & 127) * 4; f32x4 o = (f32x4){0.f, 0.f, 0.f, 0.f};
#pragma unroll
        for (int w = 0; w < 8; ++w) o += *(LAS f32x4*)(red + (w * 4 + t) * 512 + d4);
        *(u32x2*)(ATT + (size_t)(rs + t) * DM + h * 512 + d4) = pack4(o); }
    __syncthreads();
}

template <int PPR> DI void hchunk_ld(u32x4 (&r)[4], const bf16* __restrict__ src, size_t src_pitch, int tid) {
    const bf16* p = src + (size_t)(tid / PPR) * src_pitch + (tid % PPR) * 8;
#pragma unroll
    for (int i = 0; i < 4; ++i) r[i] = *(const u32x4*)(p + (size_t)i * (512 / PPR) * src_pitch);
}
template <int PPR, int PITCH> DI void hchunk_st(LAS unsigned char* dst, const u32x4 (&r)[4], int tid) {
    LAS unsigned char* d = dst + (tid / PPR) * PITCH + (tid % PPR) * 16;
#pragma unroll
    for (int i = 0; i < 4; ++i) *(LAS u32x4*)(d + i * (512 / PPR) * PITCH) = r[i];
}
constexpr int SG3_BUF = 2 * 64 * RP;
template <class Epi>
DI void sgemm3_tile(LAS unsigned char* big, const bf16* __restrict__ A, size_t lda, const bf16* __restrict__ Bt, int K, int row0, int col0, const Epi& E, int tid, int wid, int lane) {
    const int g = lane >> 4, li = lane & 15, wm = wid & 3, wn = wid >> 2;
    const bf16* ab = A + (size_t)row0 * lda; const bf16* bb = Bt + (size_t)col0 * K;
    const int n = K >> 8;
    u32x4 a0[4], b0[4], a1[4], b1[4];
    hchunk_ld<32>(a0, ab, lda, tid); hchunk_ld<32>(b0, bb, (size_t)K, tid);
    hchunk_ld<32>(a1, ab + 256, lda, tid); hchunk_ld<32>(b1, bb + 256, (size_t)K, tid);
    f32x4 acc[2] = {(f32x4){0.f, 0.f, 0.f, 0.f}, (f32x4){0.f, 0.f, 0.f, 0.f}};
    const int fao = (16 * wm + li) * RP + 16 * g, fbo = 64 * RP + (32 * wn + li) * RP + 16 * g;
#define SG3_ST(bufi, ra_, rb_) do { hchunk_st<32, RP>(big + (bufi) * SG3_BUF, ra_, tid); hchunk_st<32, RP>(big + (bufi) * SG3_BUF + 64 * RP, rb_, tid); } while (0)
#define SG3_LD(ra_, rb_, c_) do { hchunk_ld<32>(ra_, ab + (size_t)(c_) * 256, lda, tid); hchunk_ld<32>(rb_, bb + (size_t)(c_) * 256, (size_t)K, tid); } while (0)
#define SG3_MMA(bufi) do { const LAS unsigned char* fa_ = big + (bufi) * SG3_BUF + fao; const LAS unsigned char* fb_ = big + (bufi) * SG3_BUF + fbo; \
        _Pragma("unroll") for (int ks = 0; ks < 8; ++ks) { const bf16x8 af = *(const LAS bf16x8*)(fa_ + 64 * ks); \
            _Pragma("unroll") for (int nb = 0; nb < 2; ++nb) acc[nb] = MFMA16(*(const LAS bf16x8*)(fb_ + 16 * nb * RP + 64 * ks), af, acc[nb]); } } while (0)
    __syncthreads();
    SG3_ST(0, a0, b0);
    if (2 < n) SG3_LD(a0, b0, 2);
    __syncthreads();
    for (int c = 0; c < n; c += 2) {
        SG3_ST(1, a1, b1);
        if (c + 3 < n) SG3_LD(a1, b1, c + 3);
        SG3_MMA(0);
        __syncthreads();
        if (c + 2 < n) { SG3_ST(0, a0, b0); if (c + 4 < n) SG3_LD(a0, b0, c + 4); }
        SG3_MMA(1);
        __syncthreads();
    }
#undef SG3_ST
#undef SG3_LD
#undef SG3_MMA
    E(row0 + 16 * wm + li, col0 + 32 * wn + 4 * g, acc[0], acc[1], g, (col0 >> 6) * 2 + wn);
}
constexpr int SG4_BUF = 2 * 128 * VP;
template <class Epi>
DI void sgemm4_tile(LAS unsigned char* big, const bf16* __restrict__ A, size_t lda, const bf16* __restrict__ Bt, size_t ldb, int kbeg, int kend, int row0, int col0, const Epi& E, int tid, int wid, int lane) {
    const int g = lane >> 4, li = lane & 15, wm = wid & 3, wn = wid >> 2;
    const bf16* ab = A + (size_t)row0 * lda + kbeg; const bf16* bb = Bt + (size_t)col0 * ldb + kbeg;
    const int n = (kend - kbeg) >> 7;
    u32x4 a0[4], b0[4], a1[4], b1[4];
    hchunk_ld<16>(a0, ab, lda, tid); hchunk_ld<16>(b0, bb, ldb, tid);
    hchunk_ld<16>(a1, ab + 128, lda, tid); hchunk_ld<16>(b1, bb + 128, ldb, tid);
    f32x4 acc[2][4];
#pragma unroll
    for (int mb = 0; mb < 2; ++mb)
#pragma unroll
        for (int nb = 0; nb < 4; ++nb) acc[mb][nb] = (f32x4){0.f, 0.f, 0.f, 0.f};
    const int fao = (32 * wm + li) * VP + 16 * g, fbo = 128 * VP + (64 * wn + li) * VP + 16 * g;
#define SG4_ST(bufi, ra_, rb_) do { hchunk_st<16, VP>(big + (bufi) * SG4_BUF, ra_, tid); hchunk_st<16, VP>(big + (bufi) * SG4_BUF + 128 * VP, rb_, tid); } while (0)
#define SG4_LD(ra_, rb_, c_) do { hchunk_ld<16>(ra_, ab + (size_t)(c_) * 128, lda, tid); hchunk_ld<16>(rb_, bb + (size_t)(c_) * 128, ldb, tid); } while (0)
#define SG4_MMA(bufi) do { const LAS unsigned char* fa_ = big + (bufi) * SG4_BUF + fao; const LAS unsigned char* fb_ = big + (bufi) * SG4_BUF + fbo; \
        _Pragma("unroll") for (int ks = 0; ks < 4; ++ks) { const bf16x8 x0 = *(const LAS bf16x8*)(fa_ + 64 * ks), x1 = *(const LAS bf16x8*)(fa_ + 16 * VP + 64 * ks); \
            _Pragma("unroll") for (int nb = 0; nb < 4; ++nb) { const bf16x8 bfr = *(const LAS bf16x8*)(fb_ + 16 * nb * VP + 64 * ks); \
                acc[0][nb] = MFMA16(bfr, x0, acc[0][nb]); acc[1][nb] = MFMA16(bfr, x1, acc[1][nb]); } } } while (0)
    __syncthreads();
    SG4_ST(0, a0, b0);
    if (2 < n) SG4_LD(a0, b0, 2);
    __syncthreads();
    for (int c = 0; c < n; c += 2) {
        SG4_ST(1, a1, b1);
        if (c + 3 < n) SG4_LD(a1, b1, c + 3);
        SG4_MMA(0);
        __syncthreads();
        if (c + 2 < n) { SG4_ST(0, a0, b0); if (c + 4 < n) SG4_LD(a0, b0, c + 4); }
        SG4_MMA(1);
        __syncthreads();
    }
#undef SG4_ST
#undef SG4_LD
#undef SG4_MMA
#pragma unroll
    for (int mb = 0; mb < 2; ++mb)
#pragma unroll
        for (int pr = 0; pr < 2; ++pr) E(row0 + 32 * wm + 16 * mb + li, col0 + 64 * wn + 32 * pr + 4 * g, acc[mb][2 * pr], acc[mb][2 * pr + 1], g, (col0 + 64 * wn + 32 * pr) >> 5);
}
struct SEpiPart { float* part;
    DI void operator()(int row, int col, f32x4 a0, f32x4 a1, int, int) const { float* o = part + (size_t)(row - MP) * DM + col; *(f32x4*)o = a0; *(f32x4*)(o + 16) = a1; } };
struct SEpiRes { const float* basef; const bf16* baseb; bf16* xb; float* ssq;
    DI void operator()(int row, int col, f32x4 a0, f32x4 a1, int g, int slot) const { const size_t o = (size_t)row * DM + col;
        f32x4 b0, b1;
        if (basef) { b0 = *(const f32x4*)(basef + o); b1 = *(const f32x4*)(basef + o + 16); } else { b0 = unpack4(*(const u32x2*)(baseb + o)); b1 = unpack4(*(const u32x2*)(baseb + o + 16)); }
        const f32x4 v0 = b0 + a0, v1 = b1 + a1;
        *(u32x2*)(xb + o) = pack4(v0); *(u32x2*)(xb + o + 16) = pack4(v1);
        float sq = ((v0[0] * v0[0] + v0[1] * v0[1]) + (v0[2] * v0[2] + v0[3] * v0[3])) + ((v1[0] * v1[0] + v1[1] * v1[1]) + (v1[2] * v1[2] + v1[3] * v1[3]));
        sq += __shfl_xor(sq, 16); sq += __shfl_xor(sq, 32);
        if (g == 0) ssq[(size_t)row * 64 + slot] = sq; } };
template <int ACT> struct SEpiB { bf16* O; int ldc; float scale; const float* ssq;
    DI void operator()(int row, int col, f32x4 a0, f32x4 a1, int g, int slot) const { const float rs = scale * row_rstd<64>(ssq, row, g); a0 = a0 * rs; a1 = a1 * rs;
        if (ACT == 1) { a0 = __builtin_elementwise_max(a0, (f32x4){0.f, 0.f, 0.f, 0.f}); a1 = __builtin_elementwise_max(a1, (f32x4){0.f, 0.f, 0.f, 0.f}); a0 = a0 * a0; a1 = a1 * a1; }
        *(u32x2*)(O + (size_t)row * ldc + col) = pack4(a0); *(u32x2*)(O + (size_t)row * ldc + col + 16) = pack4(a1); } };

constexpr int PH_PER_LAYER = 10, NPH = 2 + 2 * PH_PER_LAYER;
constexpr int CW_BAR = 1024;
static_assert((CW_BAR + XCD_BAR_WORDS) * 4 <= (int)CTL_ZERO_BYTES, "control words inside the memset region");
struct Args { const float* in[23]; float* out; unsigned char* ws; int ph_lo, ph_hi, use_bar, pad; };

typedef const Args __attribute__((address_space(4)))* ArgsCP;
DI ArgsCP argp() { ArgsCP p = (ArgsCP)__builtin_amdgcn_kernarg_segment_ptr(); asm volatile("" : "+s"(p)); return p; }
__global__ void __launch_bounds__(512, 2) fwd(Args args_unused) {
#define args (*argp())
    extern __shared__ __attribute__((aligned(16))) unsigned char lds_raw[];
    LAS unsigned char* lds = (LAS unsigned char*)lds_raw;
    LAS unsigned char* big = lds + LDS_BIG;
    if (threadIdx.x < 256) ((LAS unsigned*)lds)[threadIdx.x] = 0u;
    __syncthreads();
    if (args.use_bar) (void)xcd_barrier_post((unsigned*)(args.ws + WS_CTL) + CW_BAR, (volatile LAS unsigned*)lds);
    const int lo = args.ph_lo, hi = args.ph_hi;
#ifndef ONLY
#define ONLY -1
#endif
#define IN(k) ((ONLY < 0 || ONLY == ((k) == 0 ? 0 : 1 + ((k) - 1) % PH_PER_LAYER)) && lo <= (k) && (k) < hi)
#ifndef PROBE_REP
#define PROBE_REP -1
#endif
#define NREP(kk) ((PROBE_REP) == (kk) ? 2 : 1)
#define SEAM(k) do { if (IN(k) && IN((k) + 1)) { XcdBarrier bb; bb.bar = (unsigned*)(ws + WS_CTL) + CW_BAR; bb.x = xb_xcc_id(); bb.st = (volatile LAS unsigned*)lds; xcd_barrier(bb); } } while (0)
#define TIDS() int tid = threadIdx.x; asm volatile("" : "+v"(tid)); const int lane = tid & 63, wid = __builtin_amdgcn_readfirstlane(tid >> 6); \
    int G = gridDim.x, bid = blockIdx.x; asm volatile("" : "+s"(G), "+s"(bid)); const int gw = bid * 8 + wid, NGW = G * 8, gt = bid * 512 + tid, NGT = G * 512; (void)lane; (void)gw; (void)NGW; (void)gt; (void)NGT
#define ws (args.ws)
#define out (args.out)
#define cosT ((float*)(ws + WS_COS))
#define sinT ((float*)(ws + WS_SIN))
#define XN ((bf16*)(ws + WS_XN))
#define Z ((bf16*)(ws + WS_Z))
#define KD ((bf16*)(ws + WS_KD))
#define PL ((bf16*)(ws + WS_PL))
#define CAT ((bf16*)(ws + WS_CAT))
#define Q2 ((bf16*)(ws + WS_Q2))
#define ATT ((bf16*)(ws + WS_ATT))
#define XA ((float*)(ws + WS_XA))
#define UP ((bf16*)(ws + WS_UP))
#define MN ((bf16*)(ws + WS_MN))
#define MKB ((bf16*)(ws + WS_MKB))
#define MVB ((bf16*)(ws + WS_MVB))
#define KVT ((bf16*)(ws + WS_KVT))
#define ST ((bf16*)(ws + WS_ST))
#define WL(off) (ws + WS_W + (size_t)l * W_LAYER + (off))

#define RETIDS() int tid_ = threadIdx.x; asm volatile("" : "+v"(tid_)); const int lane_ = tid_ & 63, wid_ = __builtin_amdgcn_readfirstlane(tid_ >> 6), gw_ = bid * 8 + wid_; (void)lane_; (void)gw_
#define SSQ(p) ((float*)(ws + WS_SSQ + (size_t)((p) & 1) * SSQ_BYTES))
#define PHASE(kk) for (int rep = 0; rep < NREP(kk); ++rep)
#define PHASE_VARS(kk) TIDS(); bf16* const XNO = (rep + 1 < NREP(kk)) ? (bf16*)(ws + WS_DUMMY) : XN; (void)XNO
    if (IN(0)) PHASE(0) {
        TIDS();
        constexpr int C_IN = 16 * 40, C_SQ = 16 * 16, C_UP = 16 * 64, C_DN = 64 * 16, C_PW = 16, C_LAYER = C_IN + 5 * C_SQ + C_UP + C_DN + C_PW;
#define CITEM(it_, t_) do { const int l_ = (it_) / C_LAYER; int r_ = (it_) - l_ * C_LAYER; unsigned char* wl_ = ws + WS_W + (size_t)l_ * W_LAYER; \
            if (r_ < C_IN) { t_ = CItem{args.in[8] + (size_t)l_ * DM * DIN, (bf16*)(wl_ + WO_IN), args.in[7] + (size_t)l_ * DM, DM, DIN, r_}; break; } r_ -= C_IN; \
            if (r_ < C_SQ) { t_ = CItem{args.in[12] + (size_t)l_ * DM * DM, (bf16*)(wl_ + WO_OUT), nullptr, DM, DM, r_}; break; } r_ -= C_SQ; \
            if (r_ < C_SQ) { t_ = CItem{args.in[15] + (size_t)l_ * DM * DM, (bf16*)(wl_ + WO_XQ), args.in[13] + (size_t)l_ * DM, DM, DM, r_}; break; } r_ -= C_SQ; \
            if (r_ < C_SQ) { t_ = CItem{args.in[16] + (size_t)l_ * DM * DM, (bf16*)(wl_ + WO_MKV), nullptr, DM, DM, r_}; break; } r_ -= C_SQ; \
            if (r_ < C_SQ) { t_ = CItem{args.in[17] + (size_t)l_ * DM * DM, (bf16*)(wl_ + WO_MKV) + (size_t)DM * DM, nullptr, DM, DM, r_}; break; } r_ -= C_SQ; \
            if (r_ < C_SQ) { t_ = CItem{args.in[18] + (size_t)l_ * DM * DM, (bf16*)(wl_ + WO_XO), nullptr, DM, DM, r_}; break; } r_ -= C_SQ; \
            if (r_ < C_UP) { t_ = CItem{args.in[20] + (size_t)l_ * DM * DFF, (bf16*)(wl_ + WO_UP), args.in[19] + (size_t)l_ * DM, DM, DFF, r_}; break; } r_ -= C_UP; \
            if (r_ < C_DN) { t_ = CItem{args.in[21] + (size_t)l_ * DFF * DM, (bf16*)(wl_ + WO_DN), nullptr, DFF, DM, r_}; break; } r_ -= C_DN; \
            t_ = CItem{args.in[10] + (size_t)(l_ * 4 + (r_ >> 2)) * 65536, (bf16*)(wl_ + WO_POOL) + (size_t)(r_ >> 2) * 65536, nullptr, 256, 256, r_ & 3}; } while (0)
        { LAS float* scr = (LAS float*)big;
          CItem ta, tb; f32x4 va[8], vb[8]; int it = bid;
          if (it < 2 * C_LAYER) { CITEM(it, ta); citem_load(ta, va, tid); }
          if (it + G < 2 * C_LAYER) { CITEM(it + G, tb); citem_load(tb, vb, tid); }
          while (it < 2 * C_LAYER) {
              citem_to_lds(ta, va, scr, tid); __syncthreads();
              const CItem tc = ta;
              if (it + 2 * G < 2 * C_LAYER) { CITEM(it + 2 * G, ta); citem_load(ta, va, tid); }
              citem_store(tc, scr, tid); __syncthreads();
              it += G; if (it >= 2 * C_LAYER) break;
              citem_to_lds(tb, vb, scr, tid); __syncthreads();
              const CItem td = tb;
              if (it + 2 * G < 2 * C_LAYER) { CITEM(it + 2 * G, tb); citem_load(tb, vb, tid); }
              citem_store(td, scr, tid); __syncthreads();
              it += G; } }
#undef CITEM
        for (int idx = gt; idx < NPOS * 128; idx += NGT) { const int p = idx >> 7, d = idx & 127;
            const double pos = (double)(p < SEQ ? p : 16384 + (p - SEQ));
            const double inv = exp2(-(double)d * (13.287712379549449 / 128.0));
            double rev = pos * inv * 0.15915494309189535; rev -= floor(rev);
            const float rf = (float)rev;
            cosT[idx] = __builtin_amdgcn_cosf(rf); sinT[idx] = __builtin_amdgcn_sinf(rf); }
        for (int m = gw; m < MT; m += NGW) { const float* xr = m < MP ? args.in[0] + (size_t)m * DM : args.in[1] + (size_t)(m - MP) * DM; row_to_xb(xr, XN + (size_t)m * DM, SSQ(0) + (size_t)m * 64, m < MP ? 32 : 64, lane); }
        for (int m = gw; m < 2 * 1024; m += NGW) { const int l = m >> 10, r = m & 1023; rms_row_bf16(args.in[2] + (size_t)r * DM, args.in[14] + (size_t)l * DM, MN + (size_t)m * DM, lane); }
    }
    SEAM(0);

    for (int l = 0; l < 2; ++l) {
        const int P = 1 + PH_PER_LAYER * l;
        if (IN(P + 0)) PHASE(1) { PHASE_VARS(1);
            { pg8::Gemm g{XN, (const bf16*)WL(WO_IN), MT, DIN, DM, DM, 0}; pg8::StaticOrder S; S.init(MT, DIN, G, bid);
              EpiZ E{Z, KD, cosT, sinT, out + OUT_PBP + (size_t)l * NB * 15 * DPOOL, out + OUT_PBS + (size_t)l * DECB * 15 * DPOOL, SSQ(3 * l)};
              pg8::gemm_phase<EpiZ, pg8::StaticOrder, true, true>(big, g, S, E); }
            { pg8::Gemm g{MN + (size_t)l * 1024 * DM, (const bf16*)WL(WO_MKV), 1024, 4096, DM, DM, 0}; pg8::StaticOrder S; S.init(1024, 4096, G, G - 1 - bid);
              EpiMemKV E{out + OUT_MK + (size_t)l * 1024 * DM, out + OUT_MV + (size_t)l * 1024 * DM, MKB, MVB};
              pg8::gemm_phase<EpiMemKV, pg8::StaticOrder, true, true>(big, g, S, E); }
        }
        SEAM(P + 0);
        if (IN(P + 1)) PHASE(2) { PHASE_VARS(2);
            for (int pass = 0; pass < 2; ++pass) {
                if ((pass == 0) == ((bid & 1) == 1)) {
                    for (int u = bid; u < 512; u += G) sret_unit(big, Z, args.in[3] + (size_t)l * DECB * 4 * 65536, out + OUT_RSS + (size_t)l * DECB * 4 * 65536, args.in[9] + (size_t)l * DRET, CAT, u >> 2, u & 3, tid, wid, lane);
                } else {
                    for (int u = bid; u < 256; u += G) kvt_unit(big, Z, KD, KVT, u >> 4, u & 15, tid, wid, lane);
                    pooled_items(Z, args.in[4] + (size_t)l * DECB * 15 * DPOOL, PL, out + OUT_PBS + (size_t)l * DECB * 15 * DPOOL, gw, NGW, lane);
                }
            }
        }
        SEAM(P + 1);
        if (IN(P + 2)) PHASE(3) { PHASE_VARS(3);
            scan_items(KVT, ST, out + OUT_RSP + (size_t)l * 16 * 65536, gt, NGT);
            { pg8::Gemm g{PL, (const bf16*)WL(WO_POOL), MT, DPOOL, 256, DPOOL, 256}; pg8::StaticOrder S; S.init(MT, DPOOL, G, bid);
              EpiB<2> E{CAT, DM, 1.0f, args.in[11] + (size_t)l * DPOOL, DRET, nullptr};
              pg8::gemm_phase<EpiB<2>, pg8::StaticOrder, true, true>(big, g, S, E); }
        }
        SEAM(P + 2);
        if (IN(P + 3)) PHASE(4) { PHASE_VARS(4);
            for (int u = bid; u < 256; u += G) ret2_unit2(big, Z, ST, args.in[9] + (size_t)l * DRET, CAT, u >> 4, u & 15, tid, wid, lane);
            { SEpiRes E{l == 0 ? args.in[1] - (size_t)MP * DM : nullptr, XN, XNO, SSQ(3 * l + 1)};
              for (int u = bid; u < 256; u += G) sgemm3_tile(big, CAT, DM, (const bf16*)WL(WO_OUT), DM, MP + (u >> 5) * 64, (u & 31) * 64, E, tid, wid, lane); }
        }
        SEAM(P + 3);
        if (IN(P + 4)) PHASE(5) { PHASE_VARS(5);
            pg8::Gemm g{CAT, (const bf16*)WL(WO_OUT), MP, DM, DM, DM, 0}; pg8::StaticOrder S; S.init(MP, DM, G, bid);
            EpiRes E{l == 0 ? args.in[0] : nullptr, XN, XNO, SSQ(3 * l + 1)};
            pg8::gemm_phase<EpiRes, pg8::StaticOrder, true, true>(big, g, S, E);
            { RETIDS(); SEpiB<0> E2{Q2, DM, 0.044194173824159216f, SSQ(3 * l + 1)};
              for (int u = bid; u < 256; u += G) sgemm3_tile(big, XN, DM, (const bf16*)WL(WO_XQ), DM, MP + (u >> 5) * 64, (u & 31) * 64, E2, tid_, wid_, lane_); }
        }
        SEAM(P + 4);
        if (IN(P + 5)) PHASE(6) { PHASE_VARS(6);
            pg8::Gemm g{XN, (const bf16*)WL(WO_XQ), MP, DM, DM, DM, 0}; pg8::StaticOrder S; S.init(MP, DM, G, bid);
            EpiB<0> E{Q2, DM, 0.044194173824159216f, nullptr, 0, SSQ(3 * l + 1)};
            if (bid & 1) { for (int u = bid; u < 512; u += G) xattn_s_unit(big, Q2, args.in[5] + (size_t)l * DECB * NMEM * DM, args.in[6] + (size_t)l * DECB * NMEM * DM, ATT, u >> 2, u & 3, tid, wid, lane); }
            pg8::gemm_phase<EpiB<0>, pg8::StaticOrder, true, true>(big, g, S, E);
            if (!(bid & 1)) { RETIDS(); for (int u = bid; u < 512; u += G) xattn_s_unit(big, Q2, args.in[5] + (size_t)l * DECB * NMEM * DM, args.in[6] + (size_t)l * DECB * NMEM * DM, ATT, u >> 2, u & 3, tid_, wid_, lane_); }
        }
        SEAM(P + 5);
        if (IN(P + 6)) PHASE(7) { PHASE_VARS(7);
            for (int u = bid; u < 256; u += G) xattn_p_unit2(big, Q2, MKB, MVB, ATT, u >> 6, (u >> 4) & 3, u & 15, tid, wid, lane);
            { SEpiRes E{nullptr, XN, XNO, SSQ(3 * l + 2)};
              for (int u = bid; u < 256; u += G) sgemm3_tile(big, ATT, DM, (const bf16*)WL(WO_XO), DM, MP + (u >> 5) * 64, (u & 31) * 64, E, tid, wid, lane); }
        }
        SEAM(P + 6);
        if (IN(P + 7)) PHASE(8) { PHASE_VARS(8);
            pg8::Gemm g{ATT, (const bf16*)WL(WO_XO), MP, DM, DM, DM, 0}; pg8::StaticOrder S; S.init(MP, DM, G, bid);
            EpiRes E{nullptr, XN, XNO, SSQ(3 * l + 2)};
            pg8::gemm_phase<EpiRes, pg8::StaticOrder, true, true>(big, g, S, E);
            { RETIDS(); SEpiB<1> E2{UP, DFF, 1.0f, SSQ(3 * l + 2)};
#ifndef PROBE_UPS
#define PROBE_UPS 1
#endif
              for (int rp = 0; rp < PROBE_UPS; ++rp)
              for (int u = bid; u < 256; u += G) sgemm4_tile(big, XN, DM, (const bf16*)WL(WO_UP), DM, 0, DM, MP + (u >> 6) * 128, (u & 63) * 128, E2, tid_, wid_, lane_); }
        }
        SEAM(P + 7);
        if (IN(P + 8)) PHASE(9) { PHASE_VARS(9);
            pg8::Gemm g{XN, (const bf16*)WL(WO_UP), MP, DFF, DM, DM, 0}; pg8::StaticOrder S; S.init(MP, DFF, G, bid);
            EpiB<1> E{UP, DFF, 1.0f, nullptr, 0, SSQ(3 * l + 2)};
            pg8::gemm_phase<EpiB<1>, pg8::StaticOrder, true, true>(big, g, S, E);
            { RETIDS();
            for (int u = bid; u < 256; u += G) { const int t = u >> 2, kq = u & 3; SEpiPart E2{(float*)(ws + WS_PART) + (size_t)kq * MS * DM};
                sgemm4_tile(big, UP, DFF, (const bf16*)WL(WO_DN), DFF, kq * 2048, kq * 2048 + 2048, MP + (t >> 4) * 128, (t & 15) * 128, E2, tid_, wid_, lane_); } }
        }
        SEAM(P + 8);
        if (IN(P + 9)) PHASE(10) { PHASE_VARS(10);
            pg8::Gemm g{UP, (const bf16*)WL(WO_DN), MP, DM, DFF, DFF, 0}; pg8::StaticOrder S; S.init(MP, DM, G, bid);
            EpiRes E{nullptr, XN, XNO, SSQ(3 * l + 3)};
            pg8::gemm_phase<EpiRes, pg8::StaticOrder, true, true>(big, g, S, E);
            { RETIDS();
            if (l == 1) { for (int m = MP + gw_; m < MT; m += NGW) rms_row_f32_b(XN + (size_t)m * DM, args.in[22], out + OUT_YS + (size_t)(m - MP) * DM, lane_, (const float*)(ws + WS_PART) + (size_t)(m - MP) * DM, (size_t)MS * DM); }
            else { for (int m = MP + gw_; m < MT; m += NGW) row_fin_bf16(XN + (size_t)m * DM, XNO + (size_t)m * DM, SSQ(3 * l + 3) + (size_t)m * 64, lane_, (const float*)(ws + WS_PART) + (size_t)(m - MP) * DM, (size_t)MS * DM); } }
        }
        SEAM(P + 9);
    }
    if (IN(NPH - 1)) { TIDS(); for (int m = gw; m < MP; m += NGW) rms_row_f32_b(XN + (size_t)m * DM, args.in[22], out + OUT_YP + (size_t)m * DM, lane); }
#undef SSQ
#undef PHASE
#undef PHASE_VARS
#undef IN
#undef SEAM
#undef NREP
#undef TIDS
#undef ws
#undef out
#undef cosT
#undef sinT
#undef XN
#undef Z
#undef KD
#undef PL
#undef CAT
#undef Q2
#undef ATT
#undef XA
#undef UP
#undef MN
#undef MKB
#undef MVB
#undef KVT
#undef ST
#undef WL
#undef args
}

extern "C" void kernel_launch(void* const* d_in, const int* in_sizes, int n_in, void* d_out, int out_size, void* d_ws, size_t ws_size, hipStream_t stream) {
    static int grid = 0;
    if (grid == 0) {
        if (n_in != 23 || (size_t)out_size != OUT_TOTAL || ws_size < WS_END) { fprintf(stderr, "kernel_launch: unexpected shapes (n_in %d, out %d, ws %zu)\n", n_in, out_size, ws_size); grid = -1; return; }
        int dev = 0, cus = 0, per_cu = 0;
        if (hipGetDevice(&dev) != hipSuccess || hipDeviceGetAttribute(&cus, hipDeviceAttributeMultiprocessorCount, dev) != hipSuccess) { grid = -1; return; }
        if (hipFuncSetAttribute((const void*)fwd, hipFuncAttributeMaxDynamicSharedMemorySize, LDS_BYTES) != hipSuccess) { fprintf(stderr, "kernel_launch: hipFuncSetAttribute failed\n"); grid = -1; return; }
        if (hipOccupancyMaxActiveBlocksPerMultiprocessor(&per_cu, (const void*)fwd, 512, LDS_BYTES) != hipSuccess || per_cu < 1) fprintf(stderr, "kernel_launch: occupancy query reports %d blocks per CU\n", per_cu);
        (void)hipGetLastError();
        grid = cus;
    }
    if (grid < 0) return;
    (void)hipMemsetAsync((char*)d_ws + WS_CTL, 0, CTL_ZERO_BYTES, stream);
    Args a{};
    for (int i = 0; i < 23; ++i) a.in[i] = (const float*)d_in[i];
    a.out = (float*)d_out; a.ws = (unsigned char*)d_ws; a.pad = 0;
#if MK_N_LAUNCHES == 1
    a.ph_lo = 0; a.ph_hi = NPH; a.use_bar = 1;
    hipLaunchKernelGGL(fwd, dim3(grid), dim3(512), LDS_BYTES, stream, a);
#else
    for (int ph = 0; ph < NPH; ++ph) { a.ph_lo = ph; a.ph_hi = ph + 1; a.use_bar = 0; hipLaunchKernelGGL(fwd, dim3(grid), dim3(512), LDS_BYTES, stream, a); }
#endif
}
```

```cpp
#include <hip/hip_runtime.h>
#include <cstdio>
#include <cstdint>

#define DI __device__ __forceinline__
#define GAS __attribute__((address_space(1)))
#define LAS __attribute__((address_space(3)))
typedef unsigned short bf16;
typedef short bf16x8 __attribute__((ext_vector_type(8)));
typedef short s16x4 __attribute__((ext_vector_type(4)));
typedef float f32x4 __attribute__((ext_vector_type(4)));
typedef float f32x2 __attribute__((ext_vector_type(2)));
typedef unsigned u32x4 __attribute__((ext_vector_type(4)));
typedef unsigned u32x2 __attribute__((ext_vector_type(2)));

#ifndef MK_N_LAUNCHES
#define MK_N_LAUNCHES 1
#endif

constexpr int DM = 2048, MP = 8192, MS = 512, MT = MP + MS, DIN = 5120, DFF = 8192, DRET = 1024, DPOOL = 1024, NMEM = 256;
constexpr int SEQ = 2048, NB = 4, DECB = 128, DECT = 4, NPOS = SEQ + DECT;
constexpr float EPS = 1e-6f;

constexpr size_t MiB = 1u << 20;
constexpr size_t WS_CTL = 0, CTL_ZERO_BYTES = 64 * 1024;
constexpr size_t WS_COS = 1 * MiB, WS_SIN = 2 * MiB + MiB / 2;
constexpr size_t WS_W = 4 * MiB, W_LAYER = 125 * MiB;
constexpr size_t WO_IN = 0, WO_OUT = 20 * MiB, WO_XQ = 28 * MiB, WO_MKV = 36 * MiB, WO_XO = 52 * MiB, WO_UP = 60 * MiB, WO_DN = 92 * MiB, WO_POOL = 124 * MiB;
constexpr size_t WS_XN = 254 * MiB;
constexpr size_t WS_Z = 288 * MiB;
constexpr size_t WS_KD = 373 * MiB;
constexpr size_t WS_PL = 389 * MiB;
constexpr size_t WS_CAT = 406 * MiB;
constexpr size_t WS_Q2 = 440 * MiB;
constexpr size_t WS_ATT = 474 * MiB;
constexpr size_t WS_XA = 508 * MiB;
constexpr size_t WS_UP = 576 * MiB;
constexpr size_t WS_MN = 712 * MiB;
constexpr size_t WS_MKB = 720 * MiB, WS_MVB = 724 * MiB;
constexpr size_t WS_KVT = 728 * MiB;
constexpr size_t WS_ST = 792 * MiB;
constexpr size_t WS_DUMMY = 824 * MiB;
constexpr size_t WS_SSQ = 892 * MiB, SSQ_BYTES = 4 * MiB;
constexpr size_t WS_PART = 900 * MiB;
constexpr size_t WS_END = 916 * MiB;

constexpr size_t OUT_YP = 0, OUT_YS = 16777216, OUT_RSP = OUT_YS + 1048576, OUT_PBP = OUT_RSP + 2097152, OUT_MK = OUT_PBP + 122880,
                 OUT_MV = OUT_MK + 4194304, OUT_RSS = OUT_MV + 4194304, OUT_PBS = OUT_RSS + 67108864, OUT_TOTAL = OUT_PBS + 3932160;

constexpr int LDS_CTL = 0, LDS_BIG = 1024, LDS_BYTES = 147456;

DI float bf2f(unsigned short b) { return __uint_as_float((unsigned)b << 16); }
typedef __bf16 bf16x2_t __attribute__((ext_vector_type(2)));
DI unsigned cvt_pk_bf16(float lo, float hi) { f32x2 v = {lo, hi}; bf16x2_t b = __builtin_convertvector(v, bf16x2_t); return __builtin_bit_cast(unsigned, b); }
DI u32x4 pack8(f32x4 a, f32x4 b) { u32x4 w; w.x = cvt_pk_bf16(a[0], a[1]); w.y = cvt_pk_bf16(a[2], a[3]); w.z = cvt_pk_bf16(b[0], b[1]); w.w = cvt_pk_bf16(b[2], b[3]); return w; }
DI u32x2 pack4(f32x4 a) { u32x2 w; w.x = cvt_pk_bf16(a[0], a[1]); w.y = cvt_pk_bf16(a[2], a[3]); return w; }
DI f32x4 unpack4(u32x2 w) { f32x4 r; r[0] = __uint_as_float(w.x << 16); r[1] = __uint_as_float(w.x & 0xffff0000u); r[2] = __uint_as_float(w.y << 16); r[3] = __uint_as_float(w.y & 0xffff0000u); return r; }
DI float wave_sum(float v) {
#pragma unroll
    for (int o = 1; o < 64; o <<= 1) v += __shfl_xor(v, o);
    return v;
}
DI float wave_max(float v) {
#pragma unroll
    for (int o = 1; o < 64; o <<= 1) v = fmaxf(v, __shfl_xor(v, o));
    return v;
}
DI float lg2gamma(int h) { return log2f(1.0f - exp2f(-5.0f - (float)h)); }
DI bf16x8 cat8(s16x4 a, s16x4 b) { return __builtin_shufflevector(a, b, 0, 1, 2, 3, 4, 5, 6, 7); }
template <int O0, int O1, int O2, int O3, int O4, int O5, int O6, int O7>
DI void tr8(unsigned a, s16x4 (&o)[8]) {
    asm volatile("ds_read_b64_tr_b16 %0, %8 offset:%9\n\tds_read_b64_tr_b16 %1, %8 offset:%10\n\tds_read_b64_tr_b16 %2, %8 offset:%11\n\tds_read_b64_tr_b16 %3, %8 offset:%12\n\t"
                 "ds_read_b64_tr_b16 %4, %8 offset:%13\n\tds_read_b64_tr_b16 %5, %8 offset:%14\n\tds_read_b64_tr_b16 %6, %8 offset:%15\n\tds_read_b64_tr_b16 %7, %8 offset:%16\n\t"
                 "s_waitcnt lgkmcnt(0)"
                 : "=&v"(o[0]), "=&v"(o[1]), "=&v"(o[2]), "=&v"(o[3]), "=&v"(o[4]), "=&v"(o[5]), "=&v"(o[6]), "=&v"(o[7])
                 : "v"(a), "i"(O0), "i"(O1), "i"(O2), "i"(O3), "i"(O4), "i"(O5), "i"(O6), "i"(O7) : "memory");
}
#define MFMA16(a, b, c) __builtin_amdgcn_mfma_f32_16x16x32_bf16((a), (b), (c), 0, 0, 0)

namespace pg8 {
#define PG8_LAS __attribute__((address_space(3)))
typedef unsigned short bf16_t;
constexpr int BM = 256, BK = 64, HALF = 128, HTB = HALF * BK * 2, STAGE_BYTES = 8 * HTB, NXCD = 8, WGM = 8;
__host__ __device__ __forceinline__ int lds_byte(int r, int c) { const int st = (r >> 4) * 2 + (c >> 5), rr = r & 15, cc = c & 31, ob = rr * 64 + cc * 2; return st * 1024 + (ob ^ (((ob >> 9) & 1) << 5)); }
__host__ __device__ __forceinline__ void stage_rc(int b, int& R, int& C) { const int st = b / 1024, sb = b % 1024, swz = sb ^ (((sb >> 9) & 1) << 5); R = (st >> 1) * 16 + swz / 64; C = (st & 1) * 32 + (swz % 64) / 2; }
__host__ __device__ __forceinline__ int perm32(int rho) { const int n = rho >> 4, i = rho & 15; return 8 * (i >> 2) + 4 * n + (i & 3); }
struct Unit { int pm, pn; };
struct Gemm { const bf16_t* A; const bf16_t* Bt; int M, N, K, lda, a_pn_off; };
struct StaticOrder {
    int nM, nN, nwg, G, c;
    __host__ __device__ void init(int M, int N, int G_, int c_) { nM = M / BM; nN = N / BM; nwg = nM * nN; G = G_; c = c_; }
    __host__ __device__ bool next(int i, Unit& u) const {
        const long L = (long)i * G + c; if (L >= nwg) return false;
        int wgid = (int)L; { const int q = nwg / NXCD, r = nwg % NXCD, xcd = wgid % NXCD, off = wgid / NXCD; wgid = (xcd < r ? xcd * (q + 1) : r * (q + 1) + (xcd - r) * q) + off; }
        const int nig = WGM * nN, gid = wgid / nig, fm = gid * WGM, gsz = (nM - fm) < WGM ? (nM - fm) : WGM;
        u.pm = fm + ((wgid % nig) % gsz); u.pn = (wgid % nig) / gsz; return true;
    }
    __device__ __forceinline__ void a_ready(const Unit&) const {}
    __device__ __forceinline__ void done(const Unit&) const {}
};
template <class Epi, class Sched, bool ALIGN_EPI = false, bool SP2 = false>
__device__ __forceinline__ void gemm_phase(PG8_LAS unsigned char* lds, const Gemm g, const Sched& S, const Epi& E) {
    int tid = threadIdx.x; asm volatile("" : "+v"(tid));
    const int wid = __builtin_amdgcn_readfirstlane(tid >> 6), lane = tid & 63, wr = wid >> 2, wc = wid & 3, fr = lane & 15, fq = lane >> 4;
    int K = g.K, lda = g.lda; asm volatile("" : "+s"(K), "+s"(lda));
    const int nt = K / BK;
    unsigned voffA[2], voffB[2];
#pragma unroll
    for (int i = 0; i < 2; ++i) { int R, C; stage_rc(tid * 16 + i * 8192, R, C); const int Rb = Epi::PERM ? ((R & ~31) + perm32(R & 31)) : R;
        voffA[i] = (unsigned)(R * lda + C) * 2u; voffB[i] = (unsigned)(Rb * K + C) * 2u; }
    const size_t kstep = (size_t)(BK * 2);
    const size_t hstepA = (size_t)HALF * lda * 2, hstepB = (size_t)HALF * K * 2;
    const size_t tstepA = 2 * hstepA, tstepB = 2 * hstepB;
    const unsigned ldsw = (unsigned)wid * 1024u;
    const int aoff = lds_byte(wr * 64 + fr, fq * 8), boff = lds_byte(wc * 32 + fr, fq * 8);
#define PG8_SA(b, h) (((b) * 2 + (h)) * HTB)
#define PG8_SB(b, h) ((4 + (b) * 2 + (h)) * HTB)
#define PG8_STAGE(bufoff, gbase, voff) do { _Pragma("unroll") for (int _i = 0; _i < 2; ++_i) \
        __builtin_amdgcn_global_load_lds((const unsigned*)((const char*)(gbase) + (voff)[_i]), (PG8_LAS unsigned*)(lds + (bufoff) + ldsw + _i * 8192), 16, 0, 0); } while (0)
#define PG8_LDA(dst, b, h) do { _Pragma("unroll") for (int m = 0; m < 4; ++m) _Pragma("unroll") for (int k = 0; k < 2; ++k) dst[m][k] = *(const PG8_LAS bf16x8*)(lds + PG8_SA(b, h) + aoff + m * 2048 + k * 1024); } while (0)
#define PG8_LDB(dst, b, h) do { _Pragma("unroll") for (int n = 0; n < 2; ++n) _Pragma("unroll") for (int k = 0; k < 2; ++k) dst[n][k] = *(const PG8_LAS bf16x8*)(lds + PG8_SB(b, h) + boff + n * 2048 + k * 1024); } while (0)
#define PG8_MMA(ai, bj, At, Bt) do { __builtin_amdgcn_s_setprio(1); _Pragma("unroll") for (int m = 0; m < 4; ++m) _Pragma("unroll") for (int n = 0; n < 2; ++n) _Pragma("unroll") for (int k = 0; k < 2; ++k) \
        acc[ai][bj][m][n] = __builtin_amdgcn_mfma_f32_16x16x32_bf16(Bt[n][k], At[m][k], acc[ai][bj][m][n], 0, 0, 0); __builtin_amdgcn_s_setprio(0); } while (0)
#define PG8_WAIT_V(n) asm volatile("s_waitcnt vmcnt(" #n ")" ::: "memory")
#define PG8_WAIT_L(n) asm volatile("s_waitcnt lgkmcnt(" #n ")" ::: "memory")
#define PG8_BAR __builtin_amdgcn_s_barrier()
#define PG8_SCHED __builtin_amdgcn_sched_barrier(0)
    Unit cur, nxt; int ui = 0;
    if (!S.next(0, cur)) return;
    f32x4 acc[2][2][4][2];
#pragma unroll
    for (int a = 0; a < 2; ++a)
#pragma unroll
        for (int b = 0; b < 2; ++b)
#pragma unroll
            for (int m = 0; m < 4; ++m)
#pragma unroll
                for (int n = 0; n < 2; ++n) acc[a][b][m][n] = (f32x4){0.f, 0.f, 0.f, 0.f};
    bf16x8 At[4][2], B0[2][2], B1[2][2];
    const char* cA = (const char*)g.A + (size_t)cur.pm * tstepA + (size_t)cur.pn * g.a_pn_off * 2; const char* cB = (const char*)g.Bt + (size_t)cur.pn * tstepB;
    S.a_ready(cur);
    if constexpr (SP2) {
        PG8_STAGE(PG8_SB(0, 0), cB, voffB); PG8_STAGE(PG8_SB(0, 1), cB + hstepB, voffB); PG8_STAGE(PG8_SA(0, 0), cA, voffA); PG8_STAGE(PG8_SA(0, 1), cA + hstepA, voffA);
        if (wr == 1) PG8_BAR;
        PG8_WAIT_V(2); PG8_BAR;
        PG8_STAGE(PG8_SB(1, 0), cB + kstep, voffB); PG8_STAGE(PG8_SA(1, 0), cA + kstep, voffA); PG8_STAGE(PG8_SB(1, 1), cB + hstepB + kstep, voffB);
        PG8_WAIT_V(6); PG8_BAR;
    } else {
        PG8_STAGE(PG8_SB(0, 0), cB, voffB); PG8_STAGE(PG8_SA(0, 0), cA, voffA); PG8_STAGE(PG8_SB(0, 1), cB + hstepB, voffB); PG8_STAGE(PG8_SA(0, 1), cA + hstepA, voffA);
        if (wr == 1) PG8_BAR;
        PG8_WAIT_V(4); PG8_BAR;
        PG8_STAGE(PG8_SB(1, 0), cB + kstep, voffB); PG8_STAGE(PG8_SA(1, 0), cA + kstep, voffA); PG8_STAGE(PG8_SB(1, 1), cB + hstepB + kstep, voffB);
        PG8_WAIT_V(6); PG8_BAR;
    }
    for (;;) {
        const bool has_next = S.next(ui + 1, nxt);
        const char* nA = has_next ? (const char*)g.A + (size_t)nxt.pm * tstepA + (size_t)nxt.pn * g.a_pn_off * 2 : cA; const char* nB = has_next ? (const char*)g.Bt + (size_t)nxt.pn * tstepB : cB;
        for (int t = 0; t < nt; t += 2) {
            const bool last = (t == nt - 2);
            const char* a1 = cA + (size_t)(t + 1) * kstep;
            const char* a2 = last ? nA : cA + (size_t)(t + 2) * kstep; const char* b2 = last ? nB : cB + (size_t)(t + 2) * kstep;
            const char* a3 = a2 + kstep; const char* b3 = b2 + kstep;
            if (last && has_next) S.a_ready(nxt);
            if constexpr (SP2) {
            PG8_LDB(B0, 0, 0); PG8_LDB(B1, 0, 1); PG8_SCHED; PG8_LDA(At, 0, 0); PG8_STAGE(PG8_SA(1, 1), a1 + hstepA, voffA);
            PG8_WAIT_V(8); PG8_WAIT_L(0); PG8_BAR; PG8_MMA(0, 0, At, B0); PG8_MMA(0, 1, At, B1); PG8_BAR; PG8_SCHED;
            PG8_LDA(At, 0, 1); PG8_STAGE(PG8_SB(0, 0), b2, voffB); PG8_STAGE(PG8_SB(0, 1), b2 + hstepB, voffB); PG8_STAGE(PG8_SA(0, 0), a2, voffA);
            PG8_WAIT_V(8); PG8_WAIT_L(0); PG8_BAR; PG8_MMA(1, 0, At, B0); PG8_MMA(1, 1, At, B1); PG8_BAR; PG8_SCHED;
            PG8_LDB(B0, 1, 0); PG8_LDB(B1, 1, 1); PG8_SCHED; PG8_LDA(At, 1, 0); PG8_STAGE(PG8_SA(0, 1), a2 + hstepA, voffA);
            PG8_WAIT_V(8); PG8_WAIT_L(0); PG8_BAR; PG8_MMA(0, 0, At, B0); PG8_MMA(0, 1, At, B1); PG8_BAR; PG8_SCHED;
            PG8_LDA(At, 1, 1); PG8_STAGE(PG8_SB(1, 0), b3, voffB); PG8_STAGE(PG8_SB(1, 1), b3 + hstepB, voffB); PG8_STAGE(PG8_SA(1, 0), a3, voffA);
            PG8_WAIT_V(8); PG8_WAIT_L(0); PG8_BAR; PG8_MMA(1, 0, At, B0); PG8_MMA(1, 1, At, B1); PG8_BAR; PG8_SCHED;
            } else {
            PG8_LDB(B0, 0, 0); PG8_SCHED; PG8_LDA(At, 0, 0); PG8_STAGE(PG8_SA(1, 1), a1 + hstepA, voffA);
            PG8_WAIT_L(8); PG8_BAR; PG8_WAIT_L(0); PG8_MMA(0, 0, At, B0); PG8_BAR; PG8_SCHED;
            PG8_LDB(B1, 0, 1); PG8_STAGE(PG8_SB(0, 0), b2, voffB);
            PG8_BAR; PG8_WAIT_L(0); PG8_MMA(0, 1, At, B1); PG8_BAR;
            PG8_LDA(At, 0, 1); PG8_STAGE(PG8_SA(0, 0), a2, voffA);
            PG8_BAR; PG8_WAIT_L(0); PG8_MMA(1, 0, At, B0); PG8_BAR; PG8_SCHED;
            PG8_STAGE(PG8_SB(0, 1), b2 + hstepB, voffB);
            PG8_WAIT_V(6); PG8_BAR; PG8_MMA(1, 1, At, B1); PG8_BAR;
            PG8_LDB(B0, 1, 0); PG8_SCHED; PG8_LDA(At, 1, 0); PG8_STAGE(PG8_SA(0, 1), a2 + hstepA, voffA);
            PG8_WAIT_L(8); PG8_BAR; PG8_WAIT_L(0); PG8_MMA(0, 0, At, B0); PG8_BAR; PG8_SCHED;
            PG8_LDB(B1, 1, 1); PG8_STAGE(PG8_SB(1, 0), b3, voffB);
            PG8_BAR; PG8_WAIT_L(0); PG8_MMA(0, 1, At, B1); PG8_BAR;
            PG8_LDA(At, 1, 1); PG8_STAGE(PG8_SA(1, 0), a3, voffA);
            PG8_BAR; PG8_WAIT_L(0); PG8_MMA(1, 0, At, B0); PG8_BAR; PG8_SCHED;
            PG8_STAGE(PG8_SB(1, 1), b3 + hstepB, voffB);
            PG8_WAIT_V(6); PG8_BAR; PG8_MMA(1, 1, At, B1); PG8_BAR;
            }
        }
        if constexpr (ALIGN_EPI) { if (wr == 0) PG8_BAR; }
        E(acc, cur, wr, wc, fr, fq); S.done(cur);
        if (!has_next) break;
#pragma unroll
        for (int a = 0; a < 2; ++a)
#pragma unroll
            for (int b = 0; b < 2; ++b)
#pragma unroll
                for (int m = 0; m < 4; ++m)
#pragma unroll
                    for (int n = 0; n < 2; ++n) acc[a][b][m][n] = (f32x4){0.f, 0.f, 0.f, 0.f};
        cur = nxt; cA = nA; cB = nB; ++ui;
        if constexpr (ALIGN_EPI) { if (wr == 1) PG8_BAR; }
    }
    PG8_WAIT_V(0);
    if constexpr (!ALIGN_EPI) { if (wr == 0) PG8_BAR; }
    PG8_BAR;
#undef PG8_SA
#undef PG8_SB
#undef PG8_STAGE
#undef PG8_LDA
#undef PG8_LDB
#undef PG8_MMA
#undef PG8_WAIT_V
#undef PG8_WAIT_L
#undef PG8_BAR
#undef PG8_SCHED
}
}
using pg8::Unit;


template <int NS> DI float row_rstd(const float* __restrict__ ssq, int row, int fq) {
    const f32x4* p = (const f32x4*)(ssq + (size_t)row * 64 + fq * (NS / 4)); float s = 0.f;
#pragma unroll
    for (int i = 0; i < NS / 16; ++i) { const f32x4 v = p[i]; s += (v[0] + v[1]) + (v[2] + v[3]); }
    s += __shfl_xor(s, 16); s += __shfl_xor(s, 32);
    return __builtin_amdgcn_rsqf(s * (1.0f / DM) + EPS);
}
struct EpiZ {
    static constexpr bool PERM = true;
    bf16* Z; bf16* KD; const float* cosT; const float* sinT; float* pbp; float* pbs; const float* ssq;
    DI void operator()(const f32x4 (&acc)[2][2][4][2], const Unit& u, int wr, int wc, int fr, int fq) const {
        asm volatile("" : "+v"(fr), "+v"(fq));
        const int type = u.pn >> 2, row0 = u.pm * 256 + wr * 64 + fr, cl = wc * 32 + 8 * fq;
        const bool sample = u.pm >= 32;
        if (type <= 1) {
            const float ksc = type == 1 ? 0.0625f : 1.0f;
#pragma unroll
            for (int ai = 0; ai < 2; ++ai)
#pragma unroll
                for (int m = 0; m < 4; ++m) {
                    const int row = row0 + ai * 128 + m * 16;
                    const int tab = sample ? (SEQ + (row & 3)) : (row & (SEQ - 1));
                    const f32x4 c0 = *(const f32x4*)(cosT + tab * 128 + cl), c1 = *(const f32x4*)(cosT + tab * 128 + cl + 4);
                    const f32x4 s0 = *(const f32x4*)(sinT + tab * 128 + cl), s1 = *(const f32x4*)(sinT + tab * 128 + cl + 4);
                    const float rs = sample ? row_rstd<64>(ssq, row, fq) : row_rstd<32>(ssq, row, fq);
                    const f32x4 a0 = acc[ai][0][m][0] * rs, a1 = acc[ai][0][m][1] * rs, b0 = acc[ai][1][m][0] * rs, b1 = acc[ai][1][m][1] * rs;
                    const f32x4 o10 = (a0 * c0 - b0 * s0) * ksc, o11 = (a1 * c1 - b1 * s1) * ksc, o20 = (b0 * c0 + a0 * s0) * ksc, o21 = (b1 * c1 + a1 * s1) * ksc;
                    bf16* zp = Z + (size_t)row * DIN + u.pn * 256 + cl;
                    *(u32x4*)zp = pack8(o10, o11); *(u32x4*)(zp + 128) = pack8(o20, o21);
                }
        } else {
#pragma unroll
            for (int ai = 0; ai < 2; ++ai)
#pragma unroll
                for (int m = 0; m < 4; ++m) {
                    const int row = row0 + ai * 128 + m * 16;
                    bf16* zp = Z + (size_t)row * DIN + u.pn * 256 + cl;
                    const float rs = sample ? row_rstd<64>(ssq, row, fq) : row_rstd<32>(ssq, row, fq);
                    f32x4 v[2][2];
#pragma unroll
                    for (int bj = 0; bj < 2; ++bj) { v[bj][0] = acc[ai][bj][m][0] * rs; v[bj][1] = acc[ai][bj][m][1] * rs; *(u32x4*)(zp + bj * 128) = pack8(v[bj][0], v[bj][1]); }
                    if (type == 4) {
                        const int cu = (u.pn - 16) * 256 + cl;
                        float* dst = nullptr;
                        if (sample) { const int rr = row - MP; dst = pbs + ((size_t)(rr >> 2) * 15 + 11 + (rr & 3)) * DPOOL + cu; }
                        else { const int t = row & (SEQ - 1); if (t >= SEQ - 15) dst = pbp + ((size_t)(row >> 11) * 15 + (t - (SEQ - 15))) * DPOOL + cu; }
                        if (dst) {
#pragma unroll
                            for (int bj = 0; bj < 2; ++bj) { *(f32x4*)(dst + bj * 128) = v[bj][0]; *(f32x4*)(dst + bj * 128 + 4) = v[bj][1]; }
                        }
                    }
                }
        }
    }
};
struct EpiMemKV {
    static constexpr bool PERM = true;
    float* ok; float* ov; bf16* kb; bf16* vb;
    DI void operator()(const f32x4 (&acc)[2][2][4][2], const Unit& u, int wr, int wc, int fr, int fq) const {
        asm volatile("" : "+v"(fr), "+v"(fq));
        const bool isv = u.pn >= 8; float* of = isv ? ov : ok; bf16* ob = isv ? vb : kb;
        const int row0 = u.pm * 256 + wr * 64 + fr, col0 = (u.pn & 7) * 256 + wc * 32 + 8 * fq;
#pragma unroll
        for (int ai = 0; ai < 2; ++ai)
#pragma unroll
            for (int m = 0; m < 4; ++m) { const size_t ro = (size_t)(row0 + ai * 128 + m * 16) * DM + col0;
#pragma unroll
                for (int bj = 0; bj < 2; ++bj) { const f32x4 v0 = acc[ai][bj][m][0], v1 = acc[ai][bj][m][1];
                    *(f32x4*)(of + ro + bj * 128) = v0; *(f32x4*)(of + ro + bj * 128 + 4) = v1; *(u32x4*)(ob + ro + bj * 128) = pack8(v0, v1); } }
    }
};
struct EpiRes {
    static constexpr bool PERM = true;
    const float* basef; const bf16* baseb; bf16* xb; float* ssq;
    DI void operator()(const f32x4 (&acc)[2][2][4][2], const Unit& u, int wr, int wc, int fr, int fq) const {
        asm volatile("" : "+v"(fr), "+v"(fq));
        const int row0 = u.pm * 256 + wr * 64 + fr, col0 = u.pn * 256 + wc * 32 + 8 * fq;
#pragma unroll
        for (int ai = 0; ai < 2; ++ai)
#pragma unroll
            for (int m = 0; m < 4; ++m) { const int row = row0 + ai * 128 + m * 16; const size_t ro = (size_t)row * DM + col0; float sq = 0.f;
#pragma unroll
                for (int bj = 0; bj < 2; ++bj) { f32x4 b0, b1;
                    if (basef) { b0 = *(const f32x4*)(basef + ro + bj * 128); b1 = *(const f32x4*)(basef + ro + bj * 128 + 4); }
                    else { const u32x4 w = *(const u32x4*)(baseb + ro + bj * 128); b0 = unpack4((u32x2){w.x, w.y}); b1 = unpack4((u32x2){w.z, w.w}); }
                    const f32x4 v0 = b0 + acc[ai][bj][m][0], v1 = b1 + acc[ai][bj][m][1];
                    *(u32x4*)(xb + ro + bj * 128) = pack8(v0, v1);
                    sq += ((v0[0] * v0[0] + v0[1] * v0[1]) + (v0[2] * v0[2] + v0[3] * v0[3])) + ((v1[0] * v1[0] + v1[1] * v1[1]) + (v1[2] * v1[2] + v1[3] * v1[3])); }
                sq += __shfl_xor(sq, 16); sq += __shfl_xor(sq, 32);
                if (fq == 0) ssq[(size_t)row * 64 + u.pn * 4 + wc] = sq; }
    }
};
template <int ACT> struct EpiB {
    static constexpr bool PERM = true;
    bf16* O; int ldc; float scale; const float* cs; int coff; const float* ssq;
    DI void operator()(const f32x4 (&acc)[2][2][4][2], const Unit& u, int wr, int wc, int fr, int fq) const {
        asm volatile("" : "+v"(fr), "+v"(fq));
        const int row0 = u.pm * 256 + wr * 64 + fr, col0 = u.pn * 256 + wc * 32 + 8 * fq;
#pragma unroll
        for (int ai = 0; ai < 2; ++ai)
#pragma unroll
            for (int m = 0; m < 4; ++m) { bf16* rp = O + (size_t)(row0 + ai * 128 + m * 16) * ldc + coff + col0;
                float rs = scale; if (ACT != 2) rs *= row_rstd<32>(ssq, row0 + ai * 128 + m * 16, fq);
#pragma unroll
                for (int bj = 0; bj < 2; ++bj) { f32x4 v0 = acc[ai][bj][m][0], v1 = acc[ai][bj][m][1];
                    if (ACT != 2) { v0 = v0 * rs; v1 = v1 * rs; }
                    if (ACT == 1) { v0 = __builtin_elementwise_max(v0, (f32x4){0.f, 0.f, 0.f, 0.f}); v1 = __builtin_elementwise_max(v1, (f32x4){0.f, 0.f, 0.f, 0.f}); v0 = v0 * v0; v1 = v1 * v1; }
                    if (ACT == 2) { v0 = v0 * *(const f32x4*)(cs + col0 + bj * 128); v1 = v1 * *(const f32x4*)(cs + col0 + bj * 128 + 4); }
                    *(u32x4*)(rp + bj * 128) = pack8(v0, v1); } }
    }
};

#define XB_TMO      128
#define XB_XCNT(j)  (256  + 64 * (j))
#define XB_XSUB(j)  (1280 + 64 * (j))
#define XB_XGEN(j)  (2304 + 64 * (j))
#define XB_TOP      3328
#define XB_TOPGEN   3392
#define XCD_BAR_WORDS 3456
#define XB_SPIN_CAP (1u << 18)
__device__ __forceinline__ unsigned xb_ld(unsigned* p)              { return __hip_atomic_load(p, __ATOMIC_RELAXED, __HIP_MEMORY_SCOPE_AGENT); }
__device__ __forceinline__ unsigned xb_add(unsigned* p, unsigned v) { return __hip_atomic_fetch_add(p, v, __ATOMIC_RELAXED, __HIP_MEMORY_SCOPE_AGENT); }
__device__ __forceinline__ unsigned xb_xcc_id() { return (unsigned)__builtin_amdgcn_s_getreg((3 << 11) | 20) & 0xFu; }
#define XB_SPIN(cond, bar) do { unsigned _sp = 0; while (cond) { __builtin_amdgcn_s_sleep(1); \
    if ((++_sp & 255u) == 0u) { if (xb_ld(&(bar)[XB_TMO])) break; if (_sp > XB_SPIN_CAP) { atomicAdd(&(bar)[XB_TMO], 1u); break; } } } } while (0)
struct XcdBarrier { unsigned* bar; unsigned x; volatile LAS unsigned* st; };
__device__ __forceinline__ XcdBarrier xcd_barrier_post(unsigned* bar, volatile LAS unsigned* st) {
    XcdBarrier b; b.bar = bar; b.x = xb_xcc_id(); b.st = st;
    if (threadIdx.x == 0) (void)xb_add(&bar[XB_XCNT(b.x)], 1u);
    return b;
}
__device__ __forceinline__ void xcd_barrier_complete(unsigned* bar, unsigned x, unsigned& nloc, unsigned& nx) {
    const unsigned G = gridDim.x * gridDim.y * gridDim.z;
    unsigned sum, cnt, mine, sp = 0u;
    for (;;) {
        sum = 0u; cnt = 0u; mine = 0u;
#pragma unroll
        for (unsigned j = 0; j < 16; ++j) { const unsigned c = xb_ld(&bar[XB_XCNT(j)]); sum += c; cnt += (c > 0u) ? 1u : 0u; }
        mine = xb_ld(&bar[XB_XCNT(x)]);
        if (sum == G) break;
        __builtin_amdgcn_s_sleep(1);
        if ((++sp & 255u) == 0u) { if (xb_ld(&bar[XB_TMO])) break; if (sp > XB_SPIN_CAP) { atomicAdd(&bar[XB_TMO], 1u); break; } }
    }
    nloc = mine > 0u ? mine : 1u; nx = cnt > 0u ? cnt : 1u;
}
__device__ __forceinline__ void xcd_barrier(const XcdBarrier& b) {
    asm volatile("s_waitcnt vmcnt(0)" ::: "memory");
    __syncthreads();
    if (threadIdx.x == 0) {
        unsigned* bar = b.bar;
        __builtin_amdgcn_s_waitcnt(0);
        unsigned nloc = b.st[0], nx = b.st[1];
        if (nloc == 0u) { xcd_barrier_complete(bar, b.x, nloc, nx); b.st[0] = nloc; b.st[1] = nx; }
        const unsigned old = xb_add(&bar[XB_XSUB(b.x)], 1u);
        const unsigned gen = old / nloc;
        if (old + 1u == (gen + 1u) * nloc) {
            __builtin_amdgcn_fence(__ATOMIC_RELEASE, "agent");
            asm volatile("s_waitcnt vmcnt(0)" ::: "memory");
            const unsigned og = xb_add(&bar[XB_TOP], 1u);
            const unsigned tg = og / nx;
            if (og + 1u == (tg + 1u) * nx) xb_add(&bar[XB_TOPGEN], 1u);
            else XB_SPIN(xb_ld(&bar[XB_TOPGEN]) == tg, bar);
            __builtin_amdgcn_fence(__ATOMIC_ACQUIRE, "agent");
            xb_add(&bar[XB_XGEN(b.x)], 1u);
            asm volatile("s_waitcnt vmcnt(0)" ::: "memory");
        } else {
            XB_SPIN(xb_ld(&bar[XB_XGEN(b.x)]) == gen, bar);
            __builtin_amdgcn_fence(__ATOMIC_ACQUIRE, "agent");
            asm volatile("s_waitcnt vmcnt(0)" ::: "memory");
        }
    }
    __syncthreads();
}

constexpr int RP = 528;
constexpr int VP = 272;
DI unsigned lds_addr(LAS unsigned char* p) { return (unsigned)(unsigned long)p; }
template <int BASE, int ST, int SF>
DI void tr_frag4(unsigned a, bf16x8 (&f)[4]) {
    s16x4 o[8];
    tr8<BASE, BASE + ST, BASE + SF, BASE + SF + ST, BASE + 2 * SF, BASE + 2 * SF + ST, BASE + 3 * SF, BASE + 3 * SF + ST>(a, o);
    f[0] = cat8(o[0], o[1]); f[1] = cat8(o[2], o[3]); f[2] = cat8(o[4], o[5]); f[3] = cat8(o[6], o[7]);
}

DI void transpose_item(const float* __restrict__ W, int K, int N, bf16* __restrict__ WT, LAS float* scr, int item, int lane, const float* __restrict__ gain = nullptr) {
    const int nblk = N >> 6, kb = item / nblk, nb = item - kb * nblk, k0 = kb * 64, n0 = nb * 64;
    const int lr = lane >> 4, lc = (lane & 15) * 4;
    f32x4 v[16];
#pragma unroll
    for (int i = 0; i < 16; ++i) v[i] = *(const f32x4*)(W + (size_t)(k0 + 4 * i + lr) * N + n0 + lc);
#pragma unroll
    for (int i = 0; i < 16; ++i) { LAS float* s = scr + (4 * i + lr) * 65 + lc; const float gn = gain ? gain[k0 + 4 * i + lr] : 1.0f;
        s[0] = v[i][0] * gn; s[1] = v[i][1] * gn; s[2] = v[i][2] * gn; s[3] = v[i][3] * gn; }
    asm volatile("s_waitcnt lgkmcnt(0)" ::: "memory");
    const int c = lane & 7;
#pragma unroll
    for (int j = 0; j < 8; ++j) { const int n = (lane >> 3) + 8 * j; const LAS float* s = scr + (8 * c) * 65 + n;
        u32x4 o; o.x = cvt_pk_bf16(s[0], s[65]); o.y = cvt_pk_bf16(s[130], s[195]); o.z = cvt_pk_bf16(s[260], s[325]); o.w = cvt_pk_bf16(s[390], s[455]);
        *(u32x4*)(WT + (size_t)(n0 + n) * K + k0 + 8 * c) = o; }
    asm volatile("s_waitcnt lgkmcnt(0)" ::: "memory");
}
struct CItem { const float* W; bf16* WT; const float* gain; int K, N, item; };
DI void citem_load(const CItem& t, f32x4 (&v)[8], int tid) {
    const int nblk = t.N >> 7, kb = t.item / nblk, nb = t.item - kb * nblk;
    const float* p = t.W + (size_t)(128 * kb + (tid >> 5)) * t.N + 128 * nb + (tid & 31) * 4;
#pragma unroll
    for (int i = 0; i < 8; ++i) v[i] = __builtin_nontemporal_load((const f32x4*)(p + (size_t)(16 * i) * t.N));
}
DI void citem_to_lds(const CItem& t, const f32x4 (&v)[8], LAS float* scr, int tid) {
    const int nblk = t.N >> 7, kb = t.item / nblk, k0 = 128 * kb;
#pragma unroll
    for (int i = 0; i < 8; ++i) { const int row = (tid >> 5) + 16 * i; LAS float* s = scr + row * 129 + (tid & 31) * 4; const float gn = t.gain ? t.gain[k0 + row] : 1.0f;
        s[0] = v[i][0] * gn; s[1] = v[i][1] * gn; s[2] = v[i][2] * gn; s[3] = v[i][3] * gn; }
}
DI void citem_store(const CItem& t, const LAS float* scr, int tid) {
    const int nblk = t.N >> 7, kb = t.item / nblk, nb = t.item - kb * nblk, k0 = 128 * kb, n0 = 128 * nb;
    const int c = tid & 15;
#pragma unroll
    for (int j = 0; j < 4; ++j) { const int n = (tid >> 4) + 32 * j; const LAS float* s = scr + (8 * c) * 129 + n;
        u32x4 o; o.x = cvt_pk_bf16(s[0], s[129]); o.y = cvt_pk_bf16(s[258], s[387]); o.z = cvt_pk_bf16(s[516], s[645]); o.w = cvt_pk_bf16(s[774], s[903]);
        *(u32x4*)(t.WT + (size_t)(n0 + n) * t.K + k0 + 8 * c) = o; }
}
DI void rms_row_bf16(const float* __restrict__ xrow, const float* __restrict__ w, bf16* __restrict__ orow, int lane) {
    const f32x4* xr = (const f32x4*)xrow + lane; const f32x4* wr = (const f32x4*)w + lane;
    f32x4 v[8]; float s = 0.f;
#pragma unroll
    for (int j = 0; j < 8; ++j) { v[j] = xr[64 * j]; s += (v[j][0] * v[j][0] + v[j][1] * v[j][1]) + (v[j][2] * v[j][2] + v[j][3] * v[j][3]); }
    const float rstd = 1.0f / sqrtf(wave_sum(s) * (1.0f / DM) + EPS);
    u32x2* o = (u32x2*)orow + lane;
#pragma unroll
    for (int j = 0; j < 8; ++j) o[64 * j] = pack4(v[j] * rstd * wr[64 * j]);
}
DI void row_to_xb(const float* __restrict__ xrow, bf16* __restrict__ orow, float* __restrict__ ssqrow, int ns, int lane, const float* __restrict__ part = nullptr, size_t pstride = 0, float* __restrict__ xw = nullptr) {
    const f32x4* xr = (const f32x4*)xrow + lane; f32x4 v[8]; float s = 0.f;
#pragma unroll
    for (int j = 0; j < 8; ++j) { v[j] = xr[64 * j];
        if (part) { for (int q = 0; q < 4; ++q) v[j] += ((const f32x4*)(part + q * pstride) + lane)[64 * j]; ((f32x4*)xw + lane)[64 * j] = v[j]; }
        s += (v[j][0] * v[j][0] + v[j][1] * v[j][1]) + (v[j][2] * v[j][2] + v[j][3] * v[j][3]); }
    s = wave_sum(s);
    u32x2* o = (u32x2*)orow + lane;
#pragma unroll
    for (int j = 0; j < 8; ++j) o[64 * j] = pack4(v[j]);
    if (lane < ns) ssqrow[lane] = lane == 0 ? s : 0.f;
}
DI void load_row_bf16(const bf16* __restrict__ xrow, f32x4 (&v)[8], int lane, const float* __restrict__ part, size_t pstride) {
    const u32x2* xr = (const u32x2*)xrow + lane;
#pragma unroll
    for (int j = 0; j < 8; ++j) { v[j] = unpack4(xr[64 * j]);
        if (part) { for (int q = 0; q < 4; ++q) v[j] += ((const f32x4*)(part + q * pstride) + lane)[64 * j]; } }
}
DI void row_fin_bf16(const bf16* __restrict__ xrow, bf16* __restrict__ orow, float* __restrict__ ssqrow, int lane, const float* __restrict__ part, size_t pstride) {
    f32x4 v[8]; load_row_bf16(xrow, v, lane, part, pstride); float s = 0.f;
#pragma unroll
    for (int j = 0; j < 8; ++j) s += (v[j][0] * v[j][0] + v[j][1] * v[j][1]) + (v[j][2] * v[j][2] + v[j][3] * v[j][3]);
    s = wave_sum(s);
    u32x2* o = (u32x2*)orow + lane;
#pragma unroll
    for (int j = 0; j < 8; ++j) o[64 * j] = pack4(v[j]);
    ssqrow[lane] = lane == 0 ? s : 0.f;
}
DI void rms_row_f32_b(const bf16* __restrict__ xrow, const float* __restrict__ w, float* __restrict__ orow, int lane, const float* __restrict__ part = nullptr, size_t pstride = 0) {
    f32x4 v[8]; load_row_bf16(xrow, v, lane, part, pstride); float s = 0.f; const f32x4* wr = (const f32x4*)w + lane;
#pragma unroll
    for (int j = 0; j < 8; ++j) s += (v[j][0] * v[j][0] + v[j][1] * v[j][1]) + (v[j][2] * v[j][2] + v[j][3] * v[j][3]);
    const float rstd = 1.0f / sqrtf(wave_sum(s) * (1.0f / DM) + EPS);
    f32x4* o = (f32x4*)orow + lane;
#pragma unroll
    for (int j = 0; j < 8; ++j) o[64 * j] = v[j] * rstd * wr[64 * j];
}
template <int KS, int NG>
DI void kvt_sub(unsigned aV, const bf16x8 af, f32x4 (&acc)[16]) {
    bf16x8 bf[4]; tr_frag4<(32 * KS) * RP + NG * 128, 4 * RP, 32>(aV, bf);
#pragma unroll
    for (int f = 0; f < 4; ++f) acc[4 * NG + f] = MFMA16(af, bf[f], acc[4 * NG + f]);
}
DI void kvt_unit(LAS unsigned char* big, const bf16* __restrict__ Z, const bf16* __restrict__ KD, bf16* __restrict__ KVT, int bh, int c, int tid, int wid, int lane) {
    const int b = bh >> 2, h = bh & 3, r0 = b * SEQ + c * 128;
    LAS unsigned char* Vs = big; LAS unsigned char* Ks = big + 128 * RP;
    const float l2g = lg2gamma(h);
#pragma unroll
    for (int i = 0; i < 8; ++i) { const int id = tid + 512 * i, row = id >> 5, ch = id & 31;
        const u32x4 v = *(const u32x4*)(Z + (size_t)(r0 + row) * DIN + 2048 + h * 256 + ch * 8);
        const u32x4 k = *(const u32x4*)(Z + (size_t)(r0 + row) * DIN + 1024 + h * 256 + ch * 8);
        const float dk = exp2f(l2g * (float)(127 - row));
        const f32x4 k0 = unpack4((u32x2){k.x, k.y}) * dk, k1 = unpack4((u32x2){k.z, k.w}) * dk;
        *(LAS u32x4*)(Vs + row * RP + ch * 16) = v; *(LAS u32x4*)(Ks + row * RP + ch * 16) = pack8(k0, k1); }
    __syncthreads();
    const int g = lane >> 4, q = (lane >> 2) & 3, p = lane & 3;
    const unsigned aV = lds_addr(Vs) + (8 * g + q) * RP + 8 * p;
    bf16* o = KVT + ((size_t)(bh * 16 + c) * 256) * 256;
    for (int mb = 0; mb < 2; ++mb) {
        const unsigned aK = lds_addr(Ks) + (8 * g + q) * RP + (32 * wid + 16 * mb + 4 * p) * 2;
        bf16x8 af[4]; tr_frag4<0, 4 * RP, 32 * RP>(aK, af);
        f32x4 acc[16];
#pragma unroll
        for (int n = 0; n < 16; ++n) acc[n] = (f32x4){0.f, 0.f, 0.f, 0.f};
        kvt_sub<0, 0>(aV, af[0], acc); kvt_sub<0, 1>(aV, af[0], acc); kvt_sub<0, 2>(aV, af[0], acc); kvt_sub<0, 3>(aV, af[0], acc);
        kvt_sub<1, 0>(aV, af[1], acc); kvt_sub<1, 1>(aV, af[1], acc); kvt_sub<1, 2>(aV, af[1], acc); kvt_sub<1, 3>(aV, af[1], acc);
        kvt_sub<2, 0>(aV, af[2], acc); kvt_sub<2, 1>(aV, af[2], acc); kvt_sub<2, 2>(aV, af[2], acc); kvt_sub<2, 3>(aV, af[2], acc);
        kvt_sub<3, 0>(aV, af[3], acc); kvt_sub<3, 1>(aV, af[3], acc); kvt_sub<3, 2>(aV, af[3], acc); kvt_sub<3, 3>(aV, af[3], acc);
#pragma unroll
        for (int nb = 0; nb < 16; ++nb) *(u32x2*)(o + (size_t)(16 * nb + (lane & 15)) * 256 + 32 * wid + 16 * mb + 4 * g) = pack4(acc[nb]);
    }
    __syncthreads();
}

DI void sret_unit(LAS unsigned char* big, const bf16* __restrict__ Z, const float* __restrict__ S0, float* __restrict__ Sout, const float* __restrict__ rnw, bf16* __restrict__ CAT,
                  int b, int h, int tid, int wid, int lane) {
    LAS float* qs = (LAS float*)big; LAS float* ks_ = qs + 1024; LAS float* vs = qs + 2048; LAS float* sc = qs + 3072; LAS float* red = qs + 3136;
    const int rs = MP + 4 * b; const float l2g = lg2gamma(h);
#pragma unroll
    for (int i = 0; i < 6; ++i) { const int id = tid + 512 * i, which = id >> 10, t = (id >> 8) & 3, d = id & 255;
        qs[id] = bf2f(Z[(size_t)(rs + t) * DIN + which * 1024 + h * 256 + d]); }
    __syncthreads();
#pragma unroll
    for (int pp = 0; pp < 2; ++pp) { const int pi = 2 * wid + pp, i = pi >> 2, j = pi & 3; float s = 0.f;
#pragma unroll
        for (int m = 0; m < 4; ++m) s += qs[i * 256 + lane + 64 * m] * ks_[j * 256 + lane + 64 * m];
        s = wave_sum(s); if (lane == 0) sc[pi] = (i >= j) ? s * exp2f(l2g * (float)(i - j)) : 0.f; }
    const float g4 = exp2f(l2g * 4.0f), gk0 = exp2f(l2g * 3.0f), gk1 = exp2f(l2g * 2.0f), gk2 = exp2f(l2g), gk3 = 1.0f;
    const size_t sbase = ((size_t)(b * 4 + h)) * 65536 + 4 * lane;
    f32x4 vv[4];
#pragma unroll
    for (int j = 0; j < 4; ++j) vv[j] = *(LAS f32x4*)(vs + j * 256 + 4 * lane);
    f32x4 oi[4];
#pragma unroll
    for (int i = 0; i < 4; ++i) oi[i] = (f32x4){0.f, 0.f, 0.f, 0.f};
    float ql[4], kl[4];
    { const int dl = wid + 8 * (lane & 31);
      ql[0] = qs[dl]; ql[1] = qs[256 + dl]; ql[2] = qs[512 + dl]; ql[3] = qs[768 + dl];
      kl[0] = ks_[dl] * gk0; kl[1] = ks_[256 + dl] * gk1; kl[2] = ks_[512 + dl] * gk2; kl[3] = ks_[768 + dl] * gk3; }
#pragma unroll
    for (int rb = 0; rb < 2; ++rb) {
        f32x4 sv[16];
#pragma unroll
        for (int r8 = 0; r8 < 16; ++r8) sv[r8] = __builtin_nontemporal_load((const f32x4*)(S0 + sbase + (size_t)(wid + 8 * (16 * rb + r8)) * 256));
#pragma unroll
        for (int r8 = 0; r8 < 16; ++r8) { const int r = 16 * rb + r8; const f32x4 s = sv[r8];
            const float fq0 = __int_as_float(__builtin_amdgcn_readlane(__float_as_int(ql[0]), r)), fq1 = __int_as_float(__builtin_amdgcn_readlane(__float_as_int(ql[1]), r));
            const float fq2 = __int_as_float(__builtin_amdgcn_readlane(__float_as_int(ql[2]), r)), fq3 = __int_as_float(__builtin_amdgcn_readlane(__float_as_int(ql[3]), r));
            const float fk0 = __int_as_float(__builtin_amdgcn_readlane(__float_as_int(kl[0]), r)), fk1 = __int_as_float(__builtin_amdgcn_readlane(__float_as_int(kl[1]), r));
            const float fk2 = __int_as_float(__builtin_amdgcn_readlane(__float_as_int(kl[2]), r)), fk3 = __int_as_float(__builtin_amdgcn_readlane(__float_as_int(kl[3]), r));
            oi[0] += s * fq0; oi[1] += s * fq1; oi[2] += s * fq2; oi[3] += s * fq3;
            const f32x4 sn = s * g4 + vv[0] * fk0 + vv[1] * fk1 + vv[2] * fk2 + vv[3] * fk3;
            __builtin_nontemporal_store(sn, (f32x4*)(Sout + sbase + (size_t)(wid + 8 * r) * 256)); }
    }
#pragma unroll
    for (int i = 0; i < 4; ++i) *(LAS f32x4*)(red + (wid * 4 + i) * 256 + 4 * lane) = oi[i];
    __syncthreads();
    if (wid < 4) { const int i = wid; f32x4 o = (f32x4){0.f, 0.f, 0.f, 0.f};
#pragma unroll
        for (int w = 0; w < 8; ++w) o += *(LAS f32x4*)(red + (w * 4 + i) * 256 + 4 * lane);
        o = o * exp2f(l2g * (float)(i + 1));
#pragma unroll
        for (int j = 0; j < 4; ++j) if (j <= i) o += vv[j] * sc[i * 4 + j];
        const float ss = wave_sum((o[0] * o[0] + o[1] * o[1]) + (o[2] * o[2] + o[3] * o[3]));
        const float rstd = 1.0f / sqrtf(ss * (1.0f / 256.0f) + EPS);
        const f32x4 w4 = *(const f32x4*)(rnw + h * 256 + 4 * lane);
        const f32x4 gt = unpack4(*(const u32x2*)(Z + (size_t)(rs + i) * DIN + 3072 + h * 256 + 4 * lane));
        f32x4 r;
#pragma unroll
        for (int e = 0; e < 4; ++e) r[e] = o[e] * rstd * w4[e] * (gt[e] / (1.0f + __expf(-gt[e])));
        *(u32x2*)(CAT + (size_t)(rs + i) * DM + h * 256 + 4 * lane) = pack4(r); }
    __syncthreads();
}

DI void pooled_items(const bf16* __restrict__ Z, const float* __restrict__ spool, bf16* __restrict__ PL, float* __restrict__ pbs, int gw, int NGW, int lane) {
    for (int it = gw; it < MT * 2; it += NGW) {
        const int row = it >> 1, col = (it & 1) * 512 + lane * 8, w = 2 << (col >> 8);
        float s[8], u0[8];
#pragma unroll
        for (int e = 0; e < 8; ++e) { s[e] = 0.f; u0[e] = 0.f; }
        float inv;
        if (row < MP) {
            const int t = row & (SEQ - 1), n = (t + 1 < w) ? t + 1 : w; inv = 1.0f / (float)n;
#pragma unroll
            for (int k = 0; k < 16; ++k) if (k < n) { const u32x4 v = *(const u32x4*)(Z + (size_t)(row - k) * DIN + 4096 + col);
                const f32x4 a = unpack4((u32x2){v.x, v.y}), c = unpack4((u32x2){v.z, v.w});
#pragma unroll
                for (int e = 0; e < 4; ++e) { s[e] += a[e]; s[4 + e] += c[e]; if (k == 0) { u0[e] = a[e]; u0[4 + e] = c[e]; } } }
        } else {
            const int rr = row - MP, b = rr >> 2, t = rr & 3; inv = 1.0f / (float)w;
#pragma unroll
            for (int k = 0; k < 16; ++k) if (k < w) { const int idx = 15 + t - k; f32x4 a, c;
                if (idx >= 15) { const u32x4 v = *(const u32x4*)(Z + (size_t)(MP + 4 * b + idx - 15) * DIN + 4096 + col); a = unpack4((u32x2){v.x, v.y}); c = unpack4((u32x2){v.z, v.w}); }
                else { const float* sp = spool + ((size_t)b * 15 + idx) * DPOOL + col; a = *(const f32x4*)sp; c = *(const f32x4*)(sp + 4); }
#pragma unroll
                for (int e = 0; e < 4; ++e) { s[e] += a[e]; s[4 + e] += c[e]; if (k == 0) { u0[e] = a[e]; u0[4 + e] = c[e]; } } }
        }
        f32x4 o0, o1;
#pragma unroll
        for (int e = 0; e < 4; ++e) { o0[e] = s[e] * inv - u0[e]; o1[e] = s[4 + e] * inv - u0[4 + e]; }
        *(u32x4*)(PL + (size_t)row * DPOOL + col) = pack8(o0, o1);
    }
    for (int it = gw; it < DECB * 11; it += NGW) { const int b = it / 11, r = it - b * 11;
        const f32x4* src = (const f32x4*)(spool + ((size_t)b * 15 + r + 4) * DPOOL) + lane; f32x4* dst = (f32x4*)(pbs + ((size_t)b * 15 + r) * DPOOL) + lane;
#pragma unroll
        for (int j = 0; j < 4; ++j) dst[64 * j] = src[64 * j]; }
}

DI void scan_items(const bf16* __restrict__ KVT, bf16* __restrict__ ST, float* __restrict__ rsp  , int gt, int NGT) {
    for (int it = gt; it < 16 * 8192; it += NGT) {
        const int bh = it >> 13, q8 = it & 8191; const float g128 = exp2f(lg2gamma(bh & 3) * 128.0f);
        f32x4 S0 = (f32x4){0.f, 0.f, 0.f, 0.f}, S1 = (f32x4){0.f, 0.f, 0.f, 0.f};
        u32x4 kv[16];
#pragma unroll
        for (int c = 0; c < 16; ++c) kv[c] = *(const u32x4*)(KVT + ((size_t)(bh * 16 + c) * 8192 + q8) * 8);
#pragma unroll
        for (int c = 0; c < 16; ++c) { S0 = S0 * g128 + unpack4((u32x2){kv[c].x, kv[c].y}); S1 = S1 * g128 + unpack4((u32x2){kv[c].z, kv[c].w});
            if (c < 15) *(u32x4*)(ST + ((size_t)(bh * 16 + c) * 8192 + q8) * 8) = pack8(S0, S1); }
        const int dv = q8 >> 5, dk = (q8 & 31) * 8;
        float* o = rsp + (size_t)bh * 65536 + (size_t)dk * 256 + dv;
        o[0] = S0[0]; o[256] = S0[1]; o[512] = S0[2]; o[768] = S0[3]; o[1024] = S1[0]; o[1280] = S1[1]; o[1536] = S1[2]; o[1792] = S1[3];
    }
}

template <int KS2, int NG>
DI void ret2_pv(unsigned aV, const bf16x8 pf, f32x4 (&oacc)[16]) {
    bf16x8 vf[4]; tr_frag4<(32 * KS2) * RP + NG * 128, 16 * RP, 32>(aV, vf);
#pragma unroll
    for (int f = 0; f < 4; ++f) oacc[4 * NG + f] = MFMA16(vf[f], pf, oacc[4 * NG + f]);
}
template <int KS2, int MG>
DI void xat_pv(unsigned aV, const bf16x8 pf, f32x4 (&oacc)[8]) {
    bf16x8 vf[4]; tr_frag4<(32 * KS2) * VP + MG * 128, 16 * VP, 32>(aV, vf);
#pragma unroll
    for (int f = 0; f < 4; ++f) oacc[4 * MG + f] = MFMA16(vf[f], pf, oacc[4 * MG + f]);
}
template <int PPR> DI void chunk_ld(u32x4 (&r)[8], const bf16* __restrict__ src, size_t src_pitch, int tid) {
    const bf16* p = src + (size_t)(tid / PPR) * src_pitch + (tid % PPR) * 8;
#pragma unroll
    for (int i = 0; i < 8; ++i) r[i] = *(const u32x4*)(p + (size_t)i * (512 / PPR) * src_pitch);
}
template <int PPR, int PITCH> DI void chunk_st(LAS unsigned char* dst, const u32x4 (&r)[8], int tid) {
    LAS unsigned char* d = dst + (tid / PPR) * PITCH + (tid % PPR) * 16;
#pragma unroll
    for (int i = 0; i < 8; ++i) *(LAS u32x4*)(d + i * (512 / PPR) * PITCH) = r[i];
}
constexpr int KP = 1040;
constexpr int XBUF = 69632;

DI void xattn_p_unit2(LAS unsigned char* big, const bf16* __restrict__ Q2, const bf16* __restrict__ MKB, const bf16* __restrict__ MVB, bf16* __restrict__ ATT, int b, int h, int qt, int tid, int wid, int lane) {
    const int g = lane >> 4, li = lane & 15, q = (lane >> 2) & 3, p = lane & 3;
    const int myrow = b * SEQ + qt * 128 + 16 * wid + li;
    LAS unsigned char* buf0 = big; LAS unsigned char* buf1 = big + XBUF;
    const bf16* kbase = MKB + (size_t)(b * NMEM) * DM + h * 512;
    const bf16* vbase = MVB + (size_t)(b * NMEM) * DM + h * 512;
    u32x4 r[8];
    chunk_ld<64>(r, kbase, DM, tid);
    bf16x8 qf[16];
#pragma unroll
    for (int ks = 0; ks < 16; ++ks) qf[ks] = *(const bf16x8*)(Q2 + (size_t)myrow * DM + h * 512 + 32 * ks + 8 * g);
    chunk_st<64, KP>(buf0, r, tid);
    __syncthreads();
    f32x4 sacc[16];
#pragma unroll
    for (int c = 0; c < 4; ++c) {
        if (c < 3) chunk_ld<64>(r, kbase + (size_t)(64 * (c + 1)) * DM, DM, tid);
        else chunk_ld<16>(r, vbase, DM, tid);
        const LAS unsigned char* cur = (c & 1) ? buf1 : buf0;
#pragma unroll
        for (int j = 0; j < 4; ++j) { const int nb = 4 * c + j; sacc[nb] = (f32x4){0.f, 0.f, 0.f, 0.f};
#pragma unroll
            for (int ks = 0; ks < 16; ++ks) sacc[nb] = MFMA16(*(const LAS bf16x8*)(cur + (16 * j + li) * KP + (32 * ks + 8 * g) * 2), qf[ks], sacc[nb]);
            __builtin_amdgcn_sched_barrier(0); }
        if (c < 3) { chunk_st<64, KP>((c & 1) ? buf0 : buf1, r, tid); __syncthreads(); }
    }
    float mx = -3.0e38f;
#pragma unroll
    for (int nb = 0; nb < 16; ++nb) mx = fmaxf(mx, fmaxf(fmaxf(sacc[nb][0], sacc[nb][1]), fmaxf(sacc[nb][2], sacc[nb][3])));
    mx = fmaxf(mx, __shfl_xor(mx, 16)); mx = fmaxf(mx, __shfl_xor(mx, 32));
    float sum = 0.f;
#pragma unroll
    for (int nb = 0; nb < 16; ++nb)
#pragma unroll
        for (int e = 0; e < 4; ++e) { const float pe = exp2f((sacc[nb][e] - mx) * 1.44269504089f); sacc[nb][e] = pe; sum += pe; }
    sum += __shfl_xor(sum, 16); sum += __shfl_xor(sum, 32);
    const float inv = 1.0f / sum;
    bf16x8 pf[8];
#pragma unroll
    for (int ks2 = 0; ks2 < 8; ++ks2) { u32x4 w; const f32x4 a = sacc[2 * ks2] * inv, c = sacc[2 * ks2 + 1] * inv;
        w.x = cvt_pk_bf16(a[0], a[1]); w.y = cvt_pk_bf16(a[2], a[3]); w.z = cvt_pk_bf16(c[0], c[1]); w.w = cvt_pk_bf16(c[2], c[3]); pf[ks2] = __builtin_bit_cast(bf16x8, w); }
    __syncthreads();
    chunk_st<16, VP>(buf0, r, tid);
    __syncthreads();
    for (int dq = 0; dq < 4; ++dq) {
        if (dq < 3) chunk_ld<16>(r, vbase + (dq + 1) * 128, DM, tid);
        const unsigned aV = lds_addr((dq & 1) ? buf1 : buf0) + (4 * g + q) * VP + 8 * p;
        f32x4 oacc[8];
#pragma unroll
        for (int mb = 0; mb < 8; ++mb) oacc[mb] = (f32x4){0.f, 0.f, 0.f, 0.f};
        xat_pv<0, 0>(aV, pf[0], oacc); xat_pv<0, 1>(aV, pf[0], oacc); xat_pv<1, 0>(aV, pf[1], oacc); xat_pv<1, 1>(aV, pf[1], oacc);
        xat_pv<2, 0>(aV, pf[2], oacc); xat_pv<2, 1>(aV, pf[2], oacc); xat_pv<3, 0>(aV, pf[3], oacc); xat_pv<3, 1>(aV, pf[3], oacc);
        xat_pv<4, 0>(aV, pf[4], oacc); xat_pv<4, 1>(aV, pf[4], oacc); xat_pv<5, 0>(aV, pf[5], oacc); xat_pv<5, 1>(aV, pf[5], oacc);
        xat_pv<6, 0>(aV, pf[6], oacc); xat_pv<6, 1>(aV, pf[6], oacc); xat_pv<7, 0>(aV, pf[7], oacc); xat_pv<7, 1>(aV, pf[7], oacc);
#pragma unroll
        for (int mb = 0; mb < 8; ++mb) *(u32x2*)(ATT + (size_t)myrow * DM + h * 512 + dq * 128 + 16 * mb + 4 * g) = pack4(oacc[mb]);
        if (dq < 3) chunk_st<16, VP>((dq & 1) ? buf0 : buf1, r, tid);
        __syncthreads();
    }
}

DI void ret2_unit2(LAS unsigned char* big, const bf16* __restrict__ Z, const bf16* __restrict__ ST, const float* __restrict__ rnw, bf16* __restrict__ CAT, int bh, int c, int tid, int wid, int lane) {
    const int b = bh >> 2, h = bh & 3, r0 = b * SEQ + c * 128;
    const int g = lane >> 4, li = lane & 15, q = (lane >> 2) & 3, p = lane & 3;
    LAS unsigned char* buf0 = big; LAS unsigned char* buf1 = big + 128 * RP;
    const bf16* kbase = Z + (size_t)r0 * DIN + 1024 + h * 256;
    const bf16* vbase = Z + (size_t)r0 * DIN + 2048 + h * 256;
    const bf16* sbase = ST + ((size_t)(bh * 16 + (c > 0 ? c - 1 : 0)) * 256) * 256;
    const int myrow = r0 + 16 * wid + li;
    u32x4 r[8];
    chunk_ld<32>(r, kbase, DIN, tid);
    bf16x8 qf[8];
#pragma unroll
    for (int ks = 0; ks < 8; ++ks) qf[ks] = *(const bf16x8*)(Z + (size_t)myrow * DIN + h * 256 + 32 * ks + 8 * g);
    chunk_st<32, RP>(buf0, r, tid);
    __syncthreads();
    if (c > 0) chunk_ld<32>(r, sbase, 256, tid); else chunk_ld<32>(r, vbase, DIN, tid);
    f32x4 sacc[8];
#pragma unroll
    for (int jb = 0; jb < 8; ++jb) { sacc[jb] = (f32x4){0.f, 0.f, 0.f, 0.f};
        if (jb <= wid) {
#pragma unroll
            for (int ks = 0; ks < 8; ++ks) sacc[jb] = MFMA16(*(const LAS bf16x8*)(buf0 + (16 * jb + li) * RP + (32 * ks + 8 * g) * 2), qf[ks], sacc[jb]); }
        __builtin_amdgcn_sched_barrier(0); }
    const float l2g = lg2gamma(h); const int i = 16 * wid + li;
    bf16x8 pf[4];
#pragma unroll
    for (int ks2 = 0; ks2 < 4; ++ks2) { u32x4 w;
#pragma unroll
        for (int hf = 0; hf < 2; ++hf) { const int jb = 2 * ks2 + hf; float d[4];
#pragma unroll
            for (int e = 0; e < 4; ++e) { const int j = 16 * jb + 4 * g + e; d[e] = (i >= j) ? sacc[jb][e] * exp2f(l2g * (float)(i - j)) : 0.f; }
            w[2 * hf] = cvt_pk_bf16(d[0], d[1]); w[2 * hf + 1] = cvt_pk_bf16(d[2], d[3]); }
        pf[ks2] = __builtin_bit_cast(bf16x8, w); }
    chunk_st<32, RP>(buf1, r, tid);
    __syncthreads();
    f32x4 oacc[16];
#pragma unroll
    for (int nb = 0; nb < 16; ++nb) oacc[nb] = (f32x4){0.f, 0.f, 0.f, 0.f};
    if (c > 0) {
        chunk_ld<32>(r, sbase + (size_t)128 * 256, 256, tid);
#pragma unroll
        for (int nb = 0; nb < 8; ++nb) {
#pragma unroll
            for (int ks = 0; ks < 8; ++ks) oacc[nb] = MFMA16(*(const LAS bf16x8*)(buf1 + (16 * nb + li) * RP + (32 * ks + 8 * g) * 2), qf[ks], oacc[nb]);
            __builtin_amdgcn_sched_barrier(0); }
        chunk_st<32, RP>(buf0, r, tid);
        __syncthreads();
        chunk_ld<32>(r, vbase, DIN, tid);
#pragma unroll
        for (int nb = 0; nb < 8; ++nb) {
#pragma unroll
            for (int ks = 0; ks < 8; ++ks) oacc[8 + nb] = MFMA16(*(const LAS bf16x8*)(buf0 + (16 * nb + li) * RP + (32 * ks + 8 * g) * 2), qf[ks], oacc[8 + nb]);
            __builtin_amdgcn_sched_barrier(0); }
        const float dq = exp2f(l2g * (float)(i + 1));
#pragma unroll
        for (int nb = 0; nb < 16; ++nb) oacc[nb] = oacc[nb] * dq;
        chunk_st<32, RP>(buf1, r, tid);
        __syncthreads();
    }
    const unsigned aV = lds_addr(buf1) + (4 * g + q) * RP + 8 * p;
    { ret2_pv<0, 0>(aV, pf[0], oacc); ret2_pv<0, 1>(aV, pf[0], oacc); ret2_pv<0, 2>(aV, pf[0], oacc); ret2_pv<0, 3>(aV, pf[0], oacc); }
    if (wid >= 2) { ret2_pv<1, 0>(aV, pf[1], oacc); ret2_pv<1, 1>(aV, pf[1], oacc); ret2_pv<1, 2>(aV, pf[1], oacc); ret2_pv<1, 3>(aV, pf[1], oacc); }
    if (wid >= 4) { ret2_pv<2, 0>(aV, pf[2], oacc); ret2_pv<2, 1>(aV, pf[2], oacc); ret2_pv<2, 2>(aV, pf[2], oacc); ret2_pv<2, 3>(aV, pf[2], oacc); }
    if (wid >= 6) { ret2_pv<3, 0>(aV, pf[3], oacc); ret2_pv<3, 1>(aV, pf[3], oacc); ret2_pv<3, 2>(aV, pf[3], oacc); ret2_pv<3, 3>(aV, pf[3], oacc); }
    float ss = 0.f;
#pragma unroll
    for (int nb = 0; nb < 16; ++nb) ss += (oacc[nb][0] * oacc[nb][0] + oacc[nb][1] * oacc[nb][1]) + (oacc[nb][2] * oacc[nb][2] + oacc[nb][3] * oacc[nb][3]);
    ss += __shfl_xor(ss, 16); ss += __shfl_xor(ss, 32);
    const float rstd = 1.0f / sqrtf(ss * (1.0f / 256.0f) + EPS);
#pragma unroll
    for (int nb = 0; nb < 16; ++nb) { const int dv = h * 256 + 16 * nb + 4 * g;
        const f32x4 w4 = *(const f32x4*)(rnw + dv); const f32x4 gt = unpack4(*(const u32x2*)(Z + (size_t)myrow * DIN + 3072 + dv));
        f32x4 rr;
#pragma unroll
        for (int e = 0; e < 4; ++e) rr[e] = oacc[nb][e] * rstd * w4[e] * (gt[e] / (1.0f + __expf(-gt[e])));
        *(u32x2*)(CAT + (size_t)myrow * DM + dv) = pack4(rr); }
    __syncthreads();
}

DI void xs_scores(const f32x4 (&x)[16], const f32x4 (&qa)[4], const f32x4 (&qb)[4], LAS float* sc, int keybase, int lane) {
    float v[32];
#pragma unroll
    for (int j = 0; j < 8; ++j)
#pragma unroll
        for (int t = 0; t < 4; ++t) { const f32x4 m = x[2 * j] * qa[t] + x[2 * j + 1] * qb[t]; v[4 * j + t] = (m[0] + m[1]) + (m[2] + m[3]); }
    const bool h32 = (lane & 32) != 0, h16 = (lane & 16) != 0, h8 = (lane & 8) != 0, h4 = (lane & 4) != 0, h2 = (lane & 2) != 0;
#pragma unroll
    for (int i = 0; i < 16; ++i) { const float keep = h32 ? v[i + 16] : v[i], send = h32 ? v[i] : v[i + 16]; v[i] = keep + __shfl_xor(send, 32); }
#pragma unroll
    for (int i = 0; i < 8; ++i) { const float keep = h16 ? v[i + 8] : v[i], send = h16 ? v[i] : v[i + 8]; v[i] = keep + __shfl_xor(send, 16); }
#pragma unroll
    for (int i = 0; i < 4; ++i) { const float keep = h8 ? v[i + 4] : v[i], send = h8 ? v[i] : v[i + 4]; v[i] = keep + __shfl_xor(send, 8); }
#pragma unroll
    for (int i = 0; i < 2; ++i) { const float keep = h4 ? v[i + 2] : v[i], send = h4 ? v[i] : v[i + 2]; v[i] = keep + __shfl_xor(send, 4); }
    { const float keep = h2 ? v[1] : v[0], send = h2 ? v[0] : v[1]; v[0] = keep + __shfl_xor(send, 2); }
    v[0] += __shfl_xor(v[0], 1);
    const int idx = ((lane >> 5) & 1) * 16 + ((lane >> 4) & 1) * 8 + ((lane >> 3) & 1) * 4 + ((lane >> 2) & 1) * 2 + ((lane >> 1) & 1);
    if (!(lane & 1)) sc[(idx & 3) * 256 + keybase + (idx >> 2)] = v[0];
}
DI void xattn_s_unit(LAS unsigned char* big, const bf16* __restrict__ Q2, const float* __restrict__ Kc, const float* __restrict__ Vc, bf16* __restrict__ ATT, int b, int h, int tid, int wid, int lane) {
    LAS float* sc = (LAS float*)big; LAS float* red = sc + 1024;
    const int rs = MP + 4 * b;
    const float* ku = Kc + ((size_t)b * NMEM + 32 * wid) * DM + h * 512;
    const float* vu = Vc + ((size_t)b * NMEM + 32 * wid) * DM + h * 512;
    const unsigned vlo = (unsigned)(4 * lane);
    f32x4 xa[16], xb[16];
#define XS_LD(dst, base, bt) do { _Pragma("unroll") for (int j = 0; j < 8; ++j) { const float* vr_ = base + (8 * (bt) + j) * DM; \
        dst[2 * j] = __builtin_nontemporal_load((const f32x4*)(vr_ + vlo)); dst[2 * j + 1] = __builtin_nontemporal_load((const f32x4*)(vr_ + 256 + vlo)); } } while (0)
    XS_LD(xa, ku, 0);
    f32x4 qa[4], qb[4];
#pragma unroll
    for (int t = 0; t < 4; ++t) { const bf16* qp = Q2 + (size_t)(rs + t) * DM + h * 512 + 4 * lane; qa[t] = unpack4(*(const u32x2*)qp); qb[t] = unpack4(*(const u32x2*)(qp + 256)); }
    __syncthreads();
    XS_LD(xb, ku, 1); xs_scores(xa, qa, qb, sc, 32 * wid, lane); __builtin_amdgcn_sched_barrier(0);
    XS_LD(xa, ku, 2); xs_scores(xb, qa, qb, sc, 32 * wid + 8, lane); __builtin_amdgcn_sched_barrier(0);
    XS_LD(xb, ku, 3); xs_scores(xa, qa, qb, sc, 32 * wid + 16, lane); __builtin_amdgcn_sched_barrier(0);
    XS_LD(xa, vu, 0); xs_scores(xb, qa, qb, sc, 32 * wid + 24, lane); __builtin_amdgcn_sched_barrier(0);
    __syncthreads();
    if (wid < 4) { LAS f32x4* sp = (LAS f32x4*)(sc + wid * 256) + lane; f32x4 s = *sp;
        const float mx = wave_max(fmaxf(fmaxf(s[0], s[1]), fmaxf(s[2], s[3])));
#pragma unroll
        for (int e = 0; e < 4; ++e) s[e] = exp2f((s[e] - mx) * 1.44269504089f);
        const float inv = 1.0f / wave_sum((s[0] + s[1]) + (s[2] + s[3]));
        *sp = s * inv; }
    __syncthreads();
    f32x4 oa[4], ob[4];
#pragma unroll
    for (int t = 0; t < 4; ++t) { oa[t] = (f32x4){0.f, 0.f, 0.f, 0.f}; ob[t] = (f32x4){0.f, 0.f, 0.f, 0.f}; }
#define XS_PV(src, bt) do { _Pragma("unroll") for (int j = 0; j < 8; ++j) { _Pragma("unroll") for (int t = 0; t < 4; ++t) { const float pw = sc[t * 256 + 32 * wid + 8 * (bt) + j]; oa[t] += src[2 * j] * pw; ob[t] += src[2 * j + 1] * pw; } } \
        __builtin_amdgcn_sched_barrier(0); } while (0)
    XS_LD(xb, vu, 1); XS_PV(xa, 0);
    XS_LD(xa, vu, 2); XS_PV(xb, 1);
    XS_LD(xb, vu, 3); XS_PV(xa, 2);
    XS_PV(xb, 3);
#undef XS_LD
#undef XS_PV
#pragma unroll
    for (int t = 0; t < 4; ++t) { *(LAS f32x4*)(red + (wid * 4 + t) * 512 + 4 * lane) = oa[t]; *(LAS f32x4*)(red + (wid * 4 + t) * 512 + 256 + 4 * lane) = ob[t]; }
    __syncthreads();
    { const int t = tid >> 7, d4 = (tid & 127) * 4; f32x4 o = (f32x4){0.f, 0.f, 0.f, 0.f};
#pragma unroll
        for (int w = 0; w < 8; ++w) o += *(LAS f32x4*)(red + (w * 4 + t) * 512 + d4);
        *(u32x2*)(ATT + (size_t)(rs + t) * DM + h * 512 + d4) = pack4(o); }
    __syncthreads();
}

template <int PPR> DI void hchunk_ld(u32x4 (&r)[4], const bf16* __restrict__ src, size_t src_pitch, int tid) {
    const bf16* p = src + (size_t)(tid / PPR) * src_pitch + (tid % PPR) * 8;
#pragma unroll
    for (int i = 0; i < 4; ++i) r[i] = *(const u32x4*)(p + (size_t)i * (512 / PPR) * src_pitch);
}
template <int PPR, int PITCH> DI void hchunk_st(LAS unsigned char* dst, const u32x4 (&r)[4], int tid) {
    LAS unsigned char* d = dst + (tid / PPR) * PITCH + (tid % PPR) * 16;
#pragma unroll
    for (int i = 0; i < 4; ++i) *(LAS u32x4*)(d + i * (512 / PPR) * PITCH) = r[i];
}
constexpr int SG3_BUF = 2 * 64 * RP;
template <class Epi>
DI void sgemm3_tile(LAS unsigned char* big, const bf16* __restrict__ A, size_t lda, const bf16* __restrict__ Bt, int K, int row0, int col0, const Epi& E, int tid, int wid, int lane) {
    const int g = lane >> 4, li = lane & 15, wm = wid & 3, wn = wid >> 2;
    const bf16* ab = A + (size_t)row0 * lda; const bf16* bb = Bt + (size_t)col0 * K;
    const int n = K >> 8;
    u32x4 a0[4], b0[4], a1[4], b1[4];
    hchunk_ld<32>(a0, ab, lda, tid); hchunk_ld<32>(b0, bb, (size_t)K, tid);
    hchunk_ld<32>(a1, ab + 256, lda, tid); hchunk_ld<32>(b1, bb + 256, (size_t)K, tid);
    f32x4 acc[2] = {(f32x4){0.f, 0.f, 0.f, 0.f}, (f32x4){0.f, 0.f, 0.f, 0.f}};
    const int fao = (16 * wm + li) * RP + 16 * g, fbo = 64 * RP + (32 * wn + li) * RP + 16 * g;
#define SG3_ST(bufi, ra_, rb_) do { hchunk_st<32, RP>(big + (bufi) * SG3_BUF, ra_, tid); hchunk_st<32, RP>(big + (bufi) * SG3_BUF + 64 * RP, rb_, tid); } while (0)
#define SG3_LD(ra_, rb_, c_) do { hchunk_ld<32>(ra_, ab + (size_t)(c_) * 256, lda, tid); hchunk_ld<32>(rb_, bb + (size_t)(c_) * 256, (size_t)K, tid); } while (0)
#define SG3_MMA(bufi) do { const LAS unsigned char* fa_ = big + (bufi) * SG3_BUF + fao; const LAS unsigned char* fb_ = big + (bufi) * SG3_BUF + fbo; \
        _Pragma("unroll") for (int ks = 0; ks < 8; ++ks) { const bf16x8 af = *(const LAS bf16x8*)(fa_ + 64 * ks); \
            _Pragma("unroll") for (int nb = 0; nb < 2; ++nb) acc[nb] = MFMA16(*(const LAS bf16x8*)(fb_ + 16 * nb * RP + 64 * ks), af, acc[nb]); } } while (0)
    __syncthreads();
    SG3_ST(0, a0, b0);
    if (2 < n) SG3_LD(a0, b0, 2);
    __syncthreads();
    for (int c = 0; c < n; c += 2) {
        SG3_ST(1, a1, b1);
        if (c + 3 < n) SG3_LD(a1, b1, c + 3);
        SG3_MMA(0);
        __syncthreads();
        if (c + 2 < n) { SG3_ST(0, a0, b0); if (c + 4 < n) SG3_LD(a0, b0, c + 4); }
        SG3_MMA(1);
        __syncthreads();
    }
#undef SG3_ST
#undef SG3_LD
#undef SG3_MMA
    E(row0 + 16 * wm + li, col0 + 32 * wn + 4 * g, acc[0], acc[1], g, (col0 >> 6) * 2 + wn);
}
constexpr int SG4_BUF = 2 * 128 * VP;
template <class Epi>
DI void sgemm4_tile(LAS unsigned char* big, const bf16* __restrict__ A, size_t lda, const bf16* __restrict__ Bt, size_t ldb, int kbeg, int kend, int row0, int col0, const Epi& E, int tid, int wid, int lane) {
    const int g = lane >> 4, li = lane & 15, wm = wid & 3, wn = wid >> 2;
    const bf16* ab = A + (size_t)row0 * lda + kbeg; const bf16* bb = Bt + (size_t)col0 * ldb + kbeg;
    const int n = (kend - kbeg) >> 7;
    u32x4 a0[4], b0[4], a1[4], b1[4];
    hchunk_ld<16>(a0, ab, lda, tid); hchunk_ld<16>(b0, bb, ldb, tid);
    hchunk_ld<16>(a1, ab + 128, lda, tid); hchunk_ld<16>(b1, bb + 128, ldb, tid);
    f32x4 acc[2][4];
#pragma unroll
    for (int mb = 0; mb < 2; ++mb)
#pragma unroll
        for (int nb = 0; nb < 4; ++nb) acc[mb][nb] = (f32x4){0.f, 0.f, 0.f, 0.f};
    const int fao = (32 * wm + li) * VP + 16 * g, fbo = 128 * VP + (64 * wn + li) * VP + 16 * g;
#define SG4_ST(bufi, ra_, rb_) do { hchunk_st<16, VP>(big + (bufi) * SG4_BUF, ra_, tid); hchunk_st<16, VP>(big + (bufi) * SG4_BUF + 128 * VP, rb_, tid); } while (0)
#define SG4_LD(ra_, rb_, c_) do { hchunk_ld<16>(ra_, ab + (size_t)(c_) * 128, lda, tid); hchunk_ld<16>(rb_, bb + (size_t)(c_) * 128, ldb, tid); } while (0)
#define SG4_MMA(bufi) do { const LAS unsigned char* fa_ = big + (bufi) * SG4_BUF + fao; const LAS unsigned char* fb_ = big + (bufi) * SG4_BUF + fbo; \
        _Pragma("unroll") for (int ks = 0; ks < 4; ++ks) { const bf16x8 x0 = *(const LAS bf16x8*)(fa_ + 64 * ks), x1 = *(const LAS bf16x8*)(fa_ + 16 * VP + 64 * ks); \
            _Pragma("unroll") for (int nb = 0; nb < 4; ++nb) { const bf16x8 bfr = *(const LAS bf16x8*)(fb_ + 16 * nb * VP + 64 * ks); \
                acc[0][nb] = MFMA16(bfr, x0, acc[0][nb]); acc[1][nb] = MFMA16(bfr, x1, acc[1][nb]); } } } while (0)
    __syncthreads();
    SG4_ST(0, a0, b0);
    if (2 < n) SG4_LD(a0, b0, 2);
    __syncthreads();
    for (int c = 0; c < n; c += 2) {
        SG4_ST(1, a1, b1);
        if (c + 3 < n) SG4_LD(a1, b1, c + 3);
        SG4_MMA(0);
        __syncthreads();
        if (c + 2 < n) { SG4_ST(0, a0, b0); if (c + 4 < n) SG4_LD(a0, b0, c + 4); }
        SG4_MMA(1);
        __syncthreads();
    }
#undef SG4_ST
#undef SG4_LD
#undef SG4_MMA
#pragma unroll
    for (int mb = 0; mb < 2; ++mb)
#pragma unroll
        for (int pr = 0; pr < 2; ++pr) E(row0 + 32 * wm + 16 * mb + li, col0 + 64 * wn + 32 * pr + 4 * g, acc[mb][2 * pr], acc[mb][2 * pr + 1], g, (col0 + 64 * wn + 32 * pr) >> 5);
}
struct SEpiPart { float* part;
    DI void operator()(int row, int col, f32x4 a0, f32x4 a1, int, int) const { float* o = part + (size_t)(row - MP) * DM + col; *(f32x4*)o = a0; *(f32x4*)(o + 16) = a1; } };
struct SEpiRes { const float* basef; const bf16* baseb; bf16* xb; float* ssq;
    DI void operator()(int row, int col, f32x4 a0, f32x4 a1, int g, int slot) const { const size_t o = (size_t)row * DM + col;
        f32x4 b0, b1;
        if (basef) { b0 = *(const f32x4*)(basef + o); b1 = *(const f32x4*)(basef + o + 16); } else { b0 = unpack4(*(const u32x2*)(baseb + o)); b1 = unpack4(*(const u32x2*)(baseb + o + 16)); }
        const f32x4 v0 = b0 + a0, v1 = b1 + a1;
        *(u32x2*)(xb + o) = pack4(v0); *(u32x2*)(xb + o + 16) = pack4(v1);
        float sq = ((v0[0] * v0[0] + v0[1] * v0[1]) + (v0[2] * v0[2] + v0[3] * v0[3])) + ((v1[0] * v1[0] + v1[1] * v1[1]) + (v1[2] * v1[2] + v1[3] * v1[3]));
        sq += __shfl_xor(sq, 16); sq += __shfl_xor(sq, 32);
        if (g == 0) ssq[(size_t)row * 64 + slot] = sq; } };
template <int ACT> struct SEpiB { bf16* O; int ldc; float scale; const float* ssq;
    DI void operator()(int row, int col, f32x4 a0, f32x4 a1, int g, int slot) const { const float rs = scale * row_rstd<64>(ssq, row, g); a0 = a0 * rs; a1 = a1 * rs;
        if (ACT == 1) { a0 = __builtin_elementwise_max(a0, (f32x4){0.f, 0.f, 0.f, 0.f}); a1 = __builtin_elementwise_max(a1, (f32x4){0.f, 0.f, 0.f, 0.f}); a0 = a0 * a0; a1 = a1 * a1; }
        *(u32x2*)(O + (size_t)row * ldc + col) = pack4(a0); *(u32x2*)(O + (size_t)row * ldc + col + 16) = pack4(a1); } };

constexpr int PH_PER_LAYER = 10, NPH = 2 + 2 * PH_PER_LAYER;
constexpr int CW_BAR = 1024;
static_assert((CW_BAR + XCD_BAR_WORDS) * 4 <= (int)CTL_ZERO_BYTES, "control words inside the memset region");
struct Args { const float* in[23]; float* out; unsigned char* ws; int ph_lo, ph_hi, use_bar, pad; };

typedef const Args __attribute__((address_space(4)))* ArgsCP;
DI ArgsCP argp() { ArgsCP p = (ArgsCP)__builtin_amdgcn_kernarg_segment_ptr(); asm volatile("" : "+s"(p)); return p; }
__global__ void __launch_bounds__(512, 2) fwd(Args args_unused) {
#define args (*argp())
    extern __shared__ __attribute__((aligned(16))) unsigned char lds_raw[];
    LAS unsigned char* lds = (LAS unsigned char*)lds_raw;
    LAS unsigned char* big = lds + LDS_BIG;
    if (threadIdx.x < 256) ((LAS unsigned*)lds)[threadIdx.x] = 0u;
    __syncthreads();
    if (args.use_bar) (void)xcd_barrier_post((unsigned*)(args.ws + WS_CTL) + CW_BAR, (volatile LAS unsigned*)lds);
    const int lo = args.ph_lo, hi = args.ph_hi;
#ifndef ONLY
#define ONLY -1
#endif
#define IN(k) ((ONLY < 0 || ONLY == ((k) == 0 ? 0 : 1 + ((k) - 1) % PH_PER_LAYER)) && lo <= (k) && (k) < hi)
#ifndef PROBE_REP
#define PROBE_REP -1
#endif
#define NREP(kk) ((PROBE_REP) == (kk) ? 2 : 1)
#define SEAM(k) do { if (IN(k) && IN((k) + 1)) { XcdBarrier bb; bb.bar = (unsigned*)(ws + WS_CTL) + CW_BAR; bb.x = xb_xcc_id(); bb.st = (volatile LAS unsigned*)lds; xcd_barrier(bb); } } while (0)
#define TIDS() int tid = threadIdx.x; asm volatile("" : "+v"(tid)); const int lane = tid & 63, wid = __builtin_amdgcn_readfirstlane(tid >> 6); \
    int G = gridDim.x, bid = blockIdx.x; asm volatile("" : "+s"(G), "+s"(bid)); const int gw = bid * 8 + wid, NGW = G * 8, gt = bid * 512 + tid, NGT = G * 512; (void)lane; (void)gw; (void)NGW; (void)gt; (void)NGT
#define ws (args.ws)
#define out (args.out)
#define cosT ((float*)(ws + WS_COS))
#define sinT ((float*)(ws + WS_SIN))
#define XN ((bf16*)(ws + WS_XN))
#define Z ((bf16*)(ws + WS_Z))
#define KD ((bf16*)(ws + WS_KD))
#define PL ((bf16*)(ws + WS_PL))
#define CAT ((bf16*)(ws + WS_CAT))
#define Q2 ((bf16*)(ws + WS_Q2))
#define ATT ((bf16*)(ws + WS_ATT))
#define XA ((float*)(ws + WS_XA))
#define UP ((bf16*)(ws + WS_UP))
#define MN ((bf16*)(ws + WS_MN))
#define MKB ((bf16*)(ws + WS_MKB))
#define MVB ((bf16*)(ws + WS_MVB))
#define KVT ((bf16*)(ws + WS_KVT))
#define ST ((bf16*)(ws + WS_ST))
#define WL(off) (ws + WS_W + (size_t)l * W_LAYER + (off))

#define RETIDS() int tid_ = threadIdx.x; asm volatile("" : "+v"(tid_)); const int lane_ = tid_ & 63, wid_ = __builtin_amdgcn_readfirstlane(tid_ >> 6), gw_ = bid * 8 + wid_; (void)lane_; (void)gw_
#define SSQ(p) ((float*)(ws + WS_SSQ + (size_t)((p) & 1) * SSQ_BYTES))
#define PHASE(kk) for (int rep = 0; rep < NREP(kk); ++rep)
#define PHASE_VARS(kk) TIDS(); bf16* const XNO = (rep + 1 < NREP(kk)) ? (bf16*)(ws + WS_DUMMY) : XN; (void)XNO
    if (IN(0)) PHASE(0) {
        TIDS();
        constexpr int C_IN = 16 * 40, C_SQ = 16 * 16, C_UP = 16 * 64, C_DN = 64 * 16, C_PW = 16, C_LAYER = C_IN + 5 * C_SQ + C_UP + C_DN + C_PW;
#define CITEM(it_, t_) do { const int l_ = (it_) / C_LAYER; int r_ = (it_) - l_ * C_LAYER; unsigned char* wl_ = ws + WS_W + (size_t)l_ * W_LAYER; \
            if (r_ < C_IN) { t_ = CItem{args.in[8] + (size_t)l_ * DM * DIN, (bf16*)(wl_ + WO_IN), args.in[7] + (size_t)l_ * DM, DM, DIN, r_}; break; } r_ -= C_IN; \
            if (r_ < C_SQ) { t_ = CItem{args.in[12] + (size_t)l_ * DM * DM, (bf16*)(wl_ + WO_OUT), nullptr, DM, DM, r_}; break; } r_ -= C_SQ; \
            if (r_ < C_SQ) { t_ = CItem{args.in[15] + (size_t)l_ * DM * DM, (bf16*)(wl_ + WO_XQ), args.in[13] + (size_t)l_ * DM, DM, DM, r_}; break; } r_ -= C_SQ; \
            if (r_ < C_SQ) { t_ = CItem{args.in[16] + (size_t)l_ * DM * DM, (bf16*)(wl_ + WO_MKV), nullptr, DM, DM, r_}; break; } r_ -= C_SQ; \
            if (r_ < C_SQ) { t_ = CItem{args.in[17] + (size_t)l_ * DM * DM, (bf16*)(wl_ + WO_MKV) + (size_t)DM * DM, nullptr, DM, DM, r_}; break; } r_ -= C_SQ; \
            if (r_ < C_SQ) { t_ = CItem{args.in[18] + (size_t)l_ * DM * DM, (bf16*)(wl_ + WO_XO), nullptr, DM, DM, r_}; break; } r_ -= C_SQ; \
            if (r_ < C_UP) { t_ = CItem{args.in[20] + (size_t)l_ * DM * DFF, (bf16*)(wl_ + WO_UP), args.in[19] + (size_t)l_ * DM, DM, DFF, r_}; break; } r_ -= C_UP; \
            if (r_ < C_DN) { t_ = CItem{args.in[21] + (size_t)l_ * DFF * DM, (bf16*)(wl_ + WO_DN), nullptr, DFF, DM, r_}; break; } r_ -= C_DN; \
            t_ = CItem{args.in[10] + (size_t)(l_ * 4 + (r_ >> 2)) * 65536, (bf16*)(wl_ + WO_POOL) + (size_t)(r_ >> 2) * 65536, nullptr, 256, 256, r_ & 3}; } while (0)
        { LAS float* scr = (LAS float*)big;
          CItem ta, tb; f32x4 va[8], vb[8]; int it = bid;
          if (it < 2 * C_LAYER) { CITEM(it, ta); citem_load(ta, va, tid); }
          if (it + G < 2 * C_LAYER) { CITEM(it + G, tb); citem_load(tb, vb, tid); }
          while (it < 2 * C_LAYER) {
              citem_to_lds(ta, va, scr, tid); __syncthreads();
              const CItem tc = ta;
              if (it + 2 * G < 2 * C_LAYER) { CITEM(it + 2 * G, ta); citem_load(ta, va, tid); }
              citem_store(tc, scr, tid); __syncthreads();
              it += G; if (it >= 2 * C_LAYER) break;
              citem_to_lds(tb, vb, scr, tid); __syncthreads();
              const CItem td = tb;
              if (it + 2 * G < 2 * C_LAYER) { CITEM(it + 2 * G, tb); citem_load(tb, vb, tid); }
              citem_store(td, scr, tid); __syncthreads();
              it += G; } }
#undef CITEM
        for (int idx = gt; idx < NPOS * 128; idx += NGT) { const int p = idx >> 7, d = idx & 127;
            const double pos = (double)(p < SEQ ? p : 16384 + (p - SEQ));
            const double inv = exp2(-(double)d * (13.287712379549449 / 128.0));
            double rev = pos * inv * 0.15915494309189535; rev -= floor(rev);
            const float rf = (float)rev;
            cosT[idx] = __builtin_amdgcn_cosf(rf); sinT[idx] = __builtin_amdgcn_sinf(rf); }
        for (int m = gw; m < MT; m += NGW) { const float* xr = m < MP ? args.in[0] + (size_t)m * DM : args.in[1] + (size_t)(m - MP) * DM; row_to_xb(xr, XN + (size_t)m * DM, SSQ(0) + (size_t)m * 64, m < MP ? 32 : 64, lane); }
        for (int m = gw; m < 2 * 1024; m += NGW) { const int l = m >> 10, r = m & 1023; rms_row_bf16(args.in[2] + (size_t)r * DM, args.in[14] + (size_t)l * DM, MN + (size_t)m * DM, lane); }
    }
    SEAM(0);

    for (int l = 0; l < 2; ++l) {
        const int P = 1 + PH_PER_LAYER * l;
        if (IN(P + 0)) PHASE(1) { PHASE_VARS(1);
            { pg8::Gemm g{XN, (const bf16*)WL(WO_IN), MT, DIN, DM, DM, 0}; pg8::StaticOrder S; S.init(MT, DIN, G, bid);
              EpiZ E{Z, KD, cosT, sinT, out + OUT_PBP + (size_t)l * NB * 15 * DPOOL, out + OUT_PBS + (size_t)l * DECB * 15 * DPOOL, SSQ(3 * l)};
              pg8::gemm_phase<EpiZ, pg8::StaticOrder, true, true>(big, g, S, E); }
            { pg8::Gemm g{MN + (size_t)l * 1024 * DM, (const bf16*)WL(WO_MKV), 1024, 4096, DM, DM, 0}; pg8::StaticOrder S; S.init(1024, 4096, G, G - 1 - bid);
              EpiMemKV E{out + OUT_MK + (size_t)l * 1024 * DM, out + OUT_MV + (size_t)l * 1024 * DM, MKB, MVB};
              pg8::gemm_phase<EpiMemKV, pg8::StaticOrder, true, true>(big, g, S, E); }
        }
        SEAM(P + 0);
        if (IN(P + 1)) PHASE(2) { PHASE_VARS(2);
            for (int pass = 0; pass < 2; ++pass) {
                if ((pass == 0) == ((bid & 1) == 1)) {
                    for (int u = bid; u < 512; u += G) sret_unit(big, Z, args.in[3] + (size_t)l * DECB * 4 * 65536, out + OUT_RSS + (size_t)l * DECB * 4 * 65536, args.in[9] + (size_t)l * DRET, CAT, u >> 2, u & 3, tid, wid, lane);
                } else {
                    for (int u = bid; u < 256; u += G) kvt_unit(big, Z, KD, KVT, u >> 4, u & 15, tid, wid, lane);
                    pooled_items(Z, args.in[4] + (size_t)l * DECB * 15 * DPOOL, PL, out + OUT_PBS + (size_t)l * DECB * 15 * DPOOL, gw, NGW, lane);
                }
            }
        }
        SEAM(P + 1);
        if (IN(P + 2)) PHASE(3) { PHASE_VARS(3);
            { const int nfree = G - 136;
              if (nfree >= 64) { if (bid >= 136) scan_items(KVT, ST, out + OUT_RSP + (size_t)l * 16 * 65536, (bid - 136) * 512 + tid, nfree * 512); }
              else scan_items(KVT, ST, out + OUT_RSP + (size_t)l * 16 * 65536, gt, NGT); }
            { pg8::Gemm g{PL, (const bf16*)WL(WO_POOL), MT, DPOOL, 256, DPOOL, 256}; pg8::StaticOrder S; S.init(MT, DPOOL, G, bid);
              EpiB<2> E{CAT, DM, 1.0f, args.in[11] + (size_t)l * DPOOL, DRET, nullptr};
              pg8::gemm_phase<EpiB<2>, pg8::StaticOrder, true, true>(big, g, S, E); }
        }
        SEAM(P + 2);
        if (IN(P + 3)) PHASE(4) { PHASE_VARS(4);
            for (int u = bid; u < 256; u += G) ret2_unit2(big, Z, ST, args.in[9] + (size_t)l * DRET, CAT, u >> 4, u & 15, tid, wid, lane);
            { SEpiRes E{l == 0 ? args.in[1] - (size_t)MP * DM : nullptr, XN, XNO, SSQ(3 * l + 1)};
              for (int u = bid; u < 256; u += G) sgemm3_tile(big, CAT, DM, (const bf16*)WL(WO_OUT), DM, MP + (u >> 5) * 64, (u & 31) * 64, E, tid, wid, lane); }
        }
        SEAM(P + 3);
        if (IN(P + 4)) PHASE(5) { PHASE_VARS(5);
            pg8::Gemm g{CAT, (const bf16*)WL(WO_OUT), MP, DM, DM, DM, 0}; pg8::StaticOrder S; S.init(MP, DM, G, bid);
            EpiRes E{l == 0 ? args.in[0] : nullptr, XN, XNO, SSQ(3 * l + 1)};
            pg8::gemm_phase<EpiRes, pg8::StaticOrder, true, true>(big, g, S, E);
            { RETIDS(); SEpiB<0> E2{Q2, DM, 0.044194173824159216f, SSQ(3 * l + 1)};
              for (int u = bid; u < 256; u += G) sgemm3_tile(big, XN, DM, (const bf16*)WL(WO_XQ), DM, MP + (u >> 5) * 64, (u & 31) * 64, E2, tid_, wid_, lane_); }
        }
        SEAM(P + 4);
        if (IN(P + 5)) PHASE(6) { PHASE_VARS(6);
            pg8::Gemm g{XN, (const bf16*)WL(WO_XQ), MP, DM, DM, DM, 0}; pg8::StaticOrder S; S.init(MP, DM, G, bid);
            EpiB<0> E{Q2, DM, 0.044194173824159216f, nullptr, 0, SSQ(3 * l + 1)};
            if (bid & 1) { for (int u = bid; u < 512; u += G) xattn_s_unit(big, Q2, args.in[5] + (size_t)l * DECB * NMEM * DM, args.in[6] + (size_t)l * DECB * NMEM * DM, ATT, u >> 2, u & 3, tid, wid, lane); }
            pg8::gemm_phase<EpiB<0>, pg8::StaticOrder, true, true>(big, g, S, E);
            if (!(bid & 1)) { RETIDS(); for (int u = bid; u < 512; u += G) xattn_s_unit(big, Q2, args.in[5] + (size_t)l * DECB * NMEM * DM, args.in[6] + (size_t)l * DECB * NMEM * DM, ATT, u >> 2, u & 3, tid_, wid_, lane_); }
        }
        SEAM(P + 5);
        if (IN(P + 6)) PHASE(7) { PHASE_VARS(7);
            for (int u = bid; u < 256; u += G) xattn_p_unit2(big, Q2, MKB, MVB, ATT, u >> 6, (u >> 4) & 3, u & 15, tid, wid, lane);
            { SEpiRes E{nullptr, XN, XNO, SSQ(3 * l + 2)};
              for (int u = bid; u < 256; u += G) sgemm3_tile(big, ATT, DM, (const bf16*)WL(WO_XO), DM, MP + (u >> 5) * 64, (u & 31) * 64, E, tid, wid, lane); }
        }
        SEAM(P + 6);
        if (IN(P + 7)) PHASE(8) { PHASE_VARS(8);
            pg8::Gemm g{ATT, (const bf16*)WL(WO_XO), MP, DM, DM, DM, 0}; pg8::StaticOrder S; S.init(MP, DM, G, bid);
            EpiRes E{nullptr, XN, XNO, SSQ(3 * l + 2)};
            pg8::gemm_phase<EpiRes, pg8::StaticOrder, true, true>(big, g, S, E);
            { RETIDS(); SEpiB<1> E2{UP, DFF, 1.0f, SSQ(3 * l + 2)};
#ifndef PROBE_UPS
#define PROBE_UPS 1
#endif
              for (int rp = 0; rp < PROBE_UPS; ++rp)
              for (int u = bid; u < 256; u += G) sgemm4_tile(big, XN, DM, (const bf16*)WL(WO_UP), DM, 0, DM, MP + (u >> 6) * 128, (u & 63) * 128, E2, tid_, wid_, lane_); }
        }
        SEAM(P + 7);
        if (IN(P + 8)) PHASE(9) { PHASE_VARS(9);
            pg8::Gemm g{XN, (const bf16*)WL(WO_UP), MP, DFF, DM, DM, 0}; pg8::StaticOrder S; S.init(MP, DFF, G, bid);
            EpiB<1> E{UP, DFF, 1.0f, nullptr, 0, SSQ(3 * l + 2)};
            pg8::gemm_phase<EpiB<1>, pg8::StaticOrder, true, true>(big, g, S, E);
            { RETIDS();
            for (int u = bid; u < 256; u += G) { const int t = u >> 2, kq = u & 3; SEpiPart E2{(float*)(ws + WS_PART) + (size_t)kq * MS * DM};
                sgemm4_tile(big, UP, DFF, (const bf16*)WL(WO_DN), DFF, kq * 2048, kq * 2048 + 2048, MP + (t >> 4) * 128, (t & 15) * 128, E2, tid_, wid_, lane_); } }
        }
        SEAM(P + 8);
        if (IN(P + 9)) PHASE(10) { PHASE_VARS(10);
            pg8::Gemm g{UP, (const bf16*)WL(WO_DN), MP, DM, DFF, DFF, 0}; pg8::StaticOrder S; S.init(MP, DM, G, bid);
            EpiRes E{nullptr, XN, XNO, SSQ(3 * l + 3)};
            pg8::gemm_phase<EpiRes, pg8::StaticOrder, true, true>(big, g, S, E);
            { RETIDS();
            if (l == 1) { for (int m = MP + gw_; m < MT; m += NGW) rms_row_f32_b(XN + (size_t)m * DM, args.in[22], out + OUT_YS + (size_t)(m - MP) * DM, lane_, (const float*)(ws + WS_PART) + (size_t)(m - MP) * DM, (size_t)MS * DM); }
            else { for (int m = MP + gw_; m < MT; m += NGW) row_fin_bf16(XN + (size_t)m * DM, XNO + (size_t)m * DM, SSQ(3 * l + 3) + (size_t)m * 64, lane_, (const float*)(ws + WS_PART) + (size_t)(m - MP) * DM, (size_t)MS * DM); } }
        }
        SEAM(P + 9);
    }
    if (IN(NPH - 1)) { TIDS(); for (int m = gw; m < MP; m += NGW) rms_row_f32_b(XN + (size_t)m * DM, args.in[22], out + OUT_YP + (size_t)m * DM, lane); }
#undef SSQ
#undef PHASE
#undef PHASE_VARS
#undef IN
#undef SEAM
#undef NREP
#undef TIDS
#undef ws
#undef out
#undef cosT
#undef sinT
#undef XN
#undef Z
#undef KD
#undef PL
#undef CAT
#undef Q2
#undef ATT
#undef XA
#undef UP
#undef MN
#undef MKB
#undef MVB
#undef KVT
#undef ST
#undef WL
#undef args
}

extern "C" void kernel_launch(void* const* d_in, const int* in_sizes, int n_in, void* d_out, int out_size, void* d_ws, size_t ws_size, hipStream_t stream) {
    static int grid = 0;
    if (grid == 0) {
        if (n_in != 23 || (size_t)out_size != OUT_TOTAL || ws_size < WS_END) { fprintf(stderr, "kernel_launch: unexpected shapes (n_in %d, out %d, ws %zu)\n", n_in, out_size, ws_size); grid = -1; return; }
        int dev = 0, cus = 0, per_cu = 0;
        if (hipGetDevice(&dev) != hipSuccess || hipDeviceGetAttribute(&cus, hipDeviceAttributeMultiprocessorCount, dev) != hipSuccess) { grid = -1; return; }
        if (hipFuncSetAttribute((const void*)fwd, hipFuncAttributeMaxDynamicSharedMemorySize, LDS_BYTES) != hipSuccess) { fprintf(stderr, "kernel_launch: hipFuncSetAttribute failed\n"); grid = -1; return; }
        if (hipOccupancyMaxActiveBlocksPerMultiprocessor(&per_cu, (const void*)fwd, 512, LDS_BYTES) != hipSuccess || per_cu < 1) fprintf(stderr, "kernel_launch: occupancy query reports %d blocks per CU\n", per_cu);
        (void)hipGetLastError();
        grid = cus;
    }
    if (grid < 0) return;
    (void)hipMemsetAsync((char*)d_ws + WS_CTL, 0, CTL_ZERO_BYTES, stream);
    Args a{};
    for (int i = 0; i < 23; ++i) a.in[i] = (const float*)d_in[i];
    a.out = (float*)d_out; a.ws = (unsigned char*)d_ws; a.pad = 0;
#if MK_N_LAUNCHES == 1
    a.ph_lo = 0; a.ph_hi = NPH; a.use_bar = 1;
    hipLaunchKernelGGL(fwd, dim3(grid), dim3(512), LDS_BYTES, stream, a);
#else
    for (int ph = 0; ph < NPH; ++ph) { a.ph_lo = ph; a.ph_hi = ph + 1; a.use_bar = 0; hipLaunchKernelGGL(fwd, dim3(grid), dim3(512), LDS_BYTES, stream, a); }
#endif
}
```
